# Optimizing an MI355X kernel written in HIP

```python
import jax
import jax.numpy as jnp
from jax import lax
import numpy as np

D_MODEL = 2048
BATCH = 4
SEQ = 4096
DEPTH = 4

RET_HEAD_DIM = 256
RET_HEADS = (D_MODEL // 2) // RET_HEAD_DIM
RET_WIDTH = RET_HEADS * RET_HEAD_DIM
RET_CHUNK = 128
POOL_WINDOWS = (2, 4, 8, 16)
POOL_WIDTH = D_MODEL - RET_WIDTH
POOL_GROUP = POOL_WIDTH // len(POOL_WINDOWS)
EVEN_IN = 4 * RET_WIDTH + POOL_WIDTH
ATTN_HEAD_DIM = 64
ATTN_Q_HEADS = D_MODEL // ATTN_HEAD_DIM
ATTN_KV_HEADS = ATTN_Q_HEADS // 8
ATTN_GROUP = ATTN_Q_HEADS // ATTN_KV_HEADS
ATTN_Q_WIDTH = ATTN_Q_HEADS * ATTN_HEAD_DIM
ATTN_KV_WIDTH = ATTN_KV_HEADS * ATTN_HEAD_DIM
ODD_IN = ATTN_Q_WIDTH + 2 * ATTN_KV_WIDTH
WINDOW = 128
ATTN_BLOCK = 128
D_FF = 5632
CONV_WIDTH = 3
N_EVEN = (DEPTH + 1) // 2
N_ODD = DEPTH // 2
DEEPNORM_ALPHA = (2 * DEPTH) ** 0.25
DEEPNORM_BETA = (8 * DEPTH) ** -0.25
LN_EPS = 1e-5

kernel_name = 'hybrid_retention_pool_swa_sink_convffn'


def layer_norm(x, g, b):
    xf = x.astype(jnp.float32)
    mu = jnp.mean(xf, axis=-1, keepdims=True)
    var = jnp.mean(jnp.square(xf - mu), axis=-1, keepdims=True)
    return ((xf - mu) * lax.rsqrt(var + LN_EPS) * g + b).astype(x.dtype)


def head_norm(y):
    mu = jnp.mean(y, axis=-1, keepdims=True)
    var = jnp.mean(jnp.square(y - mu), axis=-1, keepdims=True)
    return (y - mu) * lax.rsqrt(var + LN_EPS)


def retention_chunkwise(q, k, v):
    B, S, H, dk = q.shape
    C = RET_CHUNK
    N = S // C
    log_gamma = jnp.log1p(-(2.0 ** (-5.0 - jnp.arange(H, dtype=jnp.float32))))
    qc = q.reshape(B, N, C, H, dk)
    kc = (k * dk ** -0.5).reshape(B, N, C, H, dk)
    vc = v.reshape(B, N, C, H, v.shape[-1])
    pos = jnp.arange(C, dtype=jnp.float32)
    diff = pos[:, None] - pos[None, :]
    decay_in = jnp.where(diff[None] >= 0,
                         jnp.exp(log_gamma[:, None, None] * jnp.maximum(diff, 0.0)[None]), 0.0)
    scores = jnp.einsum('bnihd,bnjhd->bnhij', qc, kc) * decay_in
    inner = jnp.einsum('bnhij,bnjhe->bnihe', scores, vc)
    zeta = jnp.exp(log_gamma[:, None] * (C - 1.0 - pos)[None, :])
    kv = jnp.einsum('bnjhd,hj,bnjhe->bnhde', kc, zeta, vc)
    chunk_decay = jnp.exp(log_gamma * C)[:, None, None]

    def step(state, kv_n):
        return state * chunk_decay + kv_n, state

    init = jnp.zeros((B, H, dk, vc.shape[-1]), jnp.float32)
    _, prev = lax.scan(step, init, jnp.moveaxis(kv, 1, 0))
    prev = jnp.moveaxis(prev, 0, 1)
    xi = jnp.exp(log_gamma[:, None] * (pos + 1.0)[None, :])
    cross = jnp.einsum('bnihd,bnhde,hi->bnihe', qc, prev, xi)
    return (inner + cross).reshape(B, S, H, vc.shape[-1])


def multiscale_pool(u, pool_w, pool_scale):
    B, S, _ = u.shape
    uf = u.astype(jnp.float32)
    cs = jnp.cumsum(uf, axis=1)
    t = jnp.arange(S)
    outs = []
    for gi, w in enumerate(POOL_WINDOWS):
        lo, hi = gi * POOL_GROUP, (gi + 1) * POOL_GROUP
        csg = cs[..., lo:hi]
        lagged = jnp.pad(csg, ((0, 0), (w, 0), (0, 0)))[:, :S]
        count = jnp.minimum(t + 1, w).astype(jnp.float32)[None, :, None]
        pooled = (csg - lagged) / count - uf[..., lo:hi]
        outs.append(pooled @ pool_w[gi].astype(jnp.float32))
    return (jnp.concatenate(outs, axis=-1) * pool_scale.astype(jnp.float32)).astype(u.dtype)


def retention_pool_mixer(x, w_in, pool_w, pool_scale, w_out):
    B, S, _ = x.shape
    h = x @ w_in
    q, k, v, g, u = jnp.split(h, [RET_WIDTH, 2 * RET_WIDTH, 3 * RET_WIDTH, 4 * RET_WIDTH], axis=-1)
    heads = lambda a: a.astype(jnp.float32).reshape(B, S, RET_HEADS, RET_HEAD_DIM)
    y = head_norm(retention_chunkwise(heads(q), heads(k), heads(v))).reshape(B, S, RET_WIDTH)
    y_ret = (jax.nn.silu(g.astype(jnp.float32)) * y).astype(x.dtype)
    y_pool = multiscale_pool(u, pool_w, pool_scale)
    return jnp.concatenate([y_ret, y_pool], axis=-1) @ w_out


def alibi_slopes(n):
    start = 2.0 ** (-8.0 / n)
    return start ** jnp.arange(1, n + 1, dtype=jnp.float32)


def with_prev_block(a):
    pad = [(0, 0), (1, 0)] + [(0, 0)] * (a.ndim - 2)
    prev = jnp.pad(a[:, :-1], pad)
    return jnp.concatenate([prev, a], axis=2)


def swa_sink_attention(x, w_qkv, b_qkv, sinks, w_out):
    B, S, _ = x.shape
    L = ATTN_BLOCK
    NB = S // L
    h = x @ w_qkv + b_qkv
    q, k, v = jnp.split(h, [ATTN_Q_WIDTH, ATTN_Q_WIDTH + ATTN_KV_WIDTH], axis=-1)
    q = q.reshape(B, NB, L, ATTN_KV_HEADS, ATTN_GROUP, ATTN_HEAD_DIM)
    kb = with_prev_block(k.reshape(B, NB, L, ATTN_KV_HEADS, ATTN_HEAD_DIM))
    vb = with_prev_block(v.reshape(B, NB, L, ATTN_KV_HEADS, ATTN_HEAD_DIM))
    scores = jnp.einsum('bnikgd,bnjkd->bnkgij', q, kb).astype(jnp.float32) * ATTN_HEAD_DIM ** -0.5
    i = jnp.arange(L)
    j = jnp.arange(2 * L)
    delta = L + i[:, None] - j[None, :]
    s_pos = jnp.arange(NB)[:, None] * L - L + j[None, :]
    valid = (delta >= 0)[None] & (delta < WINDOW)[None] & (s_pos >= 0)[:, None, :]
    slopes = alibi_slopes(ATTN_Q_HEADS).reshape(ATTN_KV_HEADS, ATTN_GROUP)
    bias = -slopes[:, :, None, None] * delta.astype(jnp.float32)
    scores = jnp.where(valid[None, :, None, None], scores + bias[None, None], -jnp.inf)
    sink = sinks.astype(jnp.float32).reshape(ATTN_KV_HEADS, ATTN_GROUP)[None, None, :, :, None, None]
    m = jnp.maximum(jnp.max(scores, axis=-1, keepdims=True), sink)
    p = jnp.exp(scores - m)
    probs = p / (jnp.sum(p, axis=-1, keepdims=True) + jnp.exp(sink - m))
    o = jnp.einsum('bnkgij,bnjkd->bnikgd', probs.astype(vb.dtype), vb)
    return o.reshape(B, S, ATTN_Q_WIDTH) @ w_out


def conv_glu_ffn(x, w_in, conv_w, conv_b, w_out):
    S = x.shape[1]
    h = x @ w_in
    hp = jnp.pad(h, ((0, 0), (CONV_WIDTH - 1, 0), (0, 0)))
    hc = conv_b + hp[:, 0:S] * conv_w[0]
    for kk in range(1, CONV_WIDTH):
        hc = hc + hp[:, kk:kk + S] * conv_w[kk]
    gate, val = jnp.split(hc, 2, axis=-1)
    return (jax.nn.gelu(gate, approximate=False) * val) @ w_out


def setup_inputs(seed: int = 0) -> dict:
    key = jax.random.key(seed)
    ks = jax.random.split(key, 16)

    def nrm(k, shape, scale):
        return jax.random.normal(k, shape, jnp.float32) * scale

    return {
        'x': nrm(ks[0], (BATCH, SEQ, D_MODEL), 1.0),
        'ln_gain': 1.0 + nrm(ks[1], (DEPTH, 2, D_MODEL), 0.02),
        'ln_bias': nrm(ks[2], (DEPTH, 2, D_MODEL), 0.02),
        'even_w_in': nrm(ks[3], (N_EVEN, D_MODEL, EVEN_IN), D_MODEL ** -0.5),
        'pool_w': nrm(ks[4], (N_EVEN, len(POOL_WINDOWS), POOL_GROUP, POOL_GROUP), POOL_GROUP ** -0.5),
        'pool_scale': 1.0 + nrm(ks[5], (N_EVEN, POOL_WIDTH), 0.1),
        'even_w_out': nrm(ks[6], (N_EVEN, D_MODEL, D_MODEL), DEEPNORM_BETA * D_MODEL ** -0.5),
        'attn_w_qkv': nrm(ks[7], (N_ODD, D_MODEL, ODD_IN), D_MODEL ** -0.5),
        'attn_b_qkv': nrm(ks[8], (N_ODD, ODD_IN), 0.02),
        'attn_sinks': nrm(ks[9], (N_ODD, ATTN_Q_HEADS), 0.5),
        'attn_w_out': nrm(ks[10], (N_ODD, ATTN_Q_WIDTH, D_MODEL), DEEPNORM_BETA * ATTN_Q_WIDTH ** -0.5),
        'ffn_w_in': nrm(ks[11], (DEPTH, D_MODEL, 2 * D_FF), D_MODEL ** -0.5),
        'ffn_conv_w': nrm(ks[12], (DEPTH, CONV_WIDTH, 2 * D_FF), CONV_WIDTH ** -0.5),
        'ffn_conv_b': nrm(ks[13], (DEPTH, 2 * D_FF), 0.02),
        'ffn_w_out': nrm(ks[14], (DEPTH, D_FF, D_MODEL), DEEPNORM_BETA * D_FF ** -0.5),
    }


def reference(x, ln_gain, ln_bias, even_w_in, pool_w, pool_scale, even_w_out,
              attn_w_qkv, attn_b_qkv, attn_sinks, attn_w_out,
              ffn_w_in, ffn_conv_w, ffn_conv_b, ffn_w_out):
    for layer in range(DEPTH):
        li = layer // 2
        if layer % 2 == 0:
            mix = retention_pool_mixer(x, even_w_in[li], pool_w[li], pool_scale[li], even_w_out[li])
        else:
            mix = swa_sink_attention(x, attn_w_qkv[li], attn_b_qkv[li], attn_sinks[li], attn_w_out[li])
        x = layer_norm(DEEPNORM_ALPHA * x + mix, ln_gain[layer, 0], ln_bias[layer, 0])
        ffn = conv_glu_ffn(x, ffn_w_in[layer], ffn_conv_w[layer], ffn_conv_b[layer], ffn_w_out[layer])
        x = layer_norm(DEEPNORM_ALPHA * x + ffn, ln_gain[layer, 1], ln_bias[layer, 1])
    return x
```

```cpp
#include <hip/hip_runtime.h>
#include <hip/hip_cooperative_groups.h>
#include <cstdio>
#include <cstdint>
namespace cg = cooperative_groups;

#define LAS __attribute__((address_space(3)))
typedef unsigned short bf16_t;
typedef short bf16x8 __attribute__((ext_vector_type(8)));
typedef short s16x4 __attribute__((ext_vector_type(4)));
typedef float f32x4 __attribute__((ext_vector_type(4)));
typedef float f32x2 __attribute__((ext_vector_type(2)));
typedef unsigned u32x4 __attribute__((ext_vector_type(4)));
typedef unsigned u32x2 __attribute__((ext_vector_type(2)));
typedef __bf16 bf16x2_t __attribute__((ext_vector_type(2)));

constexpr int NBATCH = 4, SEQ = 4096, M = NBATCH * SEQ, D = 2048;
constexpr int EIN = 5120, OIN = 2560, FF = 5632, FF2 = 11264;
constexpr float ALPHA = 1.6817928305074290f;
constexpr float LN_EPS = 1e-5f;
constexpr float LOG2E = 1.4426950408889634f;

constexpr size_t MiB = 1u << 20;
constexpr size_t WS_EIN = 0 * MiB;
constexpr size_t WS_EOUT = 40 * MiB;
constexpr size_t WS_POOLW = 56 * MiB;
constexpr size_t WS_QKVW = 57 * MiB;
constexpr size_t WS_AOUT = 77 * MiB;
constexpr size_t WS_F1 = 93 * MiB;
constexpr size_t WS_F2 = 269 * MiB;
constexpr size_t WS_XB = 357 * MiB;
constexpr size_t WS_Y = 421 * MiB;
constexpr size_t WS_MIX = 549 * MiB;
constexpr size_t WS_BIG = 613 * MiB;
constexpr size_t WS_HF = WS_BIG;
constexpr size_t WS_ACT = WS_BIG + 352 * MiB;
constexpr size_t WS_H5 = WS_BIG;
constexpr size_t WS_QKV = WS_BIG;
constexpr size_t WS_KVT = WS_BIG + 160 * MiB;
constexpr size_t WS_PREVT = WS_BIG + 288 * MiB;
constexpr size_t WS_POOLED = WS_BIG + 352 * MiB;
constexpr size_t WS_END = 1141 * MiB;

constexpr int LDS_BYTES = 147456;

__device__ __forceinline__ unsigned pk2(float lo, float hi) { f32x2 v = {lo, hi}; bf16x2_t b = __builtin_convertvector(v, bf16x2_t); return __builtin_bit_cast(unsigned, b); }
__device__ __forceinline__ float bflo(unsigned w) { return __uint_as_float(w << 16); }
__device__ __forceinline__ float bfhi(unsigned w) { return __uint_as_float(w & 0xffff0000u); }
__device__ __forceinline__ float wave_sum(float v) {
#pragma unroll
    for (int o = 1; o < 64; o <<= 1) v += __shfl_xor(v, o);
    return v;
}
typedef short v4i16_t __attribute__((ext_vector_type(4)));
__device__ __forceinline__ s16x4 vtr(const LAS unsigned char* p) { return __builtin_bit_cast(s16x4, __builtin_amdgcn_ds_read_tr16_b64_v4i16((LAS v4i16_t*)p)); }
__device__ __forceinline__ bf16x8 cat8(s16x4 lo, s16x4 hi) { return (bf16x8){lo[0], lo[1], lo[2], lo[3], hi[0], hi[1], hi[2], hi[3]}; }
__device__ __forceinline__ f32x4 mfma16(bf16x8 a, bf16x8 b, f32x4 c) { return __builtin_amdgcn_mfma_f32_16x16x32_bf16(a, b, c, 0, 0, 0); }
__device__ __forceinline__ f32x2 gelu_pk(f32x2 v) {
    const f32x2 av = __builtin_elementwise_abs(v), d = av * 0.2316418882f + 1.0f;
    f32x2 t; t.x = __builtin_amdgcn_rcpf(d.x); t.y = __builtin_amdgcn_rcpf(d.y);
    f32x2 q = t * 0.5307027145f + (-0.7265760135f); q = q * t + 0.7107068705f; q = q * t + (-0.142248368f); q = q * t + 0.127414796f; q = q * t;
    const f32x2 s = (v * v) * (-0.72134752044f);
    f32x2 e; e.x = __builtin_amdgcn_exp2f(s.x); e.y = __builtin_amdgcn_exp2f(s.y);
    const f32x2 m = v * (q * e), r = v - m;
    f32x2 o; o.x = v.x < 0.f ? m.x : r.x; o.y = v.y < 0.f ? m.y : r.y; return o;
}

namespace pg8 {
constexpr int BM = 256, BK = 64, HALF = 128, HTB = HALF * BK * 2, STAGE_BYTES = 8 * HTB, NXCD = 8, WGM = 8;
__host__ __device__ __forceinline__ int lds_byte(int r, int c) { const int st = (r >> 4) * 2 + (c >> 5), rr = r & 15, cc = c & 31, ob = rr * 64 + cc * 2; return st * 1024 + (ob ^ (((ob >> 9) & 1) << 5)); }
__host__ __device__ __forceinline__ void stage_rc(int b, int& R, int& C) { const int st = b / 1024, sb = b % 1024, swz = sb ^ (((sb >> 9) & 1) << 5); R = (st >> 1) * 16 + swz / 64; C = (st & 1) * 32 + (swz % 64) / 2; }
__host__ __device__ __forceinline__ int perm32(int rho) { const int n = rho >> 4, i = rho & 15; return 8 * (i >> 2) + 4 * n + (i & 3); }

struct Unit { int pm, pn; };
struct Gemm { const bf16_t* A; const bf16_t* Bt; int lda, ldb, K, a_pn_off; };

struct StaticOrder {
    int nM, nN, nwg, G, c;
    __device__ void init(int M_, int N_, int G_, int c_) { nM = M_ / BM; nN = N_ / BM; nwg = nM * nN; G = G_; c = c_; }
    __device__ bool next(int i, Unit& u) const {
        const long L = (long)i * G + c; if (L >= nwg) return false;
        int wgid = (int)L; { const int q = nwg / NXCD, r = nwg % NXCD, xcd = wgid % NXCD, off = wgid / NXCD; wgid = (xcd < r ? xcd * (q + 1) : r * (q + 1) + (xcd - r) * q) + off; }
        const int nig = WGM * nN, gid = wgid / nig, fm = gid * WGM, gsz = (nM - fm) < WGM ? (nM - fm) : WGM;
        u.pm = fm + ((wgid % nig) % gsz); u.pn = (wgid % nig) / gsz; return true;
    }
};

struct EpiBf16 {
    static constexpr bool PERM = true;
    bf16_t* O; int ldc; const float* bias; const float* scale; int ocol_off;
    __device__ __forceinline__ void operator()(const f32x4 (&acc)[2][2][4][2], const Unit& u, int wr, int wc, int fr, int fq) const {
        const int row0 = u.pm * BM + wr * 64 + fr; const int bcol0 = u.pn * BM + wc * 32 + 8 * fq; const int col0 = ocol_off + bcol0;
        f32x4 bv[2][2], sv[2][2];
#pragma unroll
        for (int bj = 0; bj < 2; ++bj)
#pragma unroll
            for (int n = 0; n < 2; ++n) { bv[bj][n] = bias ? *(const f32x4*)(bias + bcol0 + bj * HALF + 4 * n) : (f32x4){0.f, 0.f, 0.f, 0.f};
                                          sv[bj][n] = scale ? *(const f32x4*)(scale + bcol0 + bj * HALF + 4 * n) : (f32x4){1.f, 1.f, 1.f, 1.f}; }
#pragma unroll
        for (int ai = 0; ai < 2; ++ai)
#pragma unroll
            for (int m = 0; m < 4; ++m) { bf16_t* rowp = O + (size_t)(row0 + ai * HALF + m * 16) * ldc + col0;
#pragma unroll
                for (int bj = 0; bj < 2; ++bj) { f32x4 v0 = (acc[ai][bj][m][0] + bv[bj][0]) * sv[bj][0], v1 = (acc[ai][bj][m][1] + bv[bj][1]) * sv[bj][1];
                    u32x4 w; w.x = pk2(v0[0], v0[1]); w.y = pk2(v0[2], v0[3]); w.z = pk2(v1[0], v1[1]); w.w = pk2(v1[2], v1[3]);
                    *(u32x4*)(rowp + bj * HALF) = w; } }
    }
};
struct EpiRes {
    static constexpr bool PERM = false;
    const float* X; float* Y;
    __device__ __forceinline__ void operator()(const f32x4 (&acc)[2][2][4][2], const Unit& u, int wr, int wc, int fr, int fq) const {
        const int row0 = u.pm * BM + wr * 64 + fr, col0 = u.pn * BM + wc * 32 + 4 * fq;
#pragma unroll
        for (int ai = 0; ai < 2; ++ai)
#pragma unroll
            for (int m = 0; m < 4; ++m) { const size_t off = (size_t)(row0 + ai * HALF + m * 16) * D + col0;
#pragma unroll
                for (int bj = 0; bj < 2; ++bj)
#pragma unroll
                    for (int n = 0; n < 2; ++n) { const f32x4 xv = *(const f32x4*)(X + off + bj * HALF + n * 16); *(f32x4*)(Y + off + bj * HALF + n * 16) = xv * ALPHA + acc[ai][bj][m][n]; }
                asm volatile("" ::: "memory"); }
    }
};

template <class Epi, bool ALIGN_EPI = true>
__device__ __forceinline__ void gemm_phase(LAS unsigned char* lds, const Gemm g, const StaticOrder& S, const Epi& E) {
    int tid = threadIdx.x; asm volatile("" : "+v"(tid));
    const int wid = __builtin_amdgcn_readfirstlane(tid >> 6), lane = tid & 63, wr = wid >> 2, wc = wid & 3, fr = lane & 15, fq = lane >> 4;
    const int K = g.K, nt = K / BK;
    unsigned voffA[2], voffB[2];
#pragma unroll
    for (int i = 0; i < 2; ++i) { int R, C; stage_rc(tid * 16 + i * 8192, R, C); const int Rb = Epi::PERM ? ((R & ~31) + perm32(R & 31)) : R;
        voffA[i] = (unsigned)(R * g.lda + C) * 2u; voffB[i] = (unsigned)(Rb * g.ldb + C) * 2u; }
    const size_t kstep = (size_t)(BK * 2);
    const size_t hA = (size_t)HALF * g.lda * 2, hB = (size_t)HALF * g.ldb * 2;
    const unsigned ldsw = (unsigned)wid * 1024u;
    const int aoff = lds_byte(wr * 64 + fr, fq * 8), boff = lds_byte(wc * 32 + fr, fq * 8);
#define PG8_SA(b, h) (((b) * 2 + (h)) * HTB)
#define PG8_SB(b, h) ((4 + (b) * 2 + (h)) * HTB)
#define PG8_STAGE(bufoff, gbase, voff) do { _Pragma("unroll") for (int _i = 0; _i < 2; ++_i) \
        __builtin_amdgcn_global_load_lds((const unsigned*)((const char*)(gbase) + (voff)[_i]), (LAS unsigned*)(lds + (bufoff) + ldsw + _i * 8192), 16, 0, 0); } while (0)
#define PG8_LDA(dst, b, h) do { _Pragma("unroll") for (int m = 0; m < 4; ++m) _Pragma("unroll") for (int k = 0; k < 2; ++k) dst[m][k] = *(const LAS bf16x8*)(lds + PG8_SA(b, h) + aoff + m * 2048 + k * 1024); } while (0)
#define PG8_LDB(dst, b, h) do { _Pragma("unroll") for (int n = 0; n < 2; ++n) _Pragma("unroll") for (int k = 0; k < 2; ++k) dst[n][k] = *(const LAS bf16x8*)(lds + PG8_SB(b, h) + boff + n * 2048 + k * 1024); } while (0)
#define PG8_MMA(ai, bj, At, Bt) do { __builtin_amdgcn_s_setprio(1); _Pragma("unroll") for (int m = 0; m < 4; ++m) _Pragma("unroll") for (int n = 0; n < 2; ++n) _Pragma("unroll") for (int k = 0; k < 2; ++k) \
        acc[ai][bj][m][n] = __builtin_amdgcn_mfma_f32_16x16x32_bf16(Bt[n][k], At[m][k], acc[ai][bj][m][n], 0, 0, 0); __builtin_amdgcn_s_setprio(0); } while (0)
#define PG8_WAIT_V(n) asm volatile("s_waitcnt vmcnt(" #n ")" ::: "memory")
#define PG8_WAIT_L(n) asm volatile("s_waitcnt lgkmcnt(" #n ")" ::: "memory")
#define PG8_BAR __builtin_amdgcn_s_barrier()
#define PG8_SCHED __builtin_amdgcn_sched_barrier(0)
    Unit cur, nxt; int ui = 0;
    if (!S.next(0, cur)) return;
    f32x4 acc[2][2][4][2];
#pragma unroll
    for (int a = 0; a < 2; ++a)
#pragma unroll
        for (int b = 0; b < 2; ++b)
#pragma unroll
            for (int m = 0; m < 4; ++m)
#pragma unroll
                for (int n = 0; n < 2; ++n) acc[a][b][m][n] = (f32x4){0.f, 0.f, 0.f, 0.f};
    bf16x8 At[4][2], B0[2][2], B1[2][2];
    const char* cA = (const char*)g.A + ((size_t)cur.pm * BM * g.lda + (size_t)cur.pn * g.a_pn_off) * 2; const char* cB = (const char*)g.Bt + (size_t)cur.pn * BM * g.ldb * 2;
    PG8_STAGE(PG8_SB(0, 0), cB, voffB); PG8_STAGE(PG8_SB(0, 1), cB + hB, voffB); PG8_STAGE(PG8_SA(0, 0), cA, voffA); PG8_STAGE(PG8_SA(0, 1), cA + hA, voffA);
    if (wr == 1) PG8_BAR;
    PG8_WAIT_V(2); PG8_BAR;
    PG8_STAGE(PG8_SB(1, 0), cB + kstep, voffB); PG8_STAGE(PG8_SA(1, 0), cA + kstep, voffA); PG8_STAGE(PG8_SB(1, 1), cB + hB + kstep, voffB);
    PG8_WAIT_V(6); PG8_BAR;
    for (;;) {
        const bool has_next = S.next(ui + 1, nxt);
        const char* nA = has_next ? (const char*)g.A + ((size_t)nxt.pm * BM * g.lda + (size_t)nxt.pn * g.a_pn_off) * 2 : cA; const char* nB = has_next ? (const char*)g.Bt + (size_t)nxt.pn * BM * g.ldb * 2 : cB;
        for (int t = 0; t < nt; t += 2) {
            const bool last = (t == nt - 2);
            const char* a1 = cA + (size_t)(t + 1) * kstep;
            const char* a2 = last ? nA : cA + (size_t)(t + 2) * kstep; const char* b2 = last ? nB : cB + (size_t)(t + 2) * kstep;
            const char* a3 = a2 + kstep; const char* b3 = b2 + kstep;
            PG8_LDB(B0, 0, 0); PG8_LDB(B1, 0, 1); PG8_SCHED; PG8_LDA(At, 0, 0); PG8_STAGE(PG8_SA(1, 1), a1 + hA, voffA);
            PG8_WAIT_V(8); PG8_WAIT_L(0); PG8_BAR; PG8_MMA(0, 0, At, B0); PG8_MMA(0, 1, At, B1); PG8_BAR; PG8_SCHED;
            PG8_LDA(At, 0, 1); PG8_STAGE(PG8_SB(0, 0), b2, voffB); PG8_STAGE(PG8_SB(0, 1), b2 + hB, voffB); PG8_STAGE(PG8_SA(0, 0), a2, voffA);
            PG8_WAIT_V(8); PG8_WAIT_L(0); PG8_BAR; PG8_MMA(1, 0, At, B0); PG8_MMA(1, 1, At, B1); PG8_BAR; PG8_SCHED;
            PG8_LDB(B0, 1, 0); PG8_LDB(B1, 1, 1); PG8_SCHED; PG8_LDA(At, 1, 0); PG8_STAGE(PG8_SA(0, 1), a2 + hA, voffA);
            PG8_WAIT_V(8); PG8_WAIT_L(0); PG8_BAR; PG8_MMA(0, 0, At, B0); PG8_MMA(0, 1, At, B1); PG8_BAR; PG8_SCHED;
            PG8_LDA(At, 1, 1); PG8_STAGE(PG8_SB(1, 0), b3, voffB); PG8_STAGE(PG8_SB(1, 1), b3 + hB, voffB); PG8_STAGE(PG8_SA(1, 0), a3, voffA);
            PG8_WAIT_V(8); PG8_WAIT_L(0); PG8_BAR; PG8_MMA(1, 0, At, B0); PG8_MMA(1, 1, At, B1); PG8_BAR; PG8_SCHED;
        }
        if constexpr (ALIGN_EPI) { if (wr == 0) PG8_BAR; }
        E(acc, cur, wr, wc, fr, fq);
        if (!has_next) break;
#pragma unroll
        for (int a = 0; a < 2; ++a)
#pragma unroll
            for (int b = 0; b < 2; ++b)
#pragma unroll
                for (int m = 0; m < 4; ++m)
#pragma unroll
                    for (int n = 0; n < 2; ++n) acc[a][b][m][n] = (f32x4){0.f, 0.f, 0.f, 0.f};
        cur = nxt; cA = nA; cB = nB; ++ui;
        if constexpr (ALIGN_EPI) { if (wr == 1) PG8_BAR; }
    }
    PG8_WAIT_V(0);
    if constexpr (!ALIGN_EPI) { if (wr == 0) PG8_BAR; }
    PG8_BAR;
#undef PG8_SA
#undef PG8_SB
#undef PG8_STAGE
#undef PG8_LDA
#undef PG8_LDB
#undef PG8_MMA
#undef PG8_WAIT_V
#undef PG8_WAIT_L
#undef PG8_BAR
#undef PG8_SCHED
}
}

struct Args { const float* in[15]; float* out; unsigned char* ws; };
struct Frame { LAS unsigned char* lds; int tid, lane, wave, G, bid; };
__device__ __forceinline__ Frame relaunder(const Frame& F0) { Frame F = F0; int t = F0.tid; asm volatile("" : "+v"(t)); F.tid = t; F.lane = t & 63; F.wave = __builtin_amdgcn_readfirstlane(t >> 6); return F; }

__device__ __forceinline__ void p0_item(const float* W, int K, int N, bf16_t* WT, int row_off, bool permff, LAS float* scr, int item, int lane) {
    const int nblk = N >> 6, kb = item / nblk, nb = item - kb * nblk, k0 = kb << 6, n0 = nb << 6;
    const float* src = W + (size_t)k0 * N + n0 + lane;
#pragma unroll 16
    for (int kk = 0; kk < 64; ++kk) scr[kk * 65 + lane] = src[(size_t)kk * N];
    asm volatile("s_waitcnt lgkmcnt(0)" ::: "memory");
    int orow0 = row_off + n0;
    if (permff) { orow0 = (n0 < FF) ? ((n0 >> 7) * 256 + (n0 & 127)) : (((n0 - FF) >> 7) * 256 + 128 + ((n0 - FF) & 127)); }
#pragma unroll
    for (int j = 0; j < 8; ++j) { const int id = lane + 64 * j, n = id >> 3, c = id & 7; const LAS float* s = scr + (8 * c) * 65 + n;
        u32x4 o; o.x = pk2(s[0 * 65], s[1 * 65]); o.y = pk2(s[2 * 65], s[3 * 65]); o.z = pk2(s[4 * 65], s[5 * 65]); o.w = pk2(s[6 * 65], s[7 * 65]);
        *(u32x4*)(WT + (size_t)(orow0 + n) * K + k0 + 8 * c) = o; }
    asm volatile("s_waitcnt lgkmcnt(0)" ::: "memory");
}
__device__ __forceinline__ void p0_prologue(const Frame& F0, const Args& a) {
    const Frame F = relaunder(F0);
    LAS float* scr = (LAS float*)(F.lds + F.wave * 16640);
    const int gw = F.bid * 8 + F.wave, NGW = F.G * 8;
    unsigned char* ws = a.ws;
    constexpr int I_EIN = (D / 64) * (EIN / 64), I_SQ = (D / 64) * (D / 64), I_PW = 16, I_QKV = (D / 64) * (OIN / 64), I_F1 = (D / 64) * (FF2 / 64), I_F2 = (FF / 64) * (D / 64);
    constexpr int T0 = 2 * I_EIN, T1 = T0 + 2 * I_SQ, T2 = T1 + 8 * I_PW, T3 = T2 + 2 * I_QKV, T4 = T3 + 2 * I_SQ, T5 = T4 + 4 * I_F1, T6 = T5 + 4 * I_F2;
    for (int it = gw; it < T6; it += NGW) {
        if (it < T0) { const int li = it / I_EIN, r = it - li * I_EIN; p0_item(a.in[3] + (size_t)li * D * EIN, D, EIN, (bf16_t*)(ws + WS_EIN) + (size_t)li * EIN * D, 0, false, scr, r, F.lane); }
        else if (it < T1) { const int x = it - T0, li = x / I_SQ, r = x - li * I_SQ; p0_item(a.in[6] + (size_t)li * D * D, D, D, (bf16_t*)(ws + WS_EOUT) + (size_t)li * D * D, 0, false, scr, r, F.lane); }
        else if (it < T2) { const int x = it - T1, lg = x / I_PW, r = x - lg * I_PW, li = lg >> 2, g = lg & 3; p0_item(a.in[4] + (size_t)lg * 65536, 256, 256, (bf16_t*)(ws + WS_POOLW) + (size_t)li * 1024 * 256, g * 256, false, scr, r, F.lane); }
        else if (it < T3) { const int x = it - T2, li = x / I_QKV, r = x - li * I_QKV; p0_item(a.in[7] + (size_t)li * D * OIN, D, OIN, (bf16_t*)(ws + WS_QKVW) + (size_t)li * OIN * D, 0, false, scr, r, F.lane); }
        else if (it < T4) { const int x = it - T3, li = x / I_SQ, r = x - li * I_SQ; p0_item(a.in[10] + (size_t)li * D * D, D, D, (bf16_t*)(ws + WS_AOUT) + (size_t)li * D * D, 0, false, scr, r, F.lane); }
        else if (it < T5) { const int x = it - T4, l = x / I_F1, r = x - l * I_F1; p0_item(a.in[11] + (size_t)l * D * FF2, D, FF2, (bf16_t*)(ws + WS_F1) + (size_t)l * FF2 * D, 0, true, scr, r, F.lane); }
        else { const int x = it - T5, l = x / I_F2, r = x - l * I_F2; p0_item(a.in[14] + (size_t)l * FF * D, FF, D, (bf16_t*)(ws + WS_F2) + (size_t)l * D * FF, 0, false, scr, r, F.lane); }
    }
    const f32x4* x4 = (const f32x4*)a.in[0]; u32x2* xb = (u32x2*)(ws + WS_XB);
    for (size_t i = (size_t)F.bid * 512 + F.tid; i < (size_t)M * D / 4; i += (size_t)F.G * 512) { const f32x4 v = x4[i]; u32x2 o; o.x = pk2(v[0], v[1]); o.y = pk2(v[2], v[3]); xb[i] = o; }
}

__device__ __forceinline__ void ln_phase(const Frame& F0, const float* Y, const float* g, const float* b, float* XF, bf16_t* XB) {
    const Frame F = relaunder(F0);
    const int gw = F.bid * 8 + F.wave, NGW = F.G * 8;
    for (int row = gw; row < M; row += NGW) {
        const f32x4* yr = (const f32x4*)(Y + (size_t)row * D) + F.lane;
        f32x4 v[8]; float s = 0.f;
#pragma unroll
        for (int j = 0; j < 8; ++j) { v[j] = yr[64 * j]; s += (v[j][0] + v[j][1]) + (v[j][2] + v[j][3]); }
        const float mean = wave_sum(s) * (1.f / D); float s2 = 0.f;
#pragma unroll
        for (int j = 0; j < 8; ++j) { v[j] = v[j] - mean; s2 += (v[j][0] * v[j][0] + v[j][1] * v[j][1]) + (v[j][2] * v[j][2] + v[j][3] * v[j][3]); }
        const float rstd = 1.0f / sqrtf(wave_sum(s2) * (1.f / D) + LN_EPS);
        f32x4* xo = (f32x4*)(XF + (size_t)row * D) + F.lane; u32x2* bo = (u32x2*)(XB + (size_t)row * D) + F.lane;
#pragma unroll
        for (int j = 0; j < 8; ++j) { const f32x4 gg = ((const f32x4*)g)[F.lane + 64 * j], bb = ((const f32x4*)b)[F.lane + 64 * j];
            const f32x4 o = v[j] * rstd * gg + bb; xo[64 * j] = o; u32x2 w; w.x = pk2(o[0], o[1]); w.y = pk2(o[2], o[3]); bo[64 * j] = w; }
    }
}

__device__ __forceinline__ void conv_phase(const Frame& F0, const bf16_t* HF, const float* cw, const float* cb, bf16_t* ACT) {
    const Frame F = relaunder(F0);
    constexpr int NCG = FF / 8, RUN = 32, NRUN = M / RUN;
    for (int it = F.bid * 512 + F.tid; it < NRUN * NCG; it += F.G * 512) {
        const int cgi = it % NCG, run = it / NCG, c = cgi * 8, hg = (c >> 7) * 256 + (c & 127);
        const int t0 = run * RUN, p0 = t0 & (SEQ - 1);
        float wg[3][8], wv[3][8], bg[8], bv[8];
#pragma unroll
        for (int k = 0; k < 3; ++k)
#pragma unroll
            for (int e = 0; e < 8; ++e) { wg[k][e] = cw[(size_t)k * FF2 + c + e]; wv[k][e] = cw[(size_t)k * FF2 + FF + c + e]; }
#pragma unroll
        for (int e = 0; e < 8; ++e) { bg[e] = cb[c + e]; bv[e] = cb[FF + c + e]; }
        float g2[8], g1[8], v2[8], v1[8];
#pragma unroll
        for (int e = 0; e < 8; ++e) { g2[e] = 0.f; g1[e] = 0.f; v2[e] = 0.f; v1[e] = 0.f; }
        if (p0 > 0) {
            const u32x4 a2 = *(const u32x4*)(HF + (size_t)(t0 - 2) * FF2 + hg), a1 = *(const u32x4*)(HF + (size_t)(t0 - 1) * FF2 + hg);
            const u32x4 b2 = *(const u32x4*)(HF + (size_t)(t0 - 2) * FF2 + hg + 128), b1 = *(const u32x4*)(HF + (size_t)(t0 - 1) * FF2 + hg + 128);
#pragma unroll
            for (int e = 0; e < 4; ++e) { g2[2 * e] = bflo(a2[e]); g2[2 * e + 1] = bfhi(a2[e]); g1[2 * e] = bflo(a1[e]); g1[2 * e + 1] = bfhi(a1[e]);
                                          v2[2 * e] = bflo(b2[e]); v2[2 * e + 1] = bfhi(b2[e]); v1[2 * e] = bflo(b1[e]); v1[2 * e + 1] = bfhi(b1[e]); }
        }
        for (int k = 0; k < RUN; ++k) {
            const int t = t0 + k;
            const u32x4 a0 = *(const u32x4*)(HF + (size_t)t * FF2 + hg), b0 = *(const u32x4*)(HF + (size_t)t * FF2 + hg + 128);
            float g0[8], v0[8];
#pragma unroll
            for (int e = 0; e < 4; ++e) { g0[2 * e] = bflo(a0[e]); g0[2 * e + 1] = bfhi(a0[e]); v0[2 * e] = bflo(b0[e]); v0[2 * e + 1] = bfhi(b0[e]); }
            u32x4 o;
#pragma unroll
            for (int e = 0; e < 4; ++e) {
                f32x2 gc, vc;
                gc.x = bg[2 * e] + wg[0][2 * e] * g2[2 * e] + wg[1][2 * e] * g1[2 * e] + wg[2][2 * e] * g0[2 * e];
                gc.y = bg[2 * e + 1] + wg[0][2 * e + 1] * g2[2 * e + 1] + wg[1][2 * e + 1] * g1[2 * e + 1] + wg[2][2 * e + 1] * g0[2 * e + 1];
                vc.x = bv[2 * e] + wv[0][2 * e] * v2[2 * e] + wv[1][2 * e] * v1[2 * e] + wv[2][2 * e] * v0[2 * e];
                vc.y = bv[2 * e + 1] + wv[0][2 * e + 1] * v2[2 * e + 1] + wv[1][2 * e + 1] * v1[2 * e + 1] + wv[2][2 * e + 1] * v0[2 * e + 1];
                const f32x2 ge = gelu_pk(gc);
                o[e] = pk2(ge.x * vc.x, ge.y * vc.y);
            }
            *(u32x4*)(ACT + (size_t)t * FF + c) = o;
#pragma unroll
            for (int e = 0; e < 8; ++e) { g2[e] = g1[e]; g1[e] = g0[e]; v2[e] = v1[e]; v1[e] = v0[e]; }
        }
    }
}

__device__ __forceinline__ void attn_phase(const Frame& F0, const bf16_t* QKV, const float* sinks, bf16_t* MIX) {
    const Frame F = relaunder(F0);
    constexpr int RS = 144;
    LAS unsigned char* Kt = F.lds; LAS unsigned char* Vt = F.lds + 256 * RS;
    const int lane = F.lane, r = lane & 15, g4 = lane >> 4, qq = r >> 2, pp = r & 3;
    for (int u = F.bid; u < 512; u += F.G) {
        const int kvh = u & 3, n = (u >> 2) & 31, b = u >> 7, tok0 = b * SEQ + n * 128;
        for (int c = F.tid; c < 256 * 8; c += 512) { const int row = c >> 3, ch = c & 7; const bool valid = (n > 0) || (row >= 128);
            u32x4 kv = (u32x4){0u, 0u, 0u, 0u}, vv = kv;
            if (valid) { const bf16_t* src = QKV + (size_t)(tok0 - 128 + row) * OIN + 2048 + kvh * 64 + ch * 8; kv = *(const u32x4*)src; vv = *(const u32x4*)(src + 256); }
            *(LAS u32x4*)(Kt + row * RS + ch * 16) = kv; *(LAS u32x4*)(Vt + row * RS + ch * 16) = vv; }
        __syncthreads();
        const int head = kvh * 8 + F.wave;
        const float slope2 = __builtin_amdgcn_exp2f(-0.25f * (float)(head + 1)) * LOG2E, sink2 = sinks[head] * LOG2E;
        for (int rb = 0; rb < 8; ++rb) {
            const bf16_t* qp = QKV + (size_t)(tok0 + 16 * rb + r) * OIN + head * 64 + 8 * g4;
            const bf16x8 q0 = *(const bf16x8*)qp, q1 = *(const bf16x8*)(qp + 32);
            f32x4 s[9];
#pragma unroll
            for (int tt = 0; tt < 9; ++tt) { const LAS unsigned char* kp = Kt + (16 * (rb + tt) + r) * RS + 16 * g4;
                f32x4 acc = (f32x4){0.f, 0.f, 0.f, 0.f};
                acc = mfma16(*(const LAS bf16x8*)kp, q0, acc); acc = mfma16(*(const LAS bf16x8*)(kp + 64), q1, acc); s[tt] = acc; }
            const int i = 16 * rb + r; float mx = -INFINITY;
#pragma unroll
            for (int tt = 0; tt < 9; ++tt)
#pragma unroll
                for (int jj = 0; jj < 4; ++jj) { const int j = 16 * (rb + tt) + 4 * g4 + jj, delta = 128 + i - j; const bool valid = (delta >= 0) && (delta < 128) && ((n > 0) || (j >= 128));
                    const float v = s[tt][jj] * (0.125f * LOG2E) - slope2 * (float)delta; s[tt][jj] = valid ? v : -INFINITY; mx = fmaxf(mx, s[tt][jj]); }
            mx = fmaxf(mx, __shfl_xor(mx, 16)); mx = fmaxf(mx, __shfl_xor(mx, 32)); mx = fmaxf(mx, sink2);
            float sum = 0.f;
#pragma unroll
            for (int tt = 0; tt < 9; ++tt)
#pragma unroll
                for (int jj = 0; jj < 4; ++jj) { const float p = __builtin_amdgcn_exp2f(s[tt][jj] - mx); s[tt][jj] = p; sum += p; }
            sum += __shfl_xor(sum, 16); sum += __shfl_xor(sum, 32);
            const float inv = 1.0f / (sum + __builtin_amdgcn_exp2f(sink2 - mx));
            u32x2 P[10];
#pragma unroll
            for (int tt = 0; tt < 9; ++tt) { P[tt].x = pk2(s[tt][0] * inv, s[tt][1] * inv); P[tt].y = pk2(s[tt][2] * inv, s[tt][3] * inv); }
            P[9] = (u32x2){0u, 0u};
            f32x4 o[4];
#pragma unroll
            for (int te = 0; te < 4; ++te) o[te] = (f32x4){0.f, 0.f, 0.f, 0.f};
#pragma unroll
            for (int pr = 0; pr < 5; ++pr) { const int t0 = 2 * pr, t1 = (pr < 4) ? 2 * pr + 1 : 2 * pr;
                const u32x4 bw = (u32x4){P[t0].x, P[t0].y, P[2 * pr + 1].x, P[2 * pr + 1].y}; const bf16x8 bfrag = __builtin_bit_cast(bf16x8, bw);
                const LAS unsigned char* v0 = Vt + (16 * (rb + t0) + 4 * g4 + qq) * RS + 8 * pp; const LAS unsigned char* v1 = Vt + (16 * (rb + t1) + 4 * g4 + qq) * RS + 8 * pp;
#pragma unroll
                for (int te = 0; te < 4; ++te) o[te] = mfma16(cat8(vtr(v0 + 32 * te), vtr(v1 + 32 * te)), bfrag, o[te]); }
            bf16_t* op = MIX + (size_t)(tok0 + i) * D + head * 64 + 4 * g4;
#pragma unroll
            for (int te = 0; te < 4; ++te) { u32x2 w; w.x = pk2(o[te][0], o[te][1]); w.y = pk2(o[te][2], o[te][3]); *(u32x2*)(op + 16 * te) = w; }
        }
        __syncthreads();
    }
}

__device__ __forceinline__ float ret_lg2(int h) { return __builtin_amdgcn_logf(1.0f - __builtin_amdgcn_exp2f(-5.0f - (float)h)); }
constexpr int RRS = 528;

__device__ __forceinline__ void ret_kv_phase(const Frame& F0, const bf16_t* H5, float* KVT) {
    const Frame F = relaunder(F0);
    LAS unsigned char* Kt = F.lds; LAS unsigned char* Vt = F.lds + 128 * RRS;
    const int lane = F.lane, r = lane & 15, g4 = lane >> 4, qq = r >> 2, pp = r & 3, w = F.wave;
    for (int u = F.bid; u < 512; u += F.G) {
        const int h = u & 3, n = (u >> 2) & 31, b = u >> 7, tok0 = b * SEQ + n * 128; const float lg2 = ret_lg2(h);
        for (int c = F.tid; c < 128 * 32; c += 512) { const int row = c >> 5, ch = c & 31; const bf16_t* src = H5 + (size_t)(tok0 + row) * EIN + 1024 + h * 256 + ch * 8;
            const u32x4 kv = *(const u32x4*)src, vv = *(const u32x4*)(src + 1024); const float z = __builtin_amdgcn_exp2f(lg2 * (float)(127 - row)) * 0.0625f;
            u32x4 ks;
#pragma unroll
            for (int e = 0; e < 4; ++e) ks[e] = pk2(bflo(kv[e]) * z, bfhi(kv[e]) * z);
            *(LAS u32x4*)(Kt + row * RRS + ch * 16) = ks; *(LAS u32x4*)(Vt + row * RRS + ch * 16) = vv; }
        __syncthreads();
        for (int dh = 0; dh < 2; ++dh) {
            f32x4 acc[2][8];
#pragma unroll
            for (int a = 0; a < 2; ++a)
#pragma unroll
                for (int d = 0; d < 8; ++d) acc[a][d] = (f32x4){0.f, 0.f, 0.f, 0.f};
#pragma unroll
            for (int ks = 0; ks < 4; ++ks) { const int R0 = 32 * ks + 8 * g4 + qq;
                const LAS unsigned char* vb = Vt + R0 * RRS + 8 * pp; const LAS unsigned char* kb = Kt + R0 * RRS + 8 * pp + 256 * dh;
                const bf16x8 vf0 = cat8(vtr(vb + 64 * w), vtr(vb + 4 * RRS + 64 * w)), vf1 = cat8(vtr(vb + 64 * w + 32), vtr(vb + 4 * RRS + 64 * w + 32));
#pragma unroll
                for (int dt = 0; dt < 8; ++dt) { const bf16x8 kf = cat8(vtr(kb + 32 * dt), vtr(kb + 4 * RRS + 32 * dt)); acc[0][dt] = mfma16(kf, vf0, acc[0][dt]); acc[1][dt] = mfma16(kf, vf1, acc[1][dt]); } }
            float* op = KVT + (size_t)u * 65536 + (size_t)(32 * w + r) * 256 + 128 * dh + 4 * g4;
#pragma unroll
            for (int a = 0; a < 2; ++a)
#pragma unroll
                for (int dt = 0; dt < 8; ++dt) *(f32x4*)(op + a * 16 * 256 + 16 * dt) = acc[a][dt];
        }
        __syncthreads();
    }
}
__device__ __forceinline__ void pooled_phase(const Frame& F0, const bf16_t* H5, bf16_t* PO) {
    const Frame F = relaunder(F0);
    for (int it = F.bid * 512 + F.tid; it < 1024 * 128; it += F.G * 512) {
        const int cgp = it & 127, run = it >> 7, c = cgp * 8, w = 2 << (c >> 8), t0 = run * 16, p0 = t0 & (SEQ - 1);
        const bf16_t* U = H5 + 4096 + c;
        float S[8];
#pragma unroll
        for (int e = 0; e < 8; ++e) S[e] = 0.f;
        for (int s = 1; s < w; ++s) if (p0 - s >= 0) { const u32x4 x = *(const u32x4*)(U + (size_t)(t0 - s) * EIN);
#pragma unroll
            for (int e = 0; e < 4; ++e) { S[2 * e] += bflo(x[e]); S[2 * e + 1] += bfhi(x[e]); } }
        for (int k = 0; k < 16; ++k) { const int t = t0 + k, p = p0 + k; const u32x4 x = *(const u32x4*)(U + (size_t)t * EIN);
            const float rc = 1.0f / (float)((p + 1 < w) ? p + 1 : w); u32x4 o;
#pragma unroll
            for (int e = 0; e < 4; ++e) { const float a0 = bflo(x[e]), a1 = bfhi(x[e]); S[2 * e] += a0; S[2 * e + 1] += a1; o[e] = pk2(S[2 * e] * rc - a0, S[2 * e + 1] * rc - a1); }
            *(u32x4*)(PO + (size_t)t * 1024 + c) = o;
            if (p - (w - 1) >= 0) { const u32x4 y = *(const u32x4*)(U + (size_t)(t - (w - 1)) * EIN);
#pragma unroll
                for (int e = 0; e < 4; ++e) { S[2 * e] -= bflo(y[e]); S[2 * e + 1] -= bfhi(y[e]); } }
        }
    }
}
__device__ __forceinline__ void ret_scan_phase(const Frame& F0, const float* KVT, bf16_t* PREVT) {
    const Frame F = relaunder(F0);
    for (int it = F.bid * 512 + F.tid; it < 16 * 16384; it += F.G * 512) {
        const int bh = it >> 14, e4 = it & 16383, b = bh >> 2, h = bh & 3; const float cd = __builtin_amdgcn_exp2f(ret_lg2(h) * 128.0f);
        f32x4 st = (f32x4){0.f, 0.f, 0.f, 0.f};
#pragma unroll 4
        for (int n = 0; n < 31; ++n) { const size_t u = (size_t)((b * 32 + n) * 4 + h);
            st = st * cd + *(const f32x4*)(KVT + u * 65536 + (size_t)e4 * 4);
            u32x2 o; o.x = pk2(st[0], st[1]); o.y = pk2(st[2], st[3]); *(u32x2*)(PREVT + (u + 4) * 65536 + (size_t)e4 * 4) = o; }
    }
}
__device__ __forceinline__ void ret_out_phase(const Frame& F0, const bf16_t* H5, const bf16_t* PREVT, bf16_t* MIX) {
    const Frame F = relaunder(F0);
    LAS unsigned char* Kt = F.lds; LAS unsigned char* Vt = F.lds + 128 * RRS;
    const int lane = F.lane, r = lane & 15, g4 = lane >> 4, qq = r >> 2, pp = r & 3, w = F.wave;
    for (int u = F.bid; u < 512; u += F.G) {
        const int h = u & 3, n = (u >> 2) & 31, b = u >> 7, tok0 = b * SEQ + n * 128; const float lg2 = ret_lg2(h);
        for (int c = F.tid; c < 128 * 32; c += 512) { const int row = c >> 5, ch = c & 31; const bf16_t* src = H5 + (size_t)(tok0 + row) * EIN + 1024 + h * 256 + ch * 8;
            *(LAS u32x4*)(Kt + row * RRS + ch * 16) = *(const u32x4*)src; *(LAS u32x4*)(Vt + row * RRS + ch * 16) = *(const u32x4*)(src + 1024); }
        const int i = 16 * w + r;
        bf16x8 Qf[8];
        { const bf16_t* qp = H5 + (size_t)(tok0 + i) * EIN + h * 256 + 8 * g4;
#pragma unroll
          for (int kk = 0; kk < 8; ++kk) Qf[kk] = *(const bf16x8*)(qp + 32 * kk); }
        __syncthreads();
        u32x2 P[8];
#pragma unroll
        for (int tj = 0; tj < 8; ++tj) {
            P[tj] = (u32x2){0u, 0u};
            if (tj <= w) { f32x4 acc = (f32x4){0.f, 0.f, 0.f, 0.f}; const LAS unsigned char* kp = Kt + (16 * tj + r) * RRS + 16 * g4;
#pragma unroll
                for (int kk = 0; kk < 8; ++kk) acc = mfma16(*(const LAS bf16x8*)(kp + 64 * kk), Qf[kk], acc);
                float pv[4];
#pragma unroll
                for (int jj = 0; jj < 4; ++jj) { const int j = 16 * tj + 4 * g4 + jj; pv[jj] = (i >= j) ? acc[jj] * 0.0625f * __builtin_amdgcn_exp2f(lg2 * (float)(i - j)) : 0.f; }
                P[tj].x = pk2(pv[0], pv[1]); P[tj].y = pk2(pv[2], pv[3]); }
        }
        __syncthreads();
        f32x4 acc[16];
#pragma unroll
        for (int te = 0; te < 16; ++te) acc[te] = (f32x4){0.f, 0.f, 0.f, 0.f};
        if (n > 0) {
#pragma unroll
            for (int half = 0; half < 2; ++half) {
                for (int c = F.tid; c < 128 * 32; c += 512) { const int row = c >> 5, ch = c & 31;
                    *(LAS u32x4*)(Kt + row * RRS + ch * 16) = *(const u32x4*)(PREVT + (size_t)u * 65536 + (size_t)(128 * half + row) * 256 + ch * 8); }
                __syncthreads();
#pragma unroll
                for (int te = 0; te < 8; ++te) { const LAS unsigned char* pq = Kt + (16 * te + r) * RRS + 16 * g4;
#pragma unroll
                    for (int kk = 0; kk < 8; ++kk) acc[8 * half + te] = mfma16(*(const LAS bf16x8*)(pq + 64 * kk), Qf[kk], acc[8 * half + te]);
                    asm volatile("" : "+v"(acc[8 * half + te])); }
                __syncthreads();
            }
            const float xi = __builtin_amdgcn_exp2f(lg2 * (float)(i + 1));
#pragma unroll
            for (int te = 0; te < 16; ++te) acc[te] = acc[te] * xi;
        }
#pragma unroll
        for (int pr = 0; pr < 4; ++pr) {
            if (2 * pr <= w) { const u32x4 bw = (u32x4){P[2 * pr].x, P[2 * pr].y, P[2 * pr + 1].x, P[2 * pr + 1].y}; const bf16x8 bfrag = __builtin_bit_cast(bf16x8, bw);
                const LAS unsigned char* v0 = Vt + (32 * pr + 4 * g4 + qq) * RRS + 8 * pp;
#pragma unroll
                for (int te = 0; te < 16; ++te) { acc[te] = mfma16(cat8(vtr(v0 + 32 * te), vtr(v0 + 16 * RRS + 32 * te)), bfrag, acc[te]); if ((te & 3) == 3) asm volatile("" : "+v"(acc[te])); } }
        }
        float s = 0.f;
#pragma unroll
        for (int te = 0; te < 16; ++te) s += (acc[te][0] + acc[te][1]) + (acc[te][2] + acc[te][3]);
        s += __shfl_xor(s, 16); s += __shfl_xor(s, 32);
        const float mean = s * (1.f / 256.f); float s2 = 0.f;
#pragma unroll
        for (int te = 0; te < 16; ++te) { acc[te] = acc[te] - mean; s2 += (acc[te][0] * acc[te][0] + acc[te][1] * acc[te][1]) + (acc[te][2] * acc[te][2] + acc[te][3] * acc[te][3]); }
        s2 += __shfl_xor(s2, 16); s2 += __shfl_xor(s2, 32);
        const float rstd = 1.0f / sqrtf(s2 * (1.f / 256.f) + LN_EPS);
        const bf16_t* gp = H5 + (size_t)(tok0 + i) * EIN + 3072 + h * 256 + 4 * g4; bf16_t* op = MIX + (size_t)(tok0 + i) * D + h * 256 + 4 * g4;
#pragma unroll
        for (int te = 0; te < 16; ++te) { const u32x2 gw = *(const u32x2*)(gp + 16 * te); float gv[4] = {bflo(gw.x), bfhi(gw.x), bflo(gw.y), bfhi(gw.y)}; float ov[4];
#pragma unroll
            for (int jj = 0; jj < 4; ++jj) { const float sg = gv[jj] / (1.0f + __builtin_amdgcn_exp2f(-gv[jj] * LOG2E)); ov[jj] = sg * acc[te][jj] * rstd; }
            u32x2 o; o.x = pk2(ov[0], ov[1]); o.y = pk2(ov[2], ov[3]); *(u32x2*)(op + 16 * te) = o; }
        __syncthreads();
    }
}

__global__ void __launch_bounds__(512, 2) fwd_megakernel(Args args) {
    extern __shared__ __attribute__((aligned(16))) unsigned char lds_raw[];
    cg::grid_group grid = cg::this_grid();
    Frame F; F.lds = (LAS unsigned char*)lds_raw; F.tid = threadIdx.x; F.lane = F.tid & 63; F.wave = __builtin_amdgcn_readfirstlane(F.tid >> 6); F.G = gridDim.x; F.bid = blockIdx.x;
    unsigned char* ws = args.ws;
    bf16_t* XB = (bf16_t*)(ws + WS_XB); float* Y = (float*)(ws + WS_Y); bf16_t* MIX = (bf16_t*)(ws + WS_MIX);
    bf16_t* HF = (bf16_t*)(ws + WS_HF); bf16_t* ACT = (bf16_t*)(ws + WS_ACT); bf16_t* H5 = (bf16_t*)(ws + WS_H5); bf16_t* QKV = (bf16_t*)(ws + WS_QKV);
    float* KVT = (float*)(ws + WS_KVT); bf16_t* PREVT = (bf16_t*)(ws + WS_PREVT); bf16_t* POOLED = (bf16_t*)(ws + WS_POOLED);
    float* XF = args.out;

    p0_prologue(F, args);
    grid.sync();

    for (int layer = 0; layer < 4; ++layer) {
        const int li = layer >> 1;
        const float* xres = (layer == 0) ? args.in[0] : XF;
        if ((layer & 1) == 0) {
            {
                pg8::Gemm g{XB, (const bf16_t*)(ws + WS_EIN) + (size_t)li * EIN * D, D, D, D, 0}; pg8::StaticOrder S; S.init(M, EIN, F.G, F.bid);
                pg8::EpiBf16 E{H5, EIN, nullptr, nullptr, 0};
                pg8::gemm_phase<pg8::EpiBf16, true>(F.lds, g, S, E);
            }
            grid.sync();
            ret_kv_phase(F, H5, KVT);
            pooled_phase(F, H5, POOLED);
            grid.sync();
            ret_scan_phase(F, KVT, PREVT);
            {
                pg8::Gemm g{POOLED, (const bf16_t*)(ws + WS_POOLW) + (size_t)li * 1024 * 256, 1024, 256, 256, 256}; pg8::StaticOrder S; S.init(M, 1024, F.G, F.bid);
                pg8::EpiBf16 E{MIX, D, nullptr, args.in[5] + (size_t)li * 1024, 1024};
                pg8::gemm_phase<pg8::EpiBf16, true>(F.lds, g, S, E);
            }
            grid.sync();
            ret_out_phase(F, H5, PREVT, MIX);
            grid.sync();
            {
                pg8::Gemm g{MIX, (const bf16_t*)(ws + WS_EOUT) + (size_t)li * D * D, D, D, D, 0}; pg8::StaticOrder S; S.init(M, D, F.G, F.bid);
                pg8::EpiRes E{xres, Y};
                pg8::gemm_phase<pg8::EpiRes, true>(F.lds, g, S, E);
            }
        } else {
            {
                pg8::Gemm g{XB, (const bf16_t*)(ws + WS_QKVW) + (size_t)li * OIN * D, D, D, D, 0}; pg8::StaticOrder S; S.init(M, OIN, F.G, F.bid);
                pg8::EpiBf16 E{QKV, OIN, args.in[8] + (size_t)li * OIN, nullptr, 0};
                pg8::gemm_phase<pg8::EpiBf16, true>(F.lds, g, S, E);
            }
            grid.sync();
            attn_phase(F, QKV, args.in[9] + li * 32, MIX);
            grid.sync();
            {
                pg8::Gemm g{MIX, (const bf16_t*)(ws + WS_AOUT) + (size_t)li * D * D, D, D, D, 0}; pg8::StaticOrder S; S.init(M, D, F.G, F.bid);
                pg8::EpiRes E{xres, Y};
                pg8::gemm_phase<pg8::EpiRes, true>(F.lds, g, S, E);
            }
        }
        grid.sync();
        ln_phase(F, Y, args.in[1] + (size_t)(layer * 2 + 0) * D, args.in[2] + (size_t)(layer * 2 + 0) * D, XF, XB);
        grid.sync();
        {
            pg8::Gemm g{XB, (const bf16_t*)(ws + WS_F1) + (size_t)layer * FF2 * D, D, D, D, 0}; pg8::StaticOrder S; S.init(M, FF2, F.G, F.bid);
            pg8::EpiBf16 E{HF, FF2, nullptr, nullptr, 0};
            pg8::gemm_phase<pg8::EpiBf16, true>(F.lds, g, S, E);
        }
        grid.sync();
        conv_phase(F, HF, args.in[12] + (size_t)layer * 3 * FF2, args.in[13] + (size_t)layer * FF2, ACT);
        grid.sync();
        {
            pg8::Gemm g{ACT, (const bf16_t*)(ws + WS_F2) + (size_t)layer * D * FF, FF, FF, FF, 0}; pg8::StaticOrder S; S.init(M, D, F.G, F.bid);
            pg8::EpiRes E{XF, Y};
            pg8::gemm_phase<pg8::EpiRes, true>(F.lds, g, S, E);
        }
        grid.sync();
        ln_phase(F, Y, args.in[1] + (size_t)(layer * 2 + 1) * D, args.in[2] + (size_t)(layer * 2 + 1) * D, XF, XB);
        grid.sync();
    }
}

extern "C" void kernel_launch(void* const* d_in, const int* in_sizes, int n_in, void* d_out, int out_size, void* d_ws, size_t ws_size, hipStream_t stream) {
    static int grid = 0;
    if (grid == 0) {
        if (n_in != 15 || out_size != M * D || ws_size < WS_END) { fprintf(stderr, "kernel_launch: unexpected problem: n_in %d out %d ws %zu (need %zu)\n", n_in, out_size, ws_size, (size_t)WS_END); grid = -1; return; }
        int dev = 0, cus = 0, per_cu = 0;
        hipGetDevice(&dev); hipDeviceGetAttribute(&cus, hipDeviceAttributeMultiprocessorCount, dev);
        if (hipFuncSetAttribute((const void*)fwd_megakernel, hipFuncAttributeMaxDynamicSharedMemorySize, LDS_BYTES) != hipSuccess) { fprintf(stderr, "kernel_launch: hipFuncSetAttribute failed\n"); grid = -1; return; }
        if (hipOccupancyMaxActiveBlocksPerMultiprocessor(&per_cu, (const void*)fwd_megakernel, 512, LDS_BYTES) != hipSuccess || per_cu < 1) { fprintf(stderr, "kernel_launch: occupancy query says %d\n", per_cu); per_cu = 1; }
        (void)hipGetLastError();
        grid = cus;
    }
    if (grid < 0) return;
    Args a{};
    for (int i = 0; i < 15; ++i) a.in[i] = (const float*)d_in[i];
    a.out = (float*)d_out; a.ws = (unsigned char*)d_ws;
    void* kargs[] = {&a};
    hipError_t e = hipLaunchCooperativeKernel((const void*)fwd_megakernel, dim3(grid), dim3(512), kargs, LDS_BYTES, stream);
    if (e != hipSuccess) fprintf(stderr, "kernel_launch: cooperative launch failed: %s (grid %d)\n", hipGetErrorString(e), grid);
}
```

```cpp
#include <hip/hip_runtime.h>
#include <hip/hip_cooperative_groups.h>
#include <cstdio>
#include <cstdint>
namespace cg = cooperative_groups;

#define LAS __attribute__((address_space(3)))
typedef unsigned short bf16_t;
typedef short bf16x8 __attribute__((ext_vector_type(8)));
typedef short s16x4 __attribute__((ext_vector_type(4)));
typedef float f32x4 __attribute__((ext_vector_type(4)));
typedef float f32x2 __attribute__((ext_vector_type(2)));
typedef unsigned u32x4 __attribute__((ext_vector_type(4)));
typedef unsigned u32x2 __attribute__((ext_vector_type(2)));
typedef __bf16 bf16x2_t __attribute__((ext_vector_type(2)));

constexpr int NBATCH = 4, SEQ = 4096, M = NBATCH * SEQ, D = 2048;
constexpr int EIN = 5120, OIN = 2560, FF = 5632, FF2 = 11264;
constexpr float ALPHA = 1.6817928305074290f;
constexpr float LN_EPS = 1e-5f;
constexpr float LOG2E = 1.4426950408889634f;

constexpr size_t MiB = 1u << 20;
constexpr size_t WS_EIN = 0 * MiB;
constexpr size_t WS_EOUT = 40 * MiB;
constexpr size_t WS_POOLW = 56 * MiB;
constexpr size_t WS_QKVW = 57 * MiB;
constexpr size_t WS_AOUT = 77 * MiB;
constexpr size_t WS_F1 = 93 * MiB;
constexpr size_t WS_F2 = 269 * MiB;
constexpr size_t WS_XB = 357 * MiB;
constexpr size_t WS_Y = 421 * MiB;
constexpr size_t WS_MIX = 549 * MiB;
constexpr size_t WS_BIG = 613 * MiB;
constexpr size_t WS_HF = WS_BIG;
constexpr size_t WS_ACT = WS_BIG + 352 * MiB;
constexpr size_t WS_H5 = WS_BIG;
constexpr size_t WS_QKV = WS_BIG;
constexpr size_t WS_KVT = WS_BIG + 160 * MiB;
constexpr size_t WS_PREVT = WS_BIG + 288 * MiB;
constexpr size_t WS_POOLED = WS_BIG + 352 * MiB;
constexpr size_t WS_CTL = 1141 * MiB;
constexpr size_t CTL_BYTES = 64 * 1024;
constexpr size_t WS_END = 1142 * MiB;
constexpr int MISC_OFF = 143360;

constexpr int LDS_BYTES = 147456;

__device__ __forceinline__ unsigned pk2(float lo, float hi) { f32x2 v = {lo, hi}; bf16x2_t b = __builtin_convertvector(v, bf16x2_t); return __builtin_bit_cast(unsigned, b); }
__device__ __forceinline__ float bflo(unsigned w) { return __uint_as_float(w << 16); }
__device__ __forceinline__ float bfhi(unsigned w) { return __uint_as_float(w & 0xffff0000u); }
__device__ __forceinline__ float wave_sum(float v) {
#pragma unroll
    for (int o = 1; o < 64; o <<= 1) v += __shfl_xor(v, o);
    return v;
}
typedef short v4i16_t __attribute__((ext_vector_type(4)));
__device__ __forceinline__ s16x4 vtr(const LAS unsigned char* p) { return __builtin_bit_cast(s16x4, __builtin_amdgcn_ds_read_tr16_b64_v4i16((LAS v4i16_t*)p)); }
__device__ __forceinline__ bf16x8 cat8(s16x4 lo, s16x4 hi) { return (bf16x8){lo[0], lo[1], lo[2], lo[3], hi[0], hi[1], hi[2], hi[3]}; }
__device__ __forceinline__ f32x4 mfma16(bf16x8 a, bf16x8 b, f32x4 c) { return __builtin_amdgcn_mfma_f32_16x16x32_bf16(a, b, c, 0, 0, 0); }
__device__ __forceinline__ f32x2 gelu_pk(f32x2 v) {
    const f32x2 av = __builtin_elementwise_abs(v), d = av * 0.2316418882f + 1.0f;
    f32x2 t; t.x = __builtin_amdgcn_rcpf(d.x); t.y = __builtin_amdgcn_rcpf(d.y);
    f32x2 q = t * 0.5307027145f + (-0.7265760135f); q = q * t + 0.7107068705f; q = q * t + (-0.142248368f); q = q * t + 0.127414796f; q = q * t;
    const f32x2 s = (v * v) * (-0.72134752044f);
    f32x2 e; e.x = __builtin_amdgcn_exp2f(s.x); e.y = __builtin_amdgcn_exp2f(s.y);
    const f32x2 m = v * (q * e), r = v - m;
    f32x2 o; o.x = v.x < 0.f ? m.x : r.x; o.y = v.y < 0.f ? m.y : r.y; return o;
}

namespace pg8 {
constexpr int BM = 256, BK = 64, HALF = 128, HTB = HALF * BK * 2, STAGE_BYTES = 8 * HTB, NXCD = 8, WGM = 8;
__host__ __device__ __forceinline__ int lds_byte(int r, int c) { const int st = (r >> 4) * 2 + (c >> 5), rr = r & 15, cc = c & 31, ob = rr * 64 + cc * 2; return st * 1024 + (ob ^ (((ob >> 9) & 1) << 5)); }
__host__ __device__ __forceinline__ void stage_rc(int b, int& R, int& C) { const int st = b / 1024, sb = b % 1024, swz = sb ^ (((sb >> 9) & 1) << 5); R = (st >> 1) * 16 + swz / 64; C = (st & 1) * 32 + (swz % 64) / 2; }
__host__ __device__ __forceinline__ int perm32(int rho) { const int n = rho >> 4, i = rho & 15; return 8 * (i >> 2) + 4 * n + (i & 3); }

struct Unit { int pm, pn; };
struct Gemm { const bf16_t* A; const bf16_t* Bt; int lda, ldb, K, a_pn_off; };

struct StaticOrder {
    int nM, nN, nwg, G, c;
    __device__ void init(int M_, int N_, int G_, int c_) { nM = M_ / BM; nN = N_ / BM; nwg = nM * nN; G = G_; c = c_; }
    __device__ bool next(int i, Unit& u) const {
        const long L = (long)i * G + c; if (L >= nwg) return false;
        int wgid = (int)L; { const int q = nwg / NXCD, r = nwg % NXCD, xcd = wgid % NXCD, off = wgid / NXCD; wgid = (xcd < r ? xcd * (q + 1) : r * (q + 1) + (xcd - r) * q) + off; }
        const int nig = WGM * nN, gid = wgid / nig, fm = gid * WGM, gsz = (nM - fm) < WGM ? (nM - fm) : WGM;
        u.pm = fm + ((wgid % nig) % gsz); u.pn = (wgid % nig) / gsz; return true;
    }
};

struct EpiBf16 {
    static constexpr bool PERM = true;
    bf16_t* O; int ldc; const float* bias; const float* scale; int ocol_off;
    __device__ __forceinline__ void operator()(const f32x4 (&acc)[2][2][4][2], const Unit& u, int wr, int wc, int fr, int fq) const {
        const int row0 = u.pm * BM + wr * 64 + fr; const int bcol0 = u.pn * BM + wc * 32 + 8 * fq; const int col0 = ocol_off + bcol0;
        f32x4 bv[2][2], sv[2][2];
#pragma unroll
        for (int bj = 0; bj < 2; ++bj)
#pragma unroll
            for (int n = 0; n < 2; ++n) { bv[bj][n] = bias ? *(const f32x4*)(bias + bcol0 + bj * HALF + 4 * n) : (f32x4){0.f, 0.f, 0.f, 0.f};
                                          sv[bj][n] = scale ? *(const f32x4*)(scale + bcol0 + bj * HALF + 4 * n) : (f32x4){1.f, 1.f, 1.f, 1.f}; }
#pragma unroll
        for (int ai = 0; ai < 2; ++ai)
#pragma unroll
            for (int m = 0; m < 4; ++m) { bf16_t* rowp = O + (size_t)(row0 + ai * HALF + m * 16) * ldc + col0;
#pragma unroll
                for (int bj = 0; bj < 2; ++bj) { f32x4 v0 = (acc[ai][bj][m][0] + bv[bj][0]) * sv[bj][0], v1 = (acc[ai][bj][m][1] + bv[bj][1]) * sv[bj][1];
                    u32x4 w; w.x = pk2(v0[0], v0[1]); w.y = pk2(v0[2], v0[3]); w.z = pk2(v1[0], v1[1]); w.w = pk2(v1[2], v1[3]);
                    *(u32x4*)(rowp + bj * HALF) = w; } }
    }
};
struct EpiRes {
    static constexpr bool PERM = false;
    const float* X; float* Y;
    __device__ __forceinline__ void operator()(const f32x4 (&acc)[2][2][4][2], const Unit& u, int wr, int wc, int fr, int fq) const {
        const int row0 = u.pm * BM + wr * 64 + fr, col0 = u.pn * BM + wc * 32 + 4 * fq;
#pragma unroll
        for (int ai = 0; ai < 2; ++ai)
#pragma unroll
            for (int m = 0; m < 4; ++m) { const size_t off = (size_t)(row0 + ai * HALF + m * 16) * D + col0;
#pragma unroll
                for (int bj = 0; bj < 2; ++bj)
#pragma unroll
                    for (int n = 0; n < 2; ++n) { const f32x4 xv = *(const f32x4*)(X + off + bj * HALF + n * 16); *(f32x4*)(Y + off + bj * HALF + n * 16) = xv * ALPHA + acc[ai][bj][m][n]; }
                asm volatile("" ::: "memory"); }
    }
};

template <class Epi, bool ALIGN_EPI = true>
__device__ __forceinline__ void gemm_phase(LAS unsigned char* lds, const Gemm g, const StaticOrder& S, const Epi& E) {
    int tid = threadIdx.x; asm volatile("" : "+v"(tid));
    const int wid = __builtin_amdgcn_readfirstlane(tid >> 6), lane = tid & 63, wr = wid >> 2, wc = wid & 3, fr = lane & 15, fq = lane >> 4;
    const int K = g.K, nt = K / BK;
    unsigned voffA[2], voffB[2];
#pragma unroll
    for (int i = 0; i < 2; ++i) { int R, C; stage_rc(tid * 16 + i * 8192, R, C); const int Rb = Epi::PERM ? ((R & ~31) + perm32(R & 31)) : R;
        voffA[i] = (unsigned)(R * g.lda + C) * 2u; voffB[i] = (unsigned)(Rb * g.ldb + C) * 2u; }
    const size_t kstep = (size_t)(BK * 2);
    const size_t hA = (size_t)HALF * g.lda * 2, hB = (size_t)HALF * g.ldb * 2;
    const unsigned ldsw = (unsigned)wid * 1024u;
    const int aoff = lds_byte(wr * 64 + fr, fq * 8), boff = lds_byte(wc * 32 + fr, fq * 8);
#define PG8_SA(b, h) (((b) * 2 + (h)) * HTB)
#define PG8_SB(b, h) ((4 + (b) * 2 + (h)) * HTB)
#define PG8_STAGE(bufoff, gbase, voff) do { _Pragma("unroll") for (int _i = 0; _i < 2; ++_i) \
        __builtin_amdgcn_global_load_lds((const unsigned*)((const char*)(gbase) + (voff)[_i]), (LAS unsigned*)(lds + (bufoff) + ldsw + _i * 8192), 16, 0, 0); } while (0)
#define PG8_LDA(dst, b, h) do { _Pragma("unroll") for (int m = 0; m < 4; ++m) _Pragma("unroll") for (int k = 0; k < 2; ++k) dst[m][k] = *(const LAS bf16x8*)(lds + PG8_SA(b, h) + aoff + m * 2048 + k * 1024); } while (0)
#define PG8_LDB(dst, b, h) do { _Pragma("unroll") for (int n = 0; n < 2; ++n) _Pragma("unroll") for (int k = 0; k < 2; ++k) dst[n][k] = *(const LAS bf16x8*)(lds + PG8_SB(b, h) + boff + n * 2048 + k * 1024); } while (0)
#define PG8_MMA(ai, bj, At, Bt) do { __builtin_amdgcn_s_setprio(1); _Pragma("unroll") for (int m = 0; m < 4; ++m) _Pragma("unroll") for (int n = 0; n < 2; ++n) _Pragma("unroll") for (int k = 0; k < 2; ++k) \
        acc[ai][bj][m][n] = __builtin_amdgcn_mfma_f32_16x16x32_bf16(Bt[n][k], At[m][k], acc[ai][bj][m][n], 0, 0, 0); __builtin_amdgcn_s_setprio(0); } while (0)
#define PG8_WAIT_V(n) asm volatile("s_waitcnt vmcnt(" #n ")" ::: "memory")
#define PG8_WAIT_L(n) asm volatile("s_waitcnt lgkmcnt(" #n ")" ::: "memory")
#define PG8_BAR __builtin_amdgcn_s_barrier()
#define PG8_SCHED __builtin_amdgcn_sched_barrier(0)
    Unit cur, nxt; int ui = 0;
    if (!S.next(0, cur)) return;
    f32x4 acc[2][2][4][2];
#pragma unroll
    for (int a = 0; a < 2; ++a)
#pragma unroll
        for (int b = 0; b < 2; ++b)
#pragma unroll
            for (int m = 0; m < 4; ++m)
#pragma unroll
                for (int n = 0; n < 2; ++n) acc[a][b][m][n] = (f32x4){0.f, 0.f, 0.f, 0.f};
    bf16x8 At[4][2], B0[2][2], B1[2][2];
    const char* cA = (const char*)g.A + ((size_t)cur.pm * BM * g.lda + (size_t)cur.pn * g.a_pn_off) * 2; const char* cB = (const char*)g.Bt + (size_t)cur.pn * BM * g.ldb * 2;
    PG8_STAGE(PG8_SB(0, 0), cB, voffB); PG8_STAGE(PG8_SB(0, 1), cB + hB, voffB); PG8_STAGE(PG8_SA(0, 0), cA, voffA); PG8_STAGE(PG8_SA(0, 1), cA + hA, voffA);
    if (wr == 1) PG8_BAR;
    PG8_WAIT_V(2); PG8_BAR;
    PG8_STAGE(PG8_SB(1, 0), cB + kstep, voffB); PG8_STAGE(PG8_SA(1, 0), cA + kstep, voffA); PG8_STAGE(PG8_SB(1, 1), cB + hB + kstep, voffB);
    PG8_WAIT_V(6); PG8_BAR;
    for (;;) {
        const bool has_next = S.next(ui + 1, nxt);
        const char* nA = has_next ? (const char*)g.A + ((size_t)nxt.pm * BM * g.lda + (size_t)nxt.pn * g.a_pn_off) * 2 : cA; const char* nB = has_next ? (const char*)g.Bt + (size_t)nxt.pn * BM * g.ldb * 2 : cB;
        for (int t = 0; t < nt; t += 2) {
            const bool last = (t == nt - 2);
            const char* a1 = cA + (size_t)(t + 1) * kstep;
            const char* a2 = last ? nA : cA + (size_t)(t + 2) * kstep; const char* b2 = last ? nB : cB + (size_t)(t + 2) * kstep;
            const char* a3 = a2 + kstep; const char* b3 = b2 + kstep;
            PG8_LDB(B0, 0, 0); PG8_LDB(B1, 0, 1); PG8_SCHED; PG8_LDA(At, 0, 0); PG8_STAGE(PG8_SA(1, 1), a1 + hA, voffA);
            PG8_WAIT_V(8); PG8_WAIT_L(0); PG8_BAR; PG8_MMA(0, 0, At, B0); PG8_MMA(0, 1, At, B1); PG8_BAR; PG8_SCHED;
            PG8_LDA(At, 0, 1); PG8_STAGE(PG8_SB(0, 0), b2, voffB); PG8_STAGE(PG8_SB(0, 1), b2 + hB, voffB); PG8_STAGE(PG8_SA(0, 0), a2, voffA);
            PG8_WAIT_V(8); PG8_WAIT_L(0); PG8_BAR; PG8_MMA(1, 0, At, B0); PG8_MMA(1, 1, At, B1); PG8_BAR; PG8_SCHED;
            PG8_LDB(B0, 1, 0); PG8_LDB(B1, 1, 1); PG8_SCHED; PG8_LDA(At, 1, 0); PG8_STAGE(PG8_SA(0, 1), a2 + hA, voffA);
            PG8_WAIT_V(8); PG8_WAIT_L(0); PG8_BAR; PG8_MMA(0, 0, At, B0); PG8_MMA(0, 1, At, B1); PG8_BAR; PG8_SCHED;
            PG8_LDA(At, 1, 1); PG8_STAGE(PG8_SB(1, 0), b3, voffB); PG8_STAGE(PG8_SB(1, 1), b3 + hB, voffB); PG8_STAGE(PG8_SA(1, 0), a3, voffA);
            PG8_WAIT_V(8); PG8_WAIT_L(0); PG8_BAR; PG8_MMA(1, 0, At, B0); PG8_MMA(1, 1, At, B1); PG8_BAR; PG8_SCHED;
        }
        if constexpr (ALIGN_EPI) { if (wr == 0) PG8_BAR; }
        E(acc, cur, wr, wc, fr, fq);
        if (!has_next) break;
#pragma unroll
        for (int a = 0; a < 2; ++a)
#pragma unroll
            for (int b = 0; b < 2; ++b)
#pragma unroll
                for (int m = 0; m < 4; ++m)
#pragma unroll
                    for (int n = 0; n < 2; ++n) acc[a][b][m][n] = (f32x4){0.f, 0.f, 0.f, 0.f};
        cur = nxt; cA = nA; cB = nB; ++ui;
        if constexpr (ALIGN_EPI) { if (wr == 1) PG8_BAR; }
    }
    PG8_WAIT_V(0);
    if constexpr (!ALIGN_EPI) { if (wr == 0) PG8_BAR; }
    PG8_BAR;
#undef PG8_SA
#undef PG8_SB
#undef PG8_STAGE
#undef PG8_LDA
#undef PG8_LDB
#undef PG8_MMA
#undef PG8_WAIT_V
#undef PG8_WAIT_L
#undef PG8_BAR
#undef PG8_SCHED
}
}

#define XB_TMO      128
#define XB_XCNT(j)  (256  + 64 * (j))
#define XB_XSUB(j)  (1280 + 64 * (j))
#define XB_XGEN(j)  (2304 + 64 * (j))
#define XB_TOP      3328
#define XB_TOPGEN   3392
#define XCD_BAR_WORDS 3456
#define XB_SPIN_CAP (1u << 22)
__device__ __forceinline__ unsigned xb_ld(unsigned* p)              { return __hip_atomic_load(p, __ATOMIC_RELAXED, __HIP_MEMORY_SCOPE_AGENT); }
__device__ __forceinline__ unsigned xb_add(unsigned* p, unsigned v) { return __hip_atomic_fetch_add(p, v, __ATOMIC_RELAXED, __HIP_MEMORY_SCOPE_AGENT); }
__device__ __forceinline__ unsigned xb_xcc_id() { return (unsigned)__builtin_amdgcn_s_getreg((3 << 11) | 20) & 0xFu; }
#define XB_SPIN(cond, bar) do { unsigned _sp = 0; while (cond) { __builtin_amdgcn_s_sleep(1); \
    if ((++_sp & 255u) == 0u) { if (xb_ld(&(bar)[XB_TMO])) break; if (_sp > XB_SPIN_CAP) { atomicAdd(&(bar)[XB_TMO], 1u); break; } } } } while (0)
struct XcdBarrier { unsigned* bar; unsigned x; volatile LAS unsigned* st; };
__device__ __forceinline__ XcdBarrier xcd_barrier_post(unsigned* bar, volatile LAS unsigned* st) {
    XcdBarrier b; b.bar = bar; b.x = xb_xcc_id(); b.st = st;
    if (threadIdx.x == 0) (void)xb_add(&bar[XB_XCNT(b.x)], 1u);
    return b;
}
__device__ __forceinline__ void xcd_barrier_complete(unsigned* bar, unsigned x, unsigned& nloc, unsigned& nx) {
    const unsigned G = gridDim.x * gridDim.y * gridDim.z;
    unsigned sum, cnt, mine, sp = 0u;
    for (;;) {
        sum = 0u; cnt = 0u; mine = 0u;
#pragma unroll
        for (unsigned j = 0; j < 16; ++j) { const unsigned c = xb_ld(&bar[XB_XCNT(j)]); sum += c; cnt += (c > 0u) ? 1u : 0u; mine = (j == x) ? c : mine; }
        if (sum == G) break;
        __builtin_amdgcn_s_sleep(1);
        if ((++sp & 255u) == 0u) { if (xb_ld(&bar[XB_TMO])) break; if (sp > XB_SPIN_CAP) { atomicAdd(&bar[XB_TMO], 1u); break; } }
    }
    nloc = mine > 0u ? mine : 1u; nx = cnt > 0u ? cnt : 1u;
}
__device__ __forceinline__ void xcd_barrier(const XcdBarrier& b) {
    asm volatile("s_waitcnt vmcnt(0)" ::: "memory");
    __syncthreads();
    if (threadIdx.x == 0) {
        unsigned* bar = b.bar;
        __builtin_amdgcn_s_waitcnt(0);
        unsigned nloc = b.st[0], nx = b.st[1];
        if (nloc == 0u) { xcd_barrier_complete(bar, b.x, nloc, nx); b.st[0] = nloc; b.st[1] = nx; }
        const unsigned old = xb_add(&bar[XB_XSUB(b.x)], 1u);
        const unsigned gen = old / nloc;
        if (old + 1u == (gen + 1u) * nloc) {
            __builtin_amdgcn_fence(__ATOMIC_RELEASE, "agent");
            asm volatile("s_waitcnt vmcnt(0)" ::: "memory");
            const unsigned og = xb_add(&bar[XB_TOP], 1u);
            const unsigned tg = og / nx;
            if (og + 1u == (tg + 1u) * nx) xb_add(&bar[XB_TOPGEN], 1u);
            else XB_SPIN(xb_ld(&bar[XB_TOPGEN]) == tg, bar);
            __builtin_amdgcn_fence(__ATOMIC_ACQUIRE, "agent");
            xb_add(&bar[XB_XGEN(b.x)], 1u);
            asm volatile("s_waitcnt vmcnt(0)" ::: "memory");
        } else {
            XB_SPIN(xb_ld(&bar[XB_XGEN(b.x)]) == gen, bar);
            __builtin_amdgcn_fence(__ATOMIC_ACQUIRE, "agent");
            asm volatile("s_waitcnt vmcnt(0)" ::: "memory");
        }
    }
    __syncthreads();
}

struct Args { const float* in[15]; float* out; unsigned char* ws; };
struct Frame { LAS unsigned char* lds; int tid, lane, wave, G, bid; };
__device__ __forceinline__ Frame relaunder(const Frame& F0) { Frame F = F0; int t = F0.tid; asm volatile("" : "+v"(t)); F.tid = t; F.lane = t & 63; F.wave = __builtin_amdgcn_readfirstlane(t >> 6); return F; }

__device__ __forceinline__ void p0_item(const float* W, int K, int N, bf16_t* WT, int row_off, bool permff, LAS float* scr, int item, int lane) {
    const int nblk = N >> 6, kb = item / nblk, nb = item - kb * nblk, k0 = kb << 6, n0 = nb << 6;
    const float* src = W + (size_t)k0 * N + n0 + lane;
#pragma unroll 16
    for (int kk = 0; kk < 64; ++kk) scr[kk * 65 + lane] = src[(size_t)kk * N];
    asm volatile("s_waitcnt lgkmcnt(0)" ::: "memory");
    int orow0 = row_off + n0;
    if (permff) { orow0 = (n0 < FF) ? ((n0 >> 7) * 256 + (n0 & 127)) : (((n0 - FF) >> 7) * 256 + 128 + ((n0 - FF) & 127)); }
#pragma unroll
    for (int j = 0; j < 8; ++j) { const int id = lane + 64 * j, n = id >> 3, c = id & 7; const LAS float* s = scr + (8 * c) * 65 + n;
        u32x4 o; o.x = pk2(s[0 * 65], s[1 * 65]); o.y = pk2(s[2 * 65], s[3 * 65]); o.z = pk2(s[4 * 65], s[5 * 65]); o.w = pk2(s[6 * 65], s[7 * 65]);
        *(u32x4*)(WT + (size_t)(orow0 + n) * K + k0 + 8 * c) = o; }
    asm volatile("s_waitcnt lgkmcnt(0)" ::: "memory");
}
__device__ __forceinline__ void p0_prologue(const Frame& F0, const Args& a) {
    const Frame F = relaunder(F0);
    LAS float* scr = (LAS float*)(F.lds + F.wave * 16640);
    const int gw = F.bid * 8 + F.wave, NGW = F.G * 8;
    unsigned char* ws = a.ws;
    constexpr int I_EIN = (D / 64) * (EIN / 64), I_SQ = (D / 64) * (D / 64), I_PW = 16, I_QKV = (D / 64) * (OIN / 64), I_F1 = (D / 64) * (FF2 / 64), I_F2 = (FF / 64) * (D / 64);
    constexpr int T0 = 2 * I_EIN, T1 = T0 + 2 * I_SQ, T2 = T1 + 8 * I_PW, T3 = T2 + 2 * I_QKV, T4 = T3 + 2 * I_SQ, T5 = T4 + 4 * I_F1, T6 = T5 + 4 * I_F2;
    for (int it = gw; it < T6; it += NGW) {
        if (it < T0) { const int li = it / I_EIN, r = it - li * I_EIN; p0_item(a.in[3] + (size_t)li * D * EIN, D, EIN, (bf16_t*)(ws + WS_EIN) + (size_t)li * EIN * D, 0, false, scr, r, F.lane); }
        else if (it < T1) { const int x = it - T0, li = x / I_SQ, r = x - li * I_SQ; p0_item(a.in[6] + (size_t)li * D * D, D, D, (bf16_t*)(ws + WS_EOUT) + (size_t)li * D * D, 0, false, scr, r, F.lane); }
        else if (it < T2) { const int x = it - T1, lg = x / I_PW, r = x - lg * I_PW, li = lg >> 2, g = lg & 3; p0_item(a.in[4] + (size_t)lg * 65536, 256, 256, (bf16_t*)(ws + WS_POOLW) + (size_t)li * 1024 * 256, g * 256, false, scr, r, F.lane); }
        else if (it < T3) { const int x = it - T2, li = x / I_QKV, r = x - li * I_QKV; p0_item(a.in[7] + (size_t)li * D * OIN, D, OIN, (bf16_t*)(ws + WS_QKVW) + (size_t)li * OIN * D, 0, false, scr, r, F.lane); }
        else if (it < T4) { const int x = it - T3, li = x / I_SQ, r = x - li * I_SQ; p0_item(a.in[10] + (size_t)li * D * D, D, D, (bf16_t*)(ws + WS_AOUT) + (size_t)li * D * D, 0, false, scr, r, F.lane); }
        else if (it < T5) { const int x = it - T4, l = x / I_F1, r = x - l * I_F1; p0_item(a.in[11] + (size_t)l * D * FF2, D, FF2, (bf16_t*)(ws + WS_F1) + (size_t)l * FF2 * D, 0, true, scr, r, F.lane); }
        else { const int x = it - T5, l = x / I_F2, r = x - l * I_F2; p0_item(a.in[14] + (size_t)l * FF * D, FF, D, (bf16_t*)(ws + WS_F2) + (size_t)l * D * FF, 0, false, scr, r, F.lane); }
    }
    const f32x4* x4 = (const f32x4*)a.in[0]; u32x2* xb = (u32x2*)(ws + WS_XB);
    for (size_t i = (size_t)F.bid * 512 + F.tid; i < (size_t)M * D / 4; i += (size_t)F.G * 512) { const f32x4 v = x4[i]; u32x2 o; o.x = pk2(v[0], v[1]); o.y = pk2(v[2], v[3]); xb[i] = o; }
}

__device__ __forceinline__ void ln_phase(const Frame& F0, const float* Y, const float* g, const float* b, float* XF, bf16_t* XB) {
    const Frame F = relaunder(F0);
    const int gw = F.bid * 8 + F.wave, NGW = F.G * 8;
    for (int row = gw; row < M; row += NGW) {
        const f32x4* yr = (const f32x4*)(Y + (size_t)row * D) + F.lane;
        f32x4 v[8]; float s = 0.f;
#pragma unroll
        for (int j = 0; j < 8; ++j) { v[j] = yr[64 * j]; s += (v[j][0] + v[j][1]) + (v[j][2] + v[j][3]); }
        const float mean = wave_sum(s) * (1.f / D); float s2 = 0.f;
#pragma unroll
        for (int j = 0; j < 8; ++j) { v[j] = v[j] - mean; s2 += (v[j][0] * v[j][0] + v[j][1] * v[j][1]) + (v[j][2] * v[j][2] + v[j][3] * v[j][3]); }
        const float rstd = 1.0f / sqrtf(wave_sum(s2) * (1.f / D) + LN_EPS);
        f32x4* xo = (f32x4*)(XF + (size_t)row * D) + F.lane; u32x2* bo = (u32x2*)(XB + (size_t)row * D) + F.lane;
#pragma unroll
        for (int j = 0; j < 8; ++j) { const f32x4 gg = ((const f32x4*)g)[F.lane + 64 * j], bb = ((const f32x4*)b)[F.lane + 64 * j];
            const f32x4 o = v[j] * rstd * gg + bb; xo[64 * j] = o; u32x2 w; w.x = pk2(o[0], o[1]); w.y = pk2(o[2], o[3]); bo[64 * j] = w; }
    }
}

__device__ __forceinline__ void conv_phase(const Frame& F0, const bf16_t* HF, const float* cw, const float* cb, bf16_t* ACT) {
    const Frame F = relaunder(F0);
    constexpr int NCG = FF / 8, RUN = 32, NRUN = M / RUN;
    for (int it = F.bid * 512 + F.tid; it < NRUN * NCG; it += F.G * 512) {
        const int cgi = it % NCG, run = it / NCG, c = cgi * 8, hg = (c >> 7) * 256 + (c & 127);
        const int t0 = run * RUN, p0 = t0 & (SEQ - 1);
        float wg[3][8], wv[3][8], bg[8], bv[8];
#pragma unroll
        for (int k = 0; k < 3; ++k)
#pragma unroll
            for (int e = 0; e < 8; ++e) { wg[k][e] = cw[(size_t)k * FF2 + c + e]; wv[k][e] = cw[(size_t)k * FF2 + FF + c + e]; }
#pragma unroll
        for (int e = 0; e < 8; ++e) { bg[e] = cb[c + e]; bv[e] = cb[FF + c + e]; }
        float g2[8], g1[8], v2[8], v1[8];
#pragma unroll
        for (int e = 0; e < 8; ++e) { g2[e] = 0.f; g1[e] = 0.f; v2[e] = 0.f; v1[e] = 0.f; }
        if (p0 > 0) {
            const u32x4 a2 = *(const u32x4*)(HF + (size_t)(t0 - 2) * FF2 + hg), a1 = *(const u32x4*)(HF + (size_t)(t0 - 1) * FF2 + hg);
            const u32x4 b2 = *(const u32x4*)(HF + (size_t)(t0 - 2) * FF2 + hg + 128), b1 = *(const u32x4*)(HF + (size_t)(t0 - 1) * FF2 + hg + 128);
#pragma unroll
            for (int e = 0; e < 4; ++e) { g2[2 * e] = bflo(a2[e]); g2[2 * e + 1] = bfhi(a2[e]); g1[2 * e] = bflo(a1[e]); g1[2 * e + 1] = bfhi(a1[e]);
                                          v2[2 * e] = bflo(b2[e]); v2[2 * e + 1] = bfhi(b2[e]); v1[2 * e] = bflo(b1[e]); v1[2 * e + 1] = bfhi(b1[e]); }
        }
        for (int k = 0; k < RUN; ++k) {
            const int t = t0 + k;
            const u32x4 a0 = *(const u32x4*)(HF + (size_t)t * FF2 + hg), b0 = *(const u32x4*)(HF + (size_t)t * FF2 + hg + 128);
            float g0[8], v0[8];
#pragma unroll
            for (int e = 0; e < 4; ++e) { g0[2 * e] = bflo(a0[e]); g0[2 * e + 1] = bfhi(a0[e]); v0[2 * e] = bflo(b0[e]); v0[2 * e + 1] = bfhi(b0[e]); }
            u32x4 o;
#pragma unroll
            for (int e = 0; e < 4; ++e) {
                f32x2 gc, vc;
                gc.x = bg[2 * e] + wg[0][2 * e] * g2[2 * e] + wg[1][2 * e] * g1[2 * e] + wg[2][2 * e] * g0[2 * e];
                gc.y = bg[2 * e + 1] + wg[0][2 * e + 1] * g2[2 * e + 1] + wg[1][2 * e + 1] * g1[2 * e + 1] + wg[2][2 * e + 1] * g0[2 * e + 1];
                vc.x = bv[2 * e] + wv[0][2 * e] * v2[2 * e] + wv[1][2 * e] * v1[2 * e] + wv[2][2 * e] * v0[2 * e];
                vc.y = bv[2 * e + 1] + wv[0][2 * e + 1] * v2[2 * e + 1] + wv[1][2 * e + 1] * v1[2 * e + 1] + wv[2][2 * e + 1] * v0[2 * e + 1];
                const f32x2 ge = gelu_pk(gc);
                o[e] = pk2(ge.x * vc.x, ge.y * vc.y);
            }
            *(u32x4*)(ACT + (size_t)t * FF + c) = o;
#pragma unroll
            for (int e = 0; e < 8; ++e) { g2[e] = g1[e]; g1[e] = g0[e]; v2[e] = v1[e]; v1[e] = v0[e]; }
        }
    }
}

__device__ __forceinline__ void attn_phase(const Frame& F0, const bf16_t* QKV, const float* sinks, bf16_t* MIX) {
    const Frame F = relaunder(F0);
    constexpr int RS = 144;
    LAS unsigned char* Kt = F.lds; LAS unsigned char* Vt = F.lds + 256 * RS;
    const int lane = F.lane, r = lane & 15, g4 = lane >> 4, qq = r >> 2, pp = r & 3;
    for (int u = F.bid; u < 512; u += F.G) {
        const int kvh = u & 3, n = (u >> 2) & 31, b = u >> 7, tok0 = b * SEQ + n * 128;
        for (int c = F.tid; c < 256 * 8; c += 512) { const int row = c >> 3, ch = c & 7; const bool valid = (n > 0) || (row >= 128);
            u32x4 kv = (u32x4){0u, 0u, 0u, 0u}, vv = kv;
            if (valid) { const bf16_t* src = QKV + (size_t)(tok0 - 128 + row) * OIN + 2048 + kvh * 64 + ch * 8; kv = *(const u32x4*)src; vv = *(const u32x4*)(src + 256); }
            *(LAS u32x4*)(Kt + row * RS + ch * 16) = kv; *(LAS u32x4*)(Vt + row * RS + ch * 16) = vv; }
        __syncthreads();
        const int head = kvh * 8 + F.wave;
        const float slope2 = __builtin_amdgcn_exp2f(-0.25f * (float)(head + 1)) * LOG2E, sink2 = sinks[head] * LOG2E;
        for (int rb = 0; rb < 8; ++rb) {
            const bf16_t* qp = QKV + (size_t)(tok0 + 16 * rb + r) * OIN + head * 64 + 8 * g4;
            const bf16x8 q0 = *(const bf16x8*)qp, q1 = *(const bf16x8*)(qp + 32);
            f32x4 s[9];
#pragma unroll
            for (int tt = 0; tt < 9; ++tt) { const LAS unsigned char* kp = Kt + (16 * (rb + tt) + r) * RS + 16 * g4;
                f32x4 acc = (f32x4){0.f, 0.f, 0.f, 0.f};
                acc = mfma16(*(const LAS bf16x8*)kp, q0, acc); acc = mfma16(*(const LAS bf16x8*)(kp + 64), q1, acc); s[tt] = acc; }
            const int i = 16 * rb + r; float mx = -INFINITY;
#pragma unroll
            for (int tt = 0; tt < 9; ++tt)
#pragma unroll
                for (int jj = 0; jj < 4; ++jj) { const int j = 16 * (rb + tt) + 4 * g4 + jj, delta = 128 + i - j; const bool valid = (delta >= 0) && (delta < 128) && ((n > 0) || (j >= 128));
                    const float v = s[tt][jj] * (0.125f * LOG2E) - slope2 * (float)delta; s[tt][jj] = valid ? v : -INFINITY; mx = fmaxf(mx, s[tt][jj]); }
            mx = fmaxf(mx, __shfl_xor(mx, 16)); mx = fmaxf(mx, __shfl_xor(mx, 32)); mx = fmaxf(mx, sink2);
            float sum = 0.f;
#pragma unroll
            for (int tt = 0; tt < 9; ++tt)
#pragma unroll
                for (int jj = 0; jj < 4; ++jj) { const float p = __builtin_amdgcn_exp2f(s[tt][jj] - mx); s[tt][jj] = p; sum += p; }
            sum += __shfl_xor(sum, 16); sum += __shfl_xor(sum, 32);
            const float inv = 1.0f / (sum + __builtin_amdgcn_exp2f(sink2 - mx));
            u32x2 P[10];
#pragma unroll
            for (int tt = 0; tt < 9; ++tt) { P[tt].x = pk2(s[tt][0] * inv, s[tt][1] * inv); P[tt].y = pk2(s[tt][2] * inv, s[tt][3] * inv); }
            P[9] = (u32x2){0u, 0u};
            f32x4 o[4];
#pragma unroll
            for (int te = 0; te < 4; ++te) o[te] = (f32x4){0.f, 0.f, 0.f, 0.f};
#pragma unroll
            for (int pr = 0; pr < 5; ++pr) { const int t0 = 2 * pr, t1 = (pr < 4) ? 2 * pr + 1 : 2 * pr;
                const u32x4 bw = (u32x4){P[t0].x, P[t0].y, P[2 * pr + 1].x, P[2 * pr + 1].y}; const bf16x8 bfrag = __builtin_bit_cast(bf16x8, bw);
                const LAS unsigned char* v0 = Vt + (16 * (rb + t0) + 4 * g4 + qq) * RS + 8 * pp; const LAS unsigned char* v1 = Vt + (16 * (rb + t1) + 4 * g4 + qq) * RS + 8 * pp;
#pragma unroll
                for (int te = 0; te < 4; ++te) o[te] = mfma16(cat8(vtr(v0 + 32 * te), vtr(v1 + 32 * te)), bfrag, o[te]); }
            bf16_t* op = MIX + (size_t)(tok0 + i) * D + head * 64 + 4 * g4;
#pragma unroll
            for (int te = 0; te < 4; ++te) { u32x2 w; w.x = pk2(o[te][0], o[te][1]); w.y = pk2(o[te][2], o[te][3]); *(u32x2*)(op + 16 * te) = w; }
        }
        __syncthreads();
    }
}

__device__ __forceinline__ float ret_lg2(int h) { return __builtin_amdgcn_logf(1.0f - __builtin_amdgcn_exp2f(-5.0f - (float)h)); }
constexpr int RRS = 528;

__device__ __forceinline__ void ret_kv_phase(const Frame& F0, const bf16_t* H5, float* KVT) {
    const Frame F = relaunder(F0);
    LAS unsigned char* Kt = F.lds; LAS unsigned char* Vt = F.lds + 128 * RRS;
    const int lane = F.lane, r = lane & 15, g4 = lane >> 4, qq = r >> 2, pp = r & 3, w = F.wave;
    for (int u = F.bid; u < 512; u += F.G) {
        const int h = u & 3, n = (u >> 2) & 31, b = u >> 7, tok0 = b * SEQ + n * 128; const float lg2 = ret_lg2(h);
        for (int c = F.tid; c < 128 * 32; c += 512) { const int row = c >> 5, ch = c & 31; const bf16_t* src = H5 + (size_t)(tok0 + row) * EIN + 1024 + h * 256 + ch * 8;
            const u32x4 kv = *(const u32x4*)src, vv = *(const u32x4*)(src + 1024); const float z = __builtin_amdgcn_exp2f(lg2 * (float)(127 - row)) * 0.0625f;
            u32x4 ks;
#pragma unroll
            for (int e = 0; e < 4; ++e) ks[e] = pk2(bflo(kv[e]) * z, bfhi(kv[e]) * z);
            *(LAS u32x4*)(Kt + row * RRS + ch * 16) = ks; *(LAS u32x4*)(Vt + row * RRS + ch * 16) = vv; }
        __syncthreads();
        for (int dh = 0; dh < 2; ++dh) {
            f32x4 acc[2][8];
#pragma unroll
            for (int a = 0; a < 2; ++a)
#pragma unroll
                for (int d = 0; d < 8; ++d) acc[a][d] = (f32x4){0.f, 0.f, 0.f, 0.f};
#pragma unroll
            for (int ks = 0; ks < 4; ++ks) { const int R0 = 32 * ks + 8 * g4 + qq;
                const LAS unsigned char* vb = Vt + R0 * RRS + 8 * pp; const LAS unsigned char* kb = Kt + R0 * RRS + 8 * pp + 256 * dh;
                const bf16x8 vf0 = cat8(vtr(vb + 64 * w), vtr(vb + 4 * RRS + 64 * w)), vf1 = cat8(vtr(vb + 64 * w + 32), vtr(vb + 4 * RRS + 64 * w + 32));
#pragma unroll
                for (int dt = 0; dt < 8; ++dt) { const bf16x8 kf = cat8(vtr(kb + 32 * dt), vtr(kb + 4 * RRS + 32 * dt)); acc[0][dt] = mfma16(kf, vf0, acc[0][dt]); acc[1][dt] = mfma16(kf, vf1, acc[1][dt]); } }
            float* op = KVT + (size_t)u * 65536 + (size_t)(32 * w + r) * 256 + 128 * dh + 4 * g4;
#pragma unroll
            for (int a = 0; a < 2; ++a)
#pragma unroll
                for (int dt = 0; dt < 8; ++dt) *(f32x4*)(op + a * 16 * 256 + 16 * dt) = acc[a][dt];
        }
        __syncthreads();
    }
}
__device__ __forceinline__ void pooled_phase(const Frame& F0, const bf16_t* H5, bf16_t* PO) {
    const Frame F = relaunder(F0);
    for (int it = F.bid * 512 + F.tid; it < 1024 * 128; it += F.G * 512) {
        const int cgp = it & 127, run = it >> 7, c = cgp * 8, w = 2 << (c >> 8), t0 = run * 16, p0 = t0 & (SEQ - 1);
        const bf16_t* U = H5 + 4096 + c;
        float S[8];
#pragma unroll
        for (int e = 0; e < 8; ++e) S[e] = 0.f;
        for (int s = 1; s < w; ++s) if (p0 - s >= 0) { const u32x4 x = *(const u32x4*)(U + (size_t)(t0 - s) * EIN);
#pragma unroll
            for (int e = 0; e < 4; ++e) { S[2 * e] += bflo(x[e]); S[2 * e + 1] += bfhi(x[e]); } }
        for (int k = 0; k < 16; ++k) { const int t = t0 + k, p = p0 + k; const u32x4 x = *(const u32x4*)(U + (size_t)t * EIN);
            const float rc = 1.0f / (float)((p + 1 < w) ? p + 1 : w); u32x4 o;
#pragma unroll
            for (int e = 0; e < 4; ++e) { const float a0 = bflo(x[e]), a1 = bfhi(x[e]); S[2 * e] += a0; S[2 * e + 1] += a1; o[e] = pk2(S[2 * e] * rc - a0, S[2 * e + 1] * rc - a1); }
            *(u32x4*)(PO + (size_t)t * 1024 + c) = o;
            if (p - (w - 1) >= 0) { const u32x4 y = *(const u32x4*)(U + (size_t)(t - (w - 1)) * EIN);
#pragma unroll
                for (int e = 0; e < 4; ++e) { S[2 * e] -= bflo(y[e]); S[2 * e + 1] -= bfhi(y[e]); } }
        }
    }
}
__device__ __forceinline__ void ret_scan_phase(const Frame& F0, const float* KVT, bf16_t* PREVT) {
    const Frame F = relaunder(F0);
    for (int it = F.bid * 512 + F.tid; it < 16 * 16384; it += F.G * 512) {
        const int bh = it >> 14, e4 = it & 16383, b = bh >> 2, h = bh & 3; const float cd = __builtin_amdgcn_exp2f(ret_lg2(h) * 128.0f);
        f32x4 st = (f32x4){0.f, 0.f, 0.f, 0.f};
#pragma unroll 4
        for (int n = 0; n < 31; ++n) { const size_t u = (size_t)((b * 32 + n) * 4 + h);
            st = st * cd + *(const f32x4*)(KVT + u * 65536 + (size_t)e4 * 4);
            u32x2 o; o.x = pk2(st[0], st[1]); o.y = pk2(st[2], st[3]); *(u32x2*)(PREVT + (u + 4) * 65536 + (size_t)e4 * 4) = o; }
    }
}
__device__ __forceinline__ void ret_out_phase(const Frame& F0, const bf16_t* H5, const bf16_t* PREVT, bf16_t* MIX) {
    const Frame F = relaunder(F0);
    LAS unsigned char* Kt = F.lds; LAS unsigned char* Vt = F.lds + 128 * RRS;
    const int lane = F.lane, r = lane & 15, g4 = lane >> 4, qq = r >> 2, pp = r & 3, w = F.wave;
    for (int u = F.bid; u < 512; u += F.G) {
        const int h = u & 3, n = (u >> 2) & 31, b = u >> 7, tok0 = b * SEQ + n * 128; const float lg2 = ret_lg2(h);
        for (int c = F.tid; c < 128 * 32; c += 512) { const int row = c >> 5, ch = c & 31; const bf16_t* src = H5 + (size_t)(tok0 + row) * EIN + 1024 + h * 256 + ch * 8;
            *(LAS u32x4*)(Kt + row * RRS + ch * 16) = *(const u32x4*)src; *(LAS u32x4*)(Vt + row * RRS + ch * 16) = *(const u32x4*)(src + 1024); }
        const int i = 16 * w + r;
        bf16x8 Qf[8];
        { const bf16_t* qp = H5 + (size_t)(tok0 + i) * EIN + h * 256 + 8 * g4;
#pragma unroll
          for (int kk = 0; kk < 8; ++kk) Qf[kk] = *(const bf16x8*)(qp + 32 * kk); }
        __syncthreads();
        u32x2 P[8];
#pragma unroll
        for (int tj = 0; tj < 8; ++tj) {
            P[tj] = (u32x2){0u, 0u};
            if (tj <= w) { f32x4 acc = (f32x4){0.f, 0.f, 0.f, 0.f}; const LAS unsigned char* kp = Kt + (16 * tj + r) * RRS + 16 * g4;
#pragma unroll
                for (int kk = 0; kk < 8; ++kk) acc = mfma16(*(const LAS bf16x8*)(kp + 64 * kk), Qf[kk], acc);
                float pv[4];
#pragma unroll
                for (int jj = 0; jj < 4; ++jj) { const int j = 16 * tj + 4 * g4 + jj; pv[jj] = (i >= j) ? acc[jj] * 0.0625f * __builtin_amdgcn_exp2f(lg2 * (float)(i - j)) : 0.f; }
                P[tj].x = pk2(pv[0], pv[1]); P[tj].y = pk2(pv[2], pv[3]); }
        }
        __syncthreads();
        f32x4 acc[16];
#pragma unroll
        for (int te = 0; te < 16; ++te) acc[te] = (f32x4){0.f, 0.f, 0.f, 0.f};
        if (n > 0) {
#pragma unroll
            for (int half = 0; half < 2; ++half) {
                for (int c = F.tid; c < 128 * 32; c += 512) { const int row = c >> 5, ch = c & 31;
                    *(LAS u32x4*)(Kt + row * RRS + ch * 16) = *(const u32x4*)(PREVT + (size_t)u * 65536 + (size_t)(128 * half + row) * 256 + ch * 8); }
                __syncthreads();
#pragma unroll
                for (int te = 0; te < 8; ++te) { const LAS unsigned char* pq = Kt + (16 * te + r) * RRS + 16 * g4;
#pragma unroll
                    for (int kk = 0; kk < 8; ++kk) acc[8 * half + te] = mfma16(*(const LAS bf16x8*)(pq + 64 * kk), Qf[kk], acc[8 * half + te]);
                    asm volatile("" : "+v"(acc[8 * half + te])); }
                __syncthreads();
            }
            const float xi = __builtin_amdgcn_exp2f(lg2 * (float)(i + 1));
#pragma unroll
            for (int te = 0; te < 16; ++te) acc[te] = acc[te] * xi;
        }
#pragma unroll
        for (int pr = 0; pr < 4; ++pr) {
            if (2 * pr <= w) { const u32x4 bw = (u32x4){P[2 * pr].x, P[2 * pr].y, P[2 * pr + 1].x, P[2 * pr + 1].y}; const bf16x8 bfrag = __builtin_bit_cast(bf16x8, bw);
                const LAS unsigned char* v0 = Vt + (32 * pr + 4 * g4 + qq) * RRS + 8 * pp;
#pragma unroll
                for (int te = 0; te < 16; ++te) { acc[te] = mfma16(cat8(vtr(v0 + 32 * te), vtr(v0 + 16 * RRS + 32 * te)), bfrag, acc[te]); if ((te & 3) == 3) asm volatile("" : "+v"(acc[te])); } }
        }
        float s = 0.f;
#pragma unroll
        for (int te = 0; te < 16; ++te) s += (acc[te][0] + acc[te][1]) + (acc[te][2] + acc[te][3]);
        s += __shfl_xor(s, 16); s += __shfl_xor(s, 32);
        const float mean = s * (1.f / 256.f); float s2 = 0.f;
#pragma unroll
        for (int te = 0; te < 16; ++te) { acc[te] = acc[te] - mean; s2 += (acc[te][0] * acc[te][0] + acc[te][1] * acc[te][1]) + (acc[te][2] * acc[te][2] + acc[te][3] * acc[te][3]); }
        s2 += __shfl_xor(s2, 16); s2 += __shfl_xor(s2, 32);
        const float rstd = 1.0f / sqrtf(s2 * (1.f / 256.f) + LN_EPS);
        const bf16_t* gp = H5 + (size_t)(tok0 + i) * EIN + 3072 + h * 256 + 4 * g4; bf16_t* op = MIX + (size_t)(tok0 + i) * D + h * 256 + 4 * g4;
#pragma unroll
        for (int te = 0; te < 16; ++te) { const u32x2 gw = *(const u32x2*)(gp + 16 * te); float gv[4] = {bflo(gw.x), bfhi(gw.x), bflo(gw.y), bfhi(gw.y)}; float ov[4];
#pragma unroll
            for (int jj = 0; jj < 4; ++jj) { const float sg = gv[jj] / (1.0f + __builtin_amdgcn_exp2f(-gv[jj] * LOG2E)); ov[jj] = sg * acc[te][jj] * rstd; }
            u32x2 o; o.x = pk2(ov[0], ov[1]); o.y = pk2(ov[2], ov[3]); *(u32x2*)(op + 16 * te) = o; }
        __syncthreads();
    }
}

__global__ void __launch_bounds__(512, 2) fwd_megakernel(Args args) {
    extern __shared__ __attribute__((aligned(16))) unsigned char lds_raw[];
    cg::grid_group grid = cg::this_grid();
    Frame F; F.lds = (LAS unsigned char*)lds_raw; F.tid = threadIdx.x; F.lane = F.tid & 63; F.wave = __builtin_amdgcn_readfirstlane(F.tid >> 6); F.G = gridDim.x; F.bid = blockIdx.x;
    unsigned char* ws = args.ws;
    bf16_t* XB = (bf16_t*)(ws + WS_XB); float* Y = (float*)(ws + WS_Y); bf16_t* MIX = (bf16_t*)(ws + WS_MIX);
    bf16_t* HF = (bf16_t*)(ws + WS_HF); bf16_t* ACT = (bf16_t*)(ws + WS_ACT); bf16_t* H5 = (bf16_t*)(ws + WS_H5); bf16_t* QKV = (bf16_t*)(ws + WS_QKV);
    float* KVT = (float*)(ws + WS_KVT); bf16_t* PREVT = (bf16_t*)(ws + WS_PREVT); bf16_t* POOLED = (bf16_t*)(ws + WS_POOLED);
    float* XF = args.out;

    for (int u = F.tid; u < (LDS_BYTES - MISC_OFF) / 4; u += 512) ((LAS unsigned*)(F.lds + MISC_OFF))[u] = 0u;
    __syncthreads();
    const XcdBarrier bar = xcd_barrier_post((unsigned*)(ws + WS_CTL), (volatile LAS unsigned*)(F.lds + MISC_OFF));
#define GRID_BAR() xcd_barrier(bar)

    p0_prologue(F, args);
    grid.sync();

    for (int layer = 0; layer < 4; ++layer) {
        const int li = layer >> 1;
        const float* xres = (layer == 0) ? args.in[0] : XF;
        if ((layer & 1) == 0) {
            {
                pg8::Gemm g{XB, (const bf16_t*)(ws + WS_EIN) + (size_t)li * EIN * D, D, D, D, 0}; pg8::StaticOrder S; S.init(M, EIN, F.G, F.bid);
                pg8::EpiBf16 E{H5, EIN, nullptr, nullptr, 0};
                pg8::gemm_phase<pg8::EpiBf16, true>(F.lds, g, S, E);
            }
            GRID_BAR();
            ret_kv_phase(F, H5, KVT);
            pooled_phase(F, H5, POOLED);
            GRID_BAR();
            ret_scan_phase(F, KVT, PREVT);
            {
                pg8::Gemm g{POOLED, (const bf16_t*)(ws + WS_POOLW) + (size_t)li * 1024 * 256, 1024, 256, 256, 256}; pg8::StaticOrder S; S.init(M, 1024, F.G, F.bid);
                pg8::EpiBf16 E{MIX, D, nullptr, args.in[5] + (size_t)li * 1024, 1024};
                pg8::gemm_phase<pg8::EpiBf16, true>(F.lds, g, S, E);
            }
            GRID_BAR();
            ret_out_phase(F, H5, PREVT, MIX);
            GRID_BAR();
            {
                pg8::Gemm g{MIX, (const bf16_t*)(ws + WS_EOUT) + (size_t)li * D * D, D, D, D, 0}; pg8::StaticOrder S; S.init(M, D, F.G, F.bid);
                pg8::EpiRes E{xres, Y};
                pg8::gemm_phase<pg8::EpiRes, true>(F.lds, g, S, E);
            }
        } else {
            {
                pg8::Gemm g{XB, (const bf16_t*)(ws + WS_QKVW) + (size_t)li * OIN * D, D, D, D, 0}; pg8::StaticOrder S; S.init(M, OIN, F.G, F.bid);
                pg8::EpiBf16 E{QKV, OIN, args.in[8] + (size_t)li * OIN, nullptr, 0};
                pg8::gemm_phase<pg8::EpiBf16, true>(F.lds, g, S, E);
            }
            GRID_BAR();
            attn_phase(F, QKV, args.in[9] + li * 32, MIX);
            GRID_BAR();
            {
                pg8::Gemm g{MIX, (const bf16_t*)(ws + WS_AOUT) + (size_t)li * D * D, D, D, D, 0}; pg8::StaticOrder S; S.init(M, D, F.G, F.bid);
                pg8::EpiRes E{xres, Y};
                pg8::gemm_phase<pg8::EpiRes, true>(F.lds, g, S, E);
            }
        }
        GRID_BAR();
        ln_phase(F, Y, args.in[1] + (size_t)(layer * 2 + 0) * D, args.in[2] + (size_t)(layer * 2 + 0) * D, XF, XB);
        GRID_BAR();
        {
            pg8::Gemm g{XB, (const bf16_t*)(ws + WS_F1) + (size_t)layer * FF2 * D, D, D, D, 0}; pg8::StaticOrder S; S.init(M, FF2, F.G, F.bid);
            pg8::EpiBf16 E{HF, FF2, nullptr, nullptr, 0};
            pg8::gemm_phase<pg8::EpiBf16, true>(F.lds, g, S, E);
        }
        GRID_BAR();
        conv_phase(F, HF, args.in[12] + (size_t)layer * 3 * FF2, args.in[13] + (size_t)layer * FF2, ACT);
        GRID_BAR();
        {
            pg8::Gemm g{ACT, (const bf16_t*)(ws + WS_F2) + (size_t)layer * D * FF, FF, FF, FF, 0}; pg8::StaticOrder S; S.init(M, D, F.G, F.bid);
            pg8::EpiRes E{XF, Y};
            pg8::gemm_phase<pg8::EpiRes, true>(F.lds, g, S, E);
        }
        GRID_BAR();
        ln_phase(F, Y, args.in[1] + (size_t)(layer * 2 + 1) * D, args.in[2] + (size_t)(layer * 2 + 1) * D, XF, XB);
        GRID_BAR();
    }
}

extern "C" void kernel_launch(void* const* d_in, const int* in_sizes, int n_in, void* d_out, int out_size, void* d_ws, size_t ws_size, hipStream_t stream) {
    static int grid = 0;
    if (grid == 0) {
        if (n_in != 15 || out_size != M * D || ws_size < WS_END) { fprintf(stderr, "kernel_launch: unexpected problem: n_in %d out %d ws %zu (need %zu)\n", n_in, out_size, ws_size, (size_t)WS_END); grid = -1; return; }
        int dev = 0, cus = 0, per_cu = 0;
        hipGetDevice(&dev); hipDeviceGetAttribute(&cus, hipDeviceAttributeMultiprocessorCount, dev);
        if (hipFuncSetAttribute((const void*)fwd_megakernel, hipFuncAttributeMaxDynamicSharedMemorySize, LDS_BYTES) != hipSuccess) { fprintf(stderr, "kernel_launch: hipFuncSetAttribute failed\n"); grid = -1; return; }
        if (hipOccupancyMaxActiveBlocksPerMultiprocessor(&per_cu, (const void*)fwd_megakernel, 512, LDS_BYTES) != hipSuccess || per_cu < 1) { fprintf(stderr, "kernel_launch: occupancy query says %d\n", per_cu); per_cu = 1; }
        (void)hipGetLastError();
        grid = cus;
    }
    if (grid < 0) return;
    Args a{};
    for (int i = 0; i < 15; ++i) a.in[i] = (const float*)d_in[i];
    a.out = (float*)d_out; a.ws = (unsigned char*)d_ws;
    if (hipMemsetAsync((char*)d_ws + WS_CTL, 0, CTL_BYTES, stream) != hipSuccess) { fprintf(stderr, "kernel_launch: memset failed\n"); return; }
    void* kargs[] = {&a};
    hipError_t e = hipLaunchCooperativeKernel((const void*)fwd_megakernel, dim3(grid), dim3(512), kargs, LDS_BYTES, stream);
    if (e != hipSuccess) fprintf(stderr, "kernel_launch: cooperative launch failed: %s (grid %d)\n", hipGetErrorString(e), grid);
}
```

```cpp
#include <hip/hip_runtime.h>
#include <hip/hip_cooperative_groups.h>
#include <cstdio>
#include <cstdint>
namespace cg = cooperative_groups;

#define LAS __attribute__((address_space(3)))
typedef unsigned short bf16_t;
typedef short bf16x8 __attribute__((ext_vector_type(8)));
typedef short s16x4 __attribute__((ext_vector_type(4)));
typedef float f32x4 __attribute__((ext_vector_type(4)));
typedef float f32x2 __attribute__((ext_vector_type(2)));
typedef unsigned u32x4 __attribute__((ext_vector_type(4)));
typedef unsigned u32x2 __attribute__((ext_vector_type(2)));
typedef __bf16 bf16x2_t __attribute__((ext_vector_type(2)));

constexpr int NBATCH = 4, SEQ = 4096, M = NBATCH * SEQ, D = 2048;
constexpr int EIN = 5120, OIN = 2560, FF = 5632, FF2 = 11264;
constexpr float ALPHA = 1.6817928305074290f;
constexpr float LN_EPS = 1e-5f;
constexpr float LOG2E = 1.4426950408889634f;

constexpr size_t MiB = 1u << 20;
constexpr size_t WS_EIN = 0 * MiB;
constexpr size_t WS_EOUT = 40 * MiB;
constexpr size_t WS_POOLW = 56 * MiB;
constexpr size_t WS_QKVW = 57 * MiB;
constexpr size_t WS_AOUT = 77 * MiB;
constexpr size_t WS_F1 = 93 * MiB;
constexpr size_t WS_F2 = 269 * MiB;
constexpr size_t WS_XB = 357 * MiB;
constexpr size_t WS_Y = 421 * MiB;
constexpr size_t WS_MIX = 549 * MiB;
constexpr size_t WS_BIG = 613 * MiB;
constexpr size_t WS_HF = WS_BIG;
constexpr size_t WS_ACT = WS_BIG + 352 * MiB;
constexpr size_t WS_H5 = WS_BIG;
constexpr size_t WS_QKV = WS_BIG;
constexpr size_t WS_KVT = WS_BIG + 160 * MiB;
constexpr size_t WS_PREVT = WS_BIG + 288 * MiB;
constexpr size_t WS_POOLED = WS_BIG + 352 * MiB;
constexpr size_t WS_CTL = 1141 * MiB;
constexpr size_t CTL_BYTES = 64 * 1024;
constexpr size_t WS_END = 1142 * MiB;
constexpr int MISC_OFF = 143360;

constexpr int LDS_BYTES = 147456;

__device__ __forceinline__ unsigned pk2(float lo, float hi) { f32x2 v = {lo, hi}; bf16x2_t b = __builtin_convertvector(v, bf16x2_t); return __builtin_bit_cast(unsigned, b); }
__device__ __forceinline__ float bflo(unsigned w) { return __uint_as_float(w << 16); }
__device__ __forceinline__ float bfhi(unsigned w) { return __uint_as_float(w & 0xffff0000u); }
__device__ __forceinline__ float wave_sum(float v) {
#pragma unroll
    for (int o = 1; o < 64; o <<= 1) v += __shfl_xor(v, o);
    return v;
}
typedef short v4i16_t __attribute__((ext_vector_type(4)));
__device__ __forceinline__ s16x4 vtr(const LAS unsigned char* p) { return __builtin_bit_cast(s16x4, __builtin_amdgcn_ds_read_tr16_b64_v4i16((LAS v4i16_t*)p)); }
__device__ __forceinline__ bf16x8 cat8(s16x4 lo, s16x4 hi) { return (bf16x8){lo[0], lo[1], lo[2], lo[3], hi[0], hi[1], hi[2], hi[3]}; }
__device__ __forceinline__ f32x4 mfma16(bf16x8 a, bf16x8 b, f32x4 c) { return __builtin_amdgcn_mfma_f32_16x16x32_bf16(a, b, c, 0, 0, 0); }
__device__ __forceinline__ f32x2 gelu_pk(f32x2 v) {
    const f32x2 av = __builtin_elementwise_abs(v), d = av * 0.2316418882f + 1.0f;
    f32x2 t; t.x = __builtin_amdgcn_rcpf(d.x); t.y = __builtin_amdgcn_rcpf(d.y);
    f32x2 q = t * 0.5307027145f + (-0.7265760135f); q = q * t + 0.7107068705f; q = q * t + (-0.142248368f); q = q * t + 0.127414796f; q = q * t;
    const f32x2 s = (v * v) * (-0.72134752044f);
    f32x2 e; e.x = __builtin_amdgcn_exp2f(s.x); e.y = __builtin_amdgcn_exp2f(s.y);
    const f32x2 m = v * (q * e), r = v - m;
    f32x2 o; o.x = v.x < 0.f ? m.x : r.x; o.y = v.y < 0.f ? m.y : r.y; return o;
}

namespace pg8 {
constexpr int BM = 256, BK = 64, HALF = 128, HTB = HALF * BK * 2, STAGE_BYTES = 8 * HTB, NXCD = 8, WGM = 8;
__host__ __device__ __forceinline__ int lds_byte(int r, int c) { const int st = (r >> 4) * 2 + (c >> 5), rr = r & 15, cc = c & 31, ob = rr * 64 + cc * 2; return st * 1024 + (ob ^ (((ob >> 9) & 1) << 5)); }
__host__ __device__ __forceinline__ void stage_rc(int b, int& R, int& C) { const int st = b / 1024, sb = b % 1024, swz = sb ^ (((sb >> 9) & 1) << 5); R = (st >> 1) * 16 + swz / 64; C = (st & 1) * 32 + (swz % 64) / 2; }
__host__ __device__ __forceinline__ int perm32(int rho) { const int n = rho >> 4, i = rho & 15; return 8 * (i >> 2) + 4 * n + (i & 3); }

struct Unit { int pm, pn; };
struct Gemm { const bf16_t* A; const bf16_t* Bt; int lda, ldb, K, a_pn_off; };

struct StaticOrder {
    int nM, nN, nwg, G, c;
    __device__ void init(int M_, int N_, int G_, int c_) { nM = M_ / BM; nN = N_ / BM; nwg = nM * nN; G = G_; c = c_; }
    __device__ bool next(int i, Unit& u) const {
        const long L = (long)i * G + c; if (L >= nwg) return false;
        int wgid = (int)L; { const int q = nwg / NXCD, r = nwg % NXCD, xcd = wgid % NXCD, off = wgid / NXCD; wgid = (xcd < r ? xcd * (q + 1) : r * (q + 1) + (xcd - r) * q) + off; }
        const int nig = WGM * nN, gid = wgid / nig, fm = gid * WGM, gsz = (nM - fm) < WGM ? (nM - fm) : WGM;
        u.pm = fm + ((wgid % nig) % gsz); u.pn = (wgid % nig) / gsz; return true;
    }
};

struct EpiBf16 {
    static constexpr bool PERM = true;
    bf16_t* O; int ldc; const float* bias; const float* scale; int ocol_off;
    __device__ __forceinline__ void operator()(const f32x4 (&acc)[2][2][4][2], const Unit& u, int wr, int wc, int fr, int fq) const {
        const int row0 = u.pm * BM + wr * 64 + fr; const int bcol0 = u.pn * BM + wc * 32 + 8 * fq; const int col0 = ocol_off + bcol0;
        f32x4 bv[2][2], sv[2][2];
#pragma unroll
        for (int bj = 0; bj < 2; ++bj)
#pragma unroll
            for (int n = 0; n < 2; ++n) { bv[bj][n] = bias ? *(const f32x4*)(bias + bcol0 + bj * HALF + 4 * n) : (f32x4){0.f, 0.f, 0.f, 0.f};
                                          sv[bj][n] = scale ? *(const f32x4*)(scale + bcol0 + bj * HALF + 4 * n) : (f32x4){1.f, 1.f, 1.f, 1.f}; }
#pragma unroll
        for (int ai = 0; ai < 2; ++ai)
#pragma unroll
            for (int m = 0; m < 4; ++m) { bf16_t* rowp = O + (size_t)(row0 + ai * HALF + m * 16) * ldc + col0;
#pragma unroll
                for (int bj = 0; bj < 2; ++bj) { f32x4 v0 = (acc[ai][bj][m][0] + bv[bj][0]) * sv[bj][0], v1 = (acc[ai][bj][m][1] + bv[bj][1]) * sv[bj][1];
                    u32x4 w; w.x = pk2(v0[0], v0[1]); w.y = pk2(v0[2], v0[3]); w.z = pk2(v1[0], v1[1]); w.w = pk2(v1[2], v1[3]);
                    *(u32x4*)(rowp + bj * HALF) = w; } }
    }
};
struct EpiRes {
    static constexpr bool PERM = false;
    const float* X; float* Y;
    __device__ __forceinline__ void operator()(const f32x4 (&acc)[2][2][4][2], const Unit& u, int wr, int wc, int fr, int fq) const {
        const int row0 = u.pm * BM + wr * 64 + fr, col0 = u.pn * BM + wc * 32 + 4 * fq;
#pragma unroll
        for (int ai = 0; ai < 2; ++ai)
#pragma unroll
            for (int m = 0; m < 4; ++m) { const size_t off = (size_t)(row0 + ai * HALF + m * 16) * D + col0;
#pragma unroll
                for (int bj = 0; bj < 2; ++bj)
#pragma unroll
                    for (int n = 0; n < 2; ++n) { const f32x4 xv = *(const f32x4*)(X + off + bj * HALF + n * 16); *(f32x4*)(Y + off + bj * HALF + n * 16) = xv * ALPHA + acc[ai][bj][m][n]; }
                asm volatile("" ::: "memory"); }
    }
};

__device__ __forceinline__ float dpp_ror1(float v) { return __int_as_float(__builtin_amdgcn_update_dpp(0, __float_as_int(v), 0x121, 0xf, 0xf, false)); }
__device__ __forceinline__ float dpp_ror2(float v) { return __int_as_float(__builtin_amdgcn_update_dpp(0, __float_as_int(v), 0x122, 0xf, 0xf, false)); }
struct EpiConvGlu {
    static constexpr bool PERM = true;
    bf16_t* ACT; float* HALO; const float* cw; const float* cb; LAS float* xbuf;
    __device__ __forceinline__ void operator()(const f32x4 (&acc)[2][2][4][2], const Unit& u, int wr, int wc, int fr, int fq) const {
        const int cl = 32 * wc + 8 * fq;
        if (fr >= 14) {
#pragma unroll
            for (int ai = 0; ai < 2; ++ai)
#pragma unroll
                for (int bj = 0; bj < 2; ++bj)
#pragma unroll
                    for (int n = 0; n < 2; ++n) *(LAS f32x4*)(xbuf + ((((ai * 2 + wr) * 2 + bj) * 2 + (fr - 14)) * 128 + cl + 4 * n)) = acc[ai][bj][3][n];
        }
        if (wr == 0 && fr < 2) {
#pragma unroll
            for (int bj = 0; bj < 2; ++bj)
#pragma unroll
                for (int n = 0; n < 2; ++n) *(f32x4*)(HALO + (size_t)(u.pm * 4 + fr) * FF2 + u.pn * 256 + bj * 128 + cl + 4 * n) = acc[0][bj][0][n];
        }
        if (wr == 1 && fr >= 14) {
#pragma unroll
            for (int bj = 0; bj < 2; ++bj)
#pragma unroll
                for (int n = 0; n < 2; ++n) *(f32x4*)(HALO + (size_t)(u.pm * 4 + fr - 12) * FF2 + u.pn * 256 + bj * 128 + cl + 4 * n) = acc[1][bj][3][n];
        }
        asm volatile("s_waitcnt lgkmcnt(0)" ::: "memory"); __builtin_amdgcn_s_barrier(); asm volatile("" ::: "memory");
        const int row0 = u.pm * BM + wr * 64 + fr;
#pragma unroll
        for (int n = 0; n < 2; ++n) {
            const int ch = u.pn * 128 + cl + 4 * n;
            f32x4 w[2][3], bb[2];
#pragma unroll
            for (int bj = 0; bj < 2; ++bj) { bb[bj] = *(const f32x4*)(cb + bj * FF + ch);
#pragma unroll
                for (int k = 0; k < 3; ++k) w[bj][k] = *(const f32x4*)(cw + (size_t)k * FF2 + bj * FF + ch); }
#pragma unroll
            for (int ai = 0; ai < 2; ++ai)
#pragma unroll
                for (int m = 0; m < 4; ++m) {
                    f32x4 cv[2];
#pragma unroll
                    for (int bj = 0; bj < 2; ++bj) {
                        const f32x4 cur = acc[ai][bj][m][n]; f32x4 p1, p2;
                        if (m > 0) { const f32x4 pb = acc[ai][bj][m > 0 ? m - 1 : 0][n];
#pragma unroll
                            for (int j = 0; j < 4; ++j) { const float a1 = dpp_ror1(cur[j]), a2 = dpp_ror2(cur[j]), b1 = dpp_ror1(pb[j]), b2 = dpp_ror2(pb[j]); p1[j] = fr >= 1 ? a1 : b1; p2[j] = fr >= 2 ? a2 : b2; }
                        } else {
                            f32x4 x1 = (f32x4){0.f, 0.f, 0.f, 0.f}, x2 = x1;
                            if (wr == 1 || ai == 1) { const int sai = (wr == 1) ? ai : 0, swr = (wr == 1) ? 0 : 1; const LAS float* xp = xbuf + (((sai * 2 + swr) * 2 + bj) * 2) * 128 + cl + 4 * n;
                                x1 = *(const LAS f32x4*)(xp + 128); x2 = *(const LAS f32x4*)(xp + (fr & 1) * 128); }
#pragma unroll
                            for (int j = 0; j < 4; ++j) { const float a1 = dpp_ror1(cur[j]), a2 = dpp_ror2(cur[j]); p1[j] = fr >= 1 ? a1 : x1[j]; p2[j] = fr >= 2 ? a2 : x2[j]; }
                        }
                        cv[bj] = bb[bj] + w[bj][0] * p2 + w[bj][1] * p1 + w[bj][2] * cur;
                    }
                    const f32x2 g0 = gelu_pk((f32x2){cv[0][0], cv[0][1]}), g1 = gelu_pk((f32x2){cv[0][2], cv[0][3]});
                    u32x2 o; o.x = pk2(g0.x * cv[1][0], g0.y * cv[1][1]); o.y = pk2(g1.x * cv[1][2], g1.y * cv[1][3]);
                    *(u32x2*)(ACT + (size_t)(row0 + ai * HALF + m * 16) * FF + ch) = o;
                }
        }
    }
};

template <class Epi, bool ALIGN_EPI = true>
__device__ __forceinline__ void gemm_phase(LAS unsigned char* lds, const Gemm g, const StaticOrder& S, const Epi& E) {
    int tid = threadIdx.x; asm volatile("" : "+v"(tid));
    const int wid = __builtin_amdgcn_readfirstlane(tid >> 6), lane = tid & 63, wr = wid >> 2, wc = wid & 3, fr = lane & 15, fq = lane >> 4;
    const int K = g.K, nt = K / BK;
    unsigned voffA[2], voffB[2];
#pragma unroll
    for (int i = 0; i < 2; ++i) { int R, C; stage_rc(tid * 16 + i * 8192, R, C); const int Rb = Epi::PERM ? ((R & ~31) + perm32(R & 31)) : R;
        voffA[i] = (unsigned)(R * g.lda + C) * 2u; voffB[i] = (unsigned)(Rb * g.ldb + C) * 2u; }
    const size_t kstep = (size_t)(BK * 2);
    const size_t hA = (size_t)HALF * g.lda * 2, hB = (size_t)HALF * g.ldb * 2;
    const unsigned ldsw = (unsigned)wid * 1024u;
    const int aoff = lds_byte(wr * 64 + fr, fq * 8), boff = lds_byte(wc * 32 + fr, fq * 8);
#define PG8_SA(b, h) (((b) * 2 + (h)) * HTB)
#define PG8_SB(b, h) ((4 + (b) * 2 + (h)) * HTB)
#define PG8_STAGE(bufoff, gbase, voff) do { _Pragma("unroll") for (int _i = 0; _i < 2; ++_i) \
        __builtin_amdgcn_global_load_lds((const unsigned*)((const char*)(gbase) + (voff)[_i]), (LAS unsigned*)(lds + (bufoff) + ldsw + _i * 8192), 16, 0, 0); } while (0)
#define PG8_LDA(dst, b, h) do { _Pragma("unroll") for (int m = 0; m < 4; ++m) _Pragma("unroll") for (int k = 0; k < 2; ++k) dst[m][k] = *(const LAS bf16x8*)(lds + PG8_SA(b, h) + aoff + m * 2048 + k * 1024); } while (0)
#define PG8_LDB(dst, b, h) do { _Pragma("unroll") for (int n = 0; n < 2; ++n) _Pragma("unroll") for (int k = 0; k < 2; ++k) dst[n][k] = *(const LAS bf16x8*)(lds + PG8_SB(b, h) + boff + n * 2048 + k * 1024); } while (0)
#define PG8_MMA(ai, bj, At, Bt) do { __builtin_amdgcn_s_setprio(1); _Pragma("unroll") for (int m = 0; m < 4; ++m) _Pragma("unroll") for (int n = 0; n < 2; ++n) _Pragma("unroll") for (int k = 0; k < 2; ++k) \
        acc[ai][bj][m][n] = __builtin_amdgcn_mfma_f32_16x16x32_bf16(Bt[n][k], At[m][k], acc[ai][bj][m][n], 0, 0, 0); __builtin_amdgcn_s_setprio(0); } while (0)
#define PG8_WAIT_V(n) asm volatile("s_waitcnt vmcnt(" #n ")" ::: "memory")
#define PG8_WAIT_L(n) asm volatile("s_waitcnt lgkmcnt(" #n ")" ::: "memory")
#define PG8_BAR __builtin_amdgcn_s_barrier()
#define PG8_SCHED __builtin_amdgcn_sched_barrier(0)
    Unit cur, nxt; int ui = 0;
    if (!S.next(0, cur)) return;
    f32x4 acc[2][2][4][2];
#pragma unroll
    for (int a = 0; a < 2; ++a)
#pragma unroll
        for (int b = 0; b < 2; ++b)
#pragma unroll
            for (int m = 0; m < 4; ++m)
#pragma unroll
                for (int n = 0; n < 2; ++n) acc[a][b][m][n] = (f32x4){0.f, 0.f, 0.f, 0.f};
    bf16x8 At[4][2], B0[2][2], B1[2][2];
    const char* cA = (const char*)g.A + ((size_t)cur.pm * BM * g.lda + (size_t)cur.pn * g.a_pn_off) * 2; const char* cB = (const char*)g.Bt + (size_t)cur.pn * BM * g.ldb * 2;
    PG8_STAGE(PG8_SB(0, 0), cB, voffB); PG8_STAGE(PG8_SB(0, 1), cB + hB, voffB); PG8_STAGE(PG8_SA(0, 0), cA, voffA); PG8_STAGE(PG8_SA(0, 1), cA + hA, voffA);
    if (wr == 1) PG8_BAR;
    PG8_WAIT_V(2); PG8_BAR;
    PG8_STAGE(PG8_SB(1, 0), cB + kstep, voffB); PG8_STAGE(PG8_SA(1, 0), cA + kstep, voffA); PG8_STAGE(PG8_SB(1, 1), cB + hB + kstep, voffB);
    PG8_WAIT_V(6); PG8_BAR;
    for (;;) {
        const bool has_next = S.next(ui + 1, nxt);
        const char* nA = has_next ? (const char*)g.A + ((size_t)nxt.pm * BM * g.lda + (size_t)nxt.pn * g.a_pn_off) * 2 : cA; const char* nB = has_next ? (const char*)g.Bt + (size_t)nxt.pn * BM * g.ldb * 2 : cB;
        for (int t = 0; t < nt; t += 2) {
            const bool last = (t == nt - 2);
            const char* a1 = cA + (size_t)(t + 1) * kstep;
            const char* a2 = last ? nA : cA + (size_t)(t + 2) * kstep; const char* b2 = last ? nB : cB + (size_t)(t + 2) * kstep;
            const char* a3 = a2 + kstep; const char* b3 = b2 + kstep;
            PG8_LDB(B0, 0, 0); PG8_LDB(B1, 0, 1); PG8_SCHED; PG8_LDA(At, 0, 0); PG8_STAGE(PG8_SA(1, 1), a1 + hA, voffA);
            PG8_WAIT_V(8); PG8_WAIT_L(0); PG8_BAR; PG8_MMA(0, 0, At, B0); PG8_MMA(0, 1, At, B1); PG8_BAR; PG8_SCHED;
            PG8_LDA(At, 0, 1); PG8_STAGE(PG8_SB(0, 0), b2, voffB); PG8_STAGE(PG8_SB(0, 1), b2 + hB, voffB); PG8_STAGE(PG8_SA(0, 0), a2, voffA);
            PG8_WAIT_V(8); PG8_WAIT_L(0); PG8_BAR; PG8_MMA(1, 0, At, B0); PG8_MMA(1, 1, At, B1); PG8_BAR; PG8_SCHED;
            PG8_LDB(B0, 1, 0); PG8_LDB(B1, 1, 1); PG8_SCHED; PG8_LDA(At, 1, 0); PG8_STAGE(PG8_SA(0, 1), a2 + hA, voffA);
            PG8_WAIT_V(8); PG8_WAIT_L(0); PG8_BAR; PG8_MMA(0, 0, At, B0); PG8_MMA(0, 1, At, B1); PG8_BAR; PG8_SCHED;
            PG8_LDA(At, 1, 1); PG8_STAGE(PG8_SB(1, 0), b3, voffB); PG8_STAGE(PG8_SB(1, 1), b3 + hB, voffB); PG8_STAGE(PG8_SA(1, 0), a3, voffA);
            PG8_WAIT_V(8); PG8_WAIT_L(0); PG8_BAR; PG8_MMA(1, 0, At, B0); PG8_MMA(1, 1, At, B1); PG8_BAR; PG8_SCHED;
        }
        if constexpr (ALIGN_EPI) { if (wr == 0) PG8_BAR; }
        E(acc, cur, wr, wc, fr, fq);
        if (!has_next) break;
#pragma unroll
        for (int a = 0; a < 2; ++a)
#pragma unroll
            for (int b = 0; b < 2; ++b)
#pragma unroll
                for (int m = 0; m < 4; ++m)
#pragma unroll
                    for (int n = 0; n < 2; ++n) acc[a][b][m][n] = (f32x4){0.f, 0.f, 0.f, 0.f};
        cur = nxt; cA = nA; cB = nB; ++ui;
        if constexpr (ALIGN_EPI) { if (wr == 1) PG8_BAR; }
    }
    PG8_WAIT_V(0);
    if constexpr (!ALIGN_EPI) { if (wr == 0) PG8_BAR; }
    PG8_BAR;
#undef PG8_SA
#undef PG8_SB
#undef PG8_STAGE
#undef PG8_LDA
#undef PG8_LDB
#undef PG8_MMA
#undef PG8_WAIT_V
#undef PG8_WAIT_L
#undef PG8_BAR
#undef PG8_SCHED
}
}

#define XB_TMO      128
#define XB_XCNT(j)  (256  + 64 * (j))
#define XB_XSUB(j)  (1280 + 64 * (j))
#define XB_XGEN(j)  (2304 + 64 * (j))
#define XB_TOP      3328
#define XB_TOPGEN   3392
#define XCD_BAR_WORDS 3456
#define XB_SPIN_CAP (1u << 22)
__device__ __forceinline__ unsigned xb_ld(unsigned* p)              { return __hip_atomic_load(p, __ATOMIC_RELAXED, __HIP_MEMORY_SCOPE_AGENT); }
__device__ __forceinline__ unsigned xb_add(unsigned* p, unsigned v) { return __hip_atomic_fetch_add(p, v, __ATOMIC_RELAXED, __HIP_MEMORY_SCOPE_AGENT); }
__device__ __forceinline__ unsigned xb_xcc_id() { return (unsigned)__builtin_amdgcn_s_getreg((3 << 11) | 20) & 0xFu; }
#define XB_SPIN(cond, bar) do { unsigned _sp = 0; while (cond) { __builtin_amdgcn_s_sleep(1); \
    if ((++_sp & 255u) == 0u) { if (xb_ld(&(bar)[XB_TMO])) break; if (_sp > XB_SPIN_CAP) { atomicAdd(&(bar)[XB_TMO], 1u); break; } } } } while (0)
struct XcdBarrier { unsigned* bar; unsigned x; volatile LAS unsigned* st; };
__device__ __forceinline__ XcdBarrier xcd_barrier_post(unsigned* bar, volatile LAS unsigned* st) {
    XcdBarrier b; b.bar = bar; b.x = xb_xcc_id(); b.st = st;
    if (threadIdx.x == 0) (void)xb_add(&bar[XB_XCNT(b.x)], 1u);
    return b;
}
__device__ __forceinline__ void xcd_barrier_complete(unsigned* bar, unsigned x, unsigned& nloc, unsigned& nx) {
    const unsigned G = gridDim.x * gridDim.y * gridDim.z;
    unsigned sum, cnt, mine, sp = 0u;
    for (;;) {
        sum = 0u; cnt = 0u; mine = 0u;
#pragma unroll
        for (unsigned j = 0; j < 16; ++j) { const unsigned c = xb_ld(&bar[XB_XCNT(j)]); sum += c; cnt += (c > 0u) ? 1u : 0u; mine = (j == x) ? c : mine; }
        if (sum == G) break;
        __builtin_amdgcn_s_sleep(1);
        if ((++sp & 255u) == 0u) { if (xb_ld(&bar[XB_TMO])) break; if (sp > XB_SPIN_CAP) { atomicAdd(&bar[XB_TMO], 1u); break; } }
    }
    nloc = mine > 0u ? mine : 1u; nx = cnt > 0u ? cnt : 1u;
}
__device__ __forceinline__ void xcd_barrier(const XcdBarrier& b) {
    asm volatile("s_waitcnt vmcnt(0)" ::: "memory");
    __syncthreads();
    if (threadIdx.x == 0) {
        unsigned* bar = b.bar;
        __builtin_amdgcn_s_waitcnt(0);
        unsigned nloc = b.st[0], nx = b.st[1];
        if (nloc == 0u) { xcd_barrier_complete(bar, b.x, nloc, nx); b.st[0] = nloc; b.st[1] = nx; }
        const unsigned old = xb_add(&bar[XB_XSUB(b.x)], 1u);
        const unsigned gen = old / nloc;
        if (old + 1u == (gen + 1u) * nloc) {
            __builtin_amdgcn_fence(__ATOMIC_RELEASE, "agent");
            asm volatile("s_waitcnt vmcnt(0)" ::: "memory");
            const unsigned og = xb_add(&bar[XB_TOP], 1u);
            const unsigned tg = og / nx;
            if (og + 1u == (tg + 1u) * nx) xb_add(&bar[XB_TOPGEN], 1u);
            else XB_SPIN(xb_ld(&bar[XB_TOPGEN]) == tg, bar);
            __builtin_amdgcn_fence(__ATOMIC_ACQUIRE, "agent");
            xb_add(&bar[XB_XGEN(b.x)], 1u);
            asm volatile("s_waitcnt vmcnt(0)" ::: "memory");
        } else {
            XB_SPIN(xb_ld(&bar[XB_XGEN(b.x)]) == gen, bar);
            __builtin_amdgcn_fence(__ATOMIC_ACQUIRE, "agent");
            asm volatile("s_waitcnt vmcnt(0)" ::: "memory");
        }
    }
    __syncthreads();
}

struct Args { const float* in[15]; float* out; unsigned char* ws; };
struct Frame { LAS unsigned char* lds; int tid, lane, wave, G, bid; };
__device__ __forceinline__ Frame relaunder(const Frame& F0) { Frame F = F0; int t = F0.tid; asm volatile("" : "+v"(t)); F.tid = t; F.lane = t & 63; F.wave = __builtin_amdgcn_readfirstlane(t >> 6); return F; }

__device__ __forceinline__ void p0_item(const float* W, int K, int N, bf16_t* WT, int row_off, bool permff, LAS float* scr, int item, int lane) {
    const int nblk = N >> 6, kb = item / nblk, nb = item - kb * nblk, k0 = kb << 6, n0 = nb << 6;
    const float* src = W + (size_t)k0 * N + n0 + lane;
#pragma unroll 16
    for (int kk = 0; kk < 64; ++kk) scr[kk * 65 + lane] = src[(size_t)kk * N];
    asm volatile("s_waitcnt lgkmcnt(0)" ::: "memory");
    int orow0 = row_off + n0;
    if (permff) { orow0 = (n0 < FF) ? ((n0 >> 7) * 256 + (n0 & 127)) : (((n0 - FF) >> 7) * 256 + 128 + ((n0 - FF) & 127)); }
#pragma unroll
    for (int j = 0; j < 8; ++j) { const int id = lane + 64 * j, n = id >> 3, c = id & 7; const LAS float* s = scr + (8 * c) * 65 + n;
        u32x4 o; o.x = pk2(s[0 * 65], s[1 * 65]); o.y = pk2(s[2 * 65], s[3 * 65]); o.z = pk2(s[4 * 65], s[5 * 65]); o.w = pk2(s[6 * 65], s[7 * 65]);
        *(u32x4*)(WT + (size_t)(orow0 + n) * K + k0 + 8 * c) = o; }
    asm volatile("s_waitcnt lgkmcnt(0)" ::: "memory");
}
__device__ __forceinline__ void p0_prologue(const Frame& F0, const Args& a) {
    const Frame F = relaunder(F0);
    LAS float* scr = (LAS float*)(F.lds + F.wave * 16640);
    const int gw = F.bid * 8 + F.wave, NGW = F.G * 8;
    unsigned char* ws = a.ws;
    constexpr int I_EIN = (D / 64) * (EIN / 64), I_SQ = (D / 64) * (D / 64), I_PW = 16, I_QKV = (D / 64) * (OIN / 64), I_F1 = (D / 64) * (FF2 / 64), I_F2 = (FF / 64) * (D / 64);
    constexpr int T0 = 2 * I_EIN, T1 = T0 + 2 * I_SQ, T2 = T1 + 8 * I_PW, T3 = T2 + 2 * I_QKV, T4 = T3 + 2 * I_SQ, T5 = T4 + 4 * I_F1, T6 = T5 + 4 * I_F2;
    for (int it = gw; it < T6; it += NGW) {
        if (it < T0) { const int li = it / I_EIN, r = it - li * I_EIN; p0_item(a.in[3] + (size_t)li * D * EIN, D, EIN, (bf16_t*)(ws + WS_EIN) + (size_t)li * EIN * D, 0, false, scr, r, F.lane); }
        else if (it < T1) { const int x = it - T0, li = x / I_SQ, r = x - li * I_SQ; p0_item(a.in[6] + (size_t)li * D * D, D, D, (bf16_t*)(ws + WS_EOUT) + (size_t)li * D * D, 0, false, scr, r, F.lane); }
        else if (it < T2) { const int x = it - T1, lg = x / I_PW, r = x - lg * I_PW, li = lg >> 2, g = lg & 3; p0_item(a.in[4] + (size_t)lg * 65536, 256, 256, (bf16_t*)(ws + WS_POOLW) + (size_t)li * 1024 * 256, g * 256, false, scr, r, F.lane); }
        else if (it < T3) { const int x = it - T2, li = x / I_QKV, r = x - li * I_QKV; p0_item(a.in[7] + (size_t)li * D * OIN, D, OIN, (bf16_t*)(ws + WS_QKVW) + (size_t)li * OIN * D, 0, false, scr, r, F.lane); }
        else if (it < T4) { const int x = it - T3, li = x / I_SQ, r = x - li * I_SQ; p0_item(a.in[10] + (size_t)li * D * D, D, D, (bf16_t*)(ws + WS_AOUT) + (size_t)li * D * D, 0, false, scr, r, F.lane); }
        else if (it < T5) { const int x = it - T4, l = x / I_F1, r = x - l * I_F1; p0_item(a.in[11] + (size_t)l * D * FF2, D, FF2, (bf16_t*)(ws + WS_F1) + (size_t)l * FF2 * D, 0, true, scr, r, F.lane); }
        else { const int x = it - T5, l = x / I_F2, r = x - l * I_F2; p0_item(a.in[14] + (size_t)l * FF * D, FF, D, (bf16_t*)(ws + WS_F2) + (size_t)l * D * FF, 0, false, scr, r, F.lane); }
    }
    const f32x4* x4 = (const f32x4*)a.in[0]; u32x2* xb = (u32x2*)(ws + WS_XB);
    for (size_t i = (size_t)F.bid * 512 + F.tid; i < (size_t)M * D / 4; i += (size_t)F.G * 512) { const f32x4 v = x4[i]; u32x2 o; o.x = pk2(v[0], v[1]); o.y = pk2(v[2], v[3]); xb[i] = o; }
}

__device__ __forceinline__ void ln_phase(const Frame& F0, const float* Y, const float* g, const float* b, float* XF, bf16_t* XB) {
    const Frame F = relaunder(F0);
    const int gw = F.bid * 8 + F.wave, NGW = F.G * 8;
    for (int row = gw; row < M; row += NGW) {
        const f32x4* yr = (const f32x4*)(Y + (size_t)row * D) + F.lane;
        f32x4 v[8]; float s = 0.f;
#pragma unroll
        for (int j = 0; j < 8; ++j) { v[j] = yr[64 * j]; s += (v[j][0] + v[j][1]) + (v[j][2] + v[j][3]); }
        const float mean = wave_sum(s) * (1.f / D); float s2 = 0.f;
#pragma unroll
        for (int j = 0; j < 8; ++j) { v[j] = v[j] - mean; s2 += (v[j][0] * v[j][0] + v[j][1] * v[j][1]) + (v[j][2] * v[j][2] + v[j][3] * v[j][3]); }
        const float rstd = 1.0f / sqrtf(wave_sum(s2) * (1.f / D) + LN_EPS);
        f32x4* xo = (f32x4*)(XF + (size_t)row * D) + F.lane; u32x2* bo = (u32x2*)(XB + (size_t)row * D) + F.lane;
#pragma unroll
        for (int j = 0; j < 8; ++j) { const f32x4 gg = ((const f32x4*)g)[F.lane + 64 * j], bb = ((const f32x4*)b)[F.lane + 64 * j];
            const f32x4 o = v[j] * rstd * gg + bb; xo[64 * j] = o; u32x2 w; w.x = pk2(o[0], o[1]); w.y = pk2(o[2], o[3]); bo[64 * j] = w; }
    }
}

__device__ __forceinline__ void conv_fixup_phase(const Frame& F0, const float* HALO, const float* cw, const float* cb, bf16_t* ACT) {
    const Frame F = relaunder(F0);
    constexpr int NCQ = FF / 4;
    for (int it = F.bid * 512 + F.tid; it < 64 * NCQ; it += F.G * 512) {
        const int pm = it / NCQ, cq = it - pm * NCQ; if ((pm & 15) == 0) continue;
        const int c = cq * 4, col = (c >> 7) * 256 + (c & 127);
        f32x4 cv[2][2];
#pragma unroll
        for (int bj = 0; bj < 2; ++bj) {
            const float* hp = HALO + (size_t)(pm * 4) * FF2 + col + bj * 128;
            const f32x4 hm2 = *(const f32x4*)(hp - 2 * FF2), hm1 = *(const f32x4*)(hp - FF2), h0 = *(const f32x4*)hp, h1 = *(const f32x4*)(hp + FF2);
            const f32x4 w0 = *(const f32x4*)(cw + bj * FF + c), w1 = *(const f32x4*)(cw + (size_t)FF2 + bj * FF + c), w2 = *(const f32x4*)(cw + (size_t)2 * FF2 + bj * FF + c), b = *(const f32x4*)(cb + bj * FF + c);
            cv[bj][0] = b + w0 * hm2 + w1 * hm1 + w2 * h0; cv[bj][1] = b + w0 * hm1 + w1 * h0 + w2 * h1;
        }
#pragma unroll
        for (int rr = 0; rr < 2; ++rr) { const f32x2 g0 = gelu_pk((f32x2){cv[0][rr][0], cv[0][rr][1]}), g1 = gelu_pk((f32x2){cv[0][rr][2], cv[0][rr][3]});
            u32x2 o; o.x = pk2(g0.x * cv[1][rr][0], g0.y * cv[1][rr][1]); o.y = pk2(g1.x * cv[1][rr][2], g1.y * cv[1][rr][3]);
            *(u32x2*)(ACT + (size_t)(pm * 256 + rr) * FF + c) = o; }
    }
}

__device__ __forceinline__ void attn_phase(const Frame& F0, const bf16_t* QKV, const float* sinks, bf16_t* MIX) {
    const Frame F = relaunder(F0);
    constexpr int RS = 144;
    LAS unsigned char* Kt = F.lds; LAS unsigned char* Vt = F.lds + 256 * RS;
    const int lane = F.lane, r = lane & 15, g4 = lane >> 4, qq = r >> 2, pp = r & 3;
    for (int u = F.bid; u < 512; u += F.G) {
        const int kvh = u & 3, n = (u >> 2) & 31, b = u >> 7, tok0 = b * SEQ + n * 128;
        for (int c = F.tid; c < 256 * 8; c += 512) { const int row = c >> 3, ch = c & 7; const bool valid = (n > 0) || (row >= 128);
            u32x4 kv = (u32x4){0u, 0u, 0u, 0u}, vv = kv;
            if (valid) { const bf16_t* src = QKV + (size_t)(tok0 - 128 + row) * OIN + 2048 + kvh * 64 + ch * 8; kv = *(const u32x4*)src; vv = *(const u32x4*)(src + 256); }
            *(LAS u32x4*)(Kt + row * RS + ch * 16) = kv; *(LAS u32x4*)(Vt + row * RS + ch * 16) = vv; }
        __syncthreads();
        const int head = kvh * 8 + F.wave;
        const float slope2 = __builtin_amdgcn_exp2f(-0.25f * (float)(head + 1)) * LOG2E, sink2 = sinks[head] * LOG2E;
        for (int rb = 0; rb < 8; ++rb) {
            const bf16_t* qp = QKV + (size_t)(tok0 + 16 * rb + r) * OIN + head * 64 + 8 * g4;
            const bf16x8 q0 = *(const bf16x8*)qp, q1 = *(const bf16x8*)(qp + 32);
            f32x4 s[9];
#pragma unroll
            for (int tt = 0; tt < 9; ++tt) { const LAS unsigned char* kp = Kt + (16 * (rb + tt) + r) * RS + 16 * g4;
                f32x4 acc = (f32x4){0.f, 0.f, 0.f, 0.f};
                acc = mfma16(*(const LAS bf16x8*)kp, q0, acc); acc = mfma16(*(const LAS bf16x8*)(kp + 64), q1, acc); s[tt] = acc; }
            const int i = 16 * rb + r; float mx = -INFINITY;
#pragma unroll
            for (int tt = 0; tt < 9; ++tt)
#pragma unroll
                for (int jj = 0; jj < 4; ++jj) { const int j = 16 * (rb + tt) + 4 * g4 + jj, delta = 128 + i - j; const bool valid = (delta >= 0) && (delta < 128) && ((n > 0) || (j >= 128));
                    const float v = s[tt][jj] * (0.125f * LOG2E) - slope2 * (float)delta; s[tt][jj] = valid ? v : -INFINITY; mx = fmaxf(mx, s[tt][jj]); }
            mx = fmaxf(mx, __shfl_xor(mx, 16)); mx = fmaxf(mx, __shfl_xor(mx, 32)); mx = fmaxf(mx, sink2);
            float sum = 0.f;
#pragma unroll
            for (int tt = 0; tt < 9; ++tt)
#pragma unroll
                for (int jj = 0; jj < 4; ++jj) { const float p = __builtin_amdgcn_exp2f(s[tt][jj] - mx); s[tt][jj] = p; sum += p; }
            sum += __shfl_xor(sum, 16); sum += __shfl_xor(sum, 32);
            const float inv = 1.0f / (sum + __builtin_amdgcn_exp2f(sink2 - mx));
            u32x2 P[10];
#pragma unroll
            for (int tt = 0; tt < 9; ++tt) { P[tt].x = pk2(s[tt][0] * inv, s[tt][1] * inv); P[tt].y = pk2(s[tt][2] * inv, s[tt][3] * inv); }
            P[9] = (u32x2){0u, 0u};
            f32x4 o[4];
#pragma unroll
            for (int te = 0; te < 4; ++te) o[te] = (f32x4){0.f, 0.f, 0.f, 0.f};
#pragma unroll
            for (int pr = 0; pr < 5; ++pr) { const int t0 = 2 * pr, t1 = (pr < 4) ? 2 * pr + 1 : 2 * pr;
                const u32x4 bw = (u32x4){P[t0].x, P[t0].y, P[2 * pr + 1].x, P[2 * pr + 1].y}; const bf16x8 bfrag = __builtin_bit_cast(bf16x8, bw);
                const LAS unsigned char* v0 = Vt + (16 * (rb + t0) + 4 * g4 + qq) * RS + 8 * pp; const LAS unsigned char* v1 = Vt + (16 * (rb + t1) + 4 * g4 + qq) * RS + 8 * pp;
#pragma unroll
                for (int te = 0; te < 4; ++te) o[te] = mfma16(cat8(vtr(v0 + 32 * te), vtr(v1 + 32 * te)), bfrag, o[te]); }
            bf16_t* op = MIX + (size_t)(tok0 + i) * D + head * 64 + 4 * g4;
#pragma unroll
            for (int te = 0; te < 4; ++te) { u32x2 w; w.x = pk2(o[te][0], o[te][1]); w.y = pk2(o[te][2], o[te][3]); *(u32x2*)(op + 16 * te) = w; }
        }
        __syncthreads();
    }
}

__device__ __forceinline__ float ret_lg2(int h) { return __builtin_amdgcn_logf(1.0f - __builtin_amdgcn_exp2f(-5.0f - (float)h)); }
constexpr int RRS = 528;

__device__ __forceinline__ void ret_kv_phase(const Frame& F0, const bf16_t* H5, float* KVT) {
    const Frame F = relaunder(F0);
    LAS unsigned char* Kt = F.lds; LAS unsigned char* Vt = F.lds + 128 * RRS;
    const int lane = F.lane, r = lane & 15, g4 = lane >> 4, qq = r >> 2, pp = r & 3, w = F.wave;
    for (int u = F.bid; u < 512; u += F.G) {
        const int h = u & 3, n = (u >> 2) & 31, b = u >> 7, tok0 = b * SEQ + n * 128; const float lg2 = ret_lg2(h);
        for (int c = F.tid; c < 128 * 32; c += 512) { const int row = c >> 5, ch = c & 31; const bf16_t* src = H5 + (size_t)(tok0 + row) * EIN + 1024 + h * 256 + ch * 8;
            const u32x4 kv = *(const u32x4*)src, vv = *(const u32x4*)(src + 1024); const float z = __builtin_amdgcn_exp2f(lg2 * (float)(127 - row)) * 0.0625f;
            u32x4 ks;
#pragma unroll
            for (int e = 0; e < 4; ++e) ks[e] = pk2(bflo(kv[e]) * z, bfhi(kv[e]) * z);
            *(LAS u32x4*)(Kt + row * RRS + ch * 16) = ks; *(LAS u32x4*)(Vt + row * RRS + ch * 16) = vv; }
        __syncthreads();
        for (int dh = 0; dh < 2; ++dh) {
            f32x4 acc[2][8];
#pragma unroll
            for (int a = 0; a < 2; ++a)
#pragma unroll
                for (int d = 0; d < 8; ++d) acc[a][d] = (f32x4){0.f, 0.f, 0.f, 0.f};
#pragma unroll
            for (int ks = 0; ks < 4; ++ks) { const int R0 = 32 * ks + 8 * g4 + qq;
                const LAS unsigned char* vb = Vt + R0 * RRS + 8 * pp; const LAS unsigned char* kb = Kt + R0 * RRS + 8 * pp + 256 * dh;
                const bf16x8 vf0 = cat8(vtr(vb + 64 * w), vtr(vb + 4 * RRS + 64 * w)), vf1 = cat8(vtr(vb + 64 * w + 32), vtr(vb + 4 * RRS + 64 * w + 32));
#pragma unroll
                for (int dt = 0; dt < 8; ++dt) { const bf16x8 kf = cat8(vtr(kb + 32 * dt), vtr(kb + 4 * RRS + 32 * dt)); acc[0][dt] = mfma16(kf, vf0, acc[0][dt]); acc[1][dt] = mfma16(kf, vf1, acc[1][dt]); } }
            float* op = KVT + (size_t)u * 65536 + (size_t)(32 * w + r) * 256 + 128 * dh + 4 * g4;
#pragma unroll
            for (int a = 0; a < 2; ++a)
#pragma unroll
                for (int dt = 0; dt < 8; ++dt) *(f32x4*)(op + a * 16 * 256 + 16 * dt) = acc[a][dt];
        }
        __syncthreads();
    }
}
__device__ __forceinline__ void pooled_phase(const Frame& F0, const bf16_t* H5, bf16_t* PO) {
    const Frame F = relaunder(F0);
    for (int it = F.bid * 512 + F.tid; it < 1024 * 128; it += F.G * 512) {
        const int cgp = it & 127, run = it >> 7, c = cgp * 8, w = 2 << (c >> 8), t0 = run * 16, p0 = t0 & (SEQ - 1);
        const bf16_t* U = H5 + 4096 + c;
        float S[8];
#pragma unroll
        for (int e = 0; e < 8; ++e) S[e] = 0.f;
        for (int s = 1; s < w; ++s) if (p0 - s >= 0) { const u32x4 x = *(const u32x4*)(U + (size_t)(t0 - s) * EIN);
#pragma unroll
            for (int e = 0; e < 4; ++e) { S[2 * e] += bflo(x[e]); S[2 * e + 1] += bfhi(x[e]); } }
        for (int k = 0; k < 16; ++k) { const int t = t0 + k, p = p0 + k; const u32x4 x = *(const u32x4*)(U + (size_t)t * EIN);
            const float rc = 1.0f / (float)((p + 1 < w) ? p + 1 : w); u32x4 o;
#pragma unroll
            for (int e = 0; e < 4; ++e) { const float a0 = bflo(x[e]), a1 = bfhi(x[e]); S[2 * e] += a0; S[2 * e + 1] += a1; o[e] = pk2(S[2 * e] * rc - a0, S[2 * e + 1] * rc - a1); }
            *(u32x4*)(PO + (size_t)t * 1024 + c) = o;
            if (p - (w - 1) >= 0) { const u32x4 y = *(const u32x4*)(U + (size_t)(t - (w - 1)) * EIN);
#pragma unroll
                for (int e = 0; e < 4; ++e) { S[2 * e] -= bflo(y[e]); S[2 * e + 1] -= bfhi(y[e]); } }
        }
    }
}
__device__ __forceinline__ void ret_scan_phase(const Frame& F0, const float* KVT, bf16_t* PREVT) {
    const Frame F = relaunder(F0);
    for (int it = F.bid * 512 + F.tid; it < 16 * 16384; it += F.G * 512) {
        const int bh = it >> 14, e4 = it & 16383, b = bh >> 2, h = bh & 3; const float cd = __builtin_amdgcn_exp2f(ret_lg2(h) * 128.0f);
        f32x4 st = (f32x4){0.f, 0.f, 0.f, 0.f};
#pragma unroll 4
        for (int n = 0; n < 31; ++n) { const size_t u = (size_t)((b * 32 + n) * 4 + h);
            st = st * cd + *(const f32x4*)(KVT + u * 65536 + (size_t)e4 * 4);
            u32x2 o; o.x = pk2(st[0], st[1]); o.y = pk2(st[2], st[3]); *(u32x2*)(PREVT + (u + 4) * 65536 + (size_t)e4 * 4) = o; }
    }
}
__device__ __forceinline__ void ret_out_phase(const Frame& F0, const bf16_t* H5, const bf16_t* PREVT, bf16_t* MIX) {
    const Frame F = relaunder(F0);
    LAS unsigned char* Kt = F.lds; LAS unsigned char* Vt = F.lds + 128 * RRS;
    const int lane = F.lane, r = lane & 15, g4 = lane >> 4, qq = r >> 2, pp = r & 3, w = F.wave;
    for (int u = F.bid; u < 512; u += F.G) {
        const int h = u & 3, n = (u >> 2) & 31, b = u >> 7, tok0 = b * SEQ + n * 128; const float lg2 = ret_lg2(h);
        for (int c = F.tid; c < 128 * 32; c += 512) { const int row = c >> 5, ch = c & 31; const bf16_t* src = H5 + (size_t)(tok0 + row) * EIN + 1024 + h * 256 + ch * 8;
            *(LAS u32x4*)(Kt + row * RRS + ch * 16) = *(const u32x4*)src; *(LAS u32x4*)(Vt + row * RRS + ch * 16) = *(const u32x4*)(src + 1024); }
        const int i = 16 * w + r;
        bf16x8 Qf[8];
        { const bf16_t* qp = H5 + (size_t)(tok0 + i) * EIN + h * 256 + 8 * g4;
#pragma unroll
          for (int kk = 0; kk < 8; ++kk) Qf[kk] = *(const bf16x8*)(qp + 32 * kk); }
        __syncthreads();
        u32x2 P[8];
#pragma unroll
        for (int tj = 0; tj < 8; ++tj) {
            P[tj] = (u32x2){0u, 0u};
            if (tj <= w) { f32x4 acc = (f32x4){0.f, 0.f, 0.f, 0.f}; const LAS unsigned char* kp = Kt + (16 * tj + r) * RRS + 16 * g4;
#pragma unroll
                for (int kk = 0; kk < 8; ++kk) acc = mfma16(*(const LAS bf16x8*)(kp + 64 * kk), Qf[kk], acc);
                float pv[4];
#pragma unroll
                for (int jj = 0; jj < 4; ++jj) { const int j = 16 * tj + 4 * g4 + jj; pv[jj] = (i >= j) ? acc[jj] * 0.0625f * __builtin_amdgcn_exp2f(lg2 * (float)(i - j)) : 0.f; }
                P[tj].x = pk2(pv[0], pv[1]); P[tj].y = pk2(pv[2], pv[3]); }
        }
        __syncthreads();
        f32x4 acc[16];
#pragma unroll
        for (int te = 0; te < 16; ++te) acc[te] = (f32x4){0.f, 0.f, 0.f, 0.f};
        if (n > 0) {
#pragma unroll
            for (int half = 0; half < 2; ++half) {
                for (int c = F.tid; c < 128 * 32; c += 512) { const int row = c >> 5, ch = c & 31;
                    *(LAS u32x4*)(Kt + row * RRS + ch * 16) = *(const u32x4*)(PREVT + (size_t)u * 65536 + (size_t)(128 * half + row) * 256 + ch * 8); }
                __syncthreads();
#pragma unroll
                for (int te = 0; te < 8; ++te) { const LAS unsigned char* pq = Kt + (16 * te + r) * RRS + 16 * g4;
#pragma unroll
                    for (int kk = 0; kk < 8; ++kk) acc[8 * half + te] = mfma16(*(const LAS bf16x8*)(pq + 64 * kk), Qf[kk], acc[8 * half + te]);
                    asm volatile("" : "+v"(acc[8 * half + te])); }
                __syncthreads();
            }
            const float xi = __builtin_amdgcn_exp2f(lg2 * (float)(i + 1));
#pragma unroll
            for (int te = 0; te < 16; ++te) acc[te] = acc[te] * xi;
        }
#pragma unroll
        for (int pr = 0; pr < 4; ++pr) {
            if (2 * pr <= w) { const u32x4 bw = (u32x4){P[2 * pr].x, P[2 * pr].y, P[2 * pr + 1].x, P[2 * pr + 1].y}; const bf16x8 bfrag = __builtin_bit_cast(bf16x8, bw);
                const LAS unsigned char* v0 = Vt + (32 * pr + 4 * g4 + qq) * RRS + 8 * pp;
#pragma unroll
                for (int te = 0; te < 16; ++te) { acc[te] = mfma16(cat8(vtr(v0 + 32 * te), vtr(v0 + 16 * RRS + 32 * te)), bfrag, acc[te]); if ((te & 3) == 3) asm volatile("" : "+v"(acc[te])); } }
        }
        float s = 0.f;
#pragma unroll
        for (int te = 0; te < 16; ++te) s += (acc[te][0] + acc[te][1]) + (acc[te][2] + acc[te][3]);
        s += __shfl_xor(s, 16); s += __shfl_xor(s, 32);
        const float mean = s * (1.f / 256.f); float s2 = 0.f;
#pragma unroll
        for (int te = 0; te < 16; ++te) { acc[te] = acc[te] - mean; s2 += (acc[te][0] * acc[te][0] + acc[te][1] * acc[te][1]) + (acc[te][2] * acc[te][2] + acc[te][3] * acc[te][3]); }
        s2 += __shfl_xor(s2, 16); s2 += __shfl_xor(s2, 32);
        const float rstd = 1.0f / sqrtf(s2 * (1.f / 256.f) + LN_EPS);
        const bf16_t* gp = H5 + (size_t)(tok0 + i) * EIN + 3072 + h * 256 + 4 * g4; bf16_t* op = MIX + (size_t)(tok0 + i) * D + h * 256 + 4 * g4;
#pragma unroll
        for (int te = 0; te < 16; ++te) { const u32x2 gw = *(const u32x2*)(gp + 16 * te); float gv[4] = {bflo(gw.x), bfhi(gw.x), bflo(gw.y), bfhi(gw.y)}; float ov[4];
#pragma unroll
            for (int jj = 0; jj < 4; ++jj) { const float sg = gv[jj] / (1.0f + __builtin_amdgcn_exp2f(-gv[jj] * LOG2E)); ov[jj] = sg * acc[te][jj] * rstd; }
            u32x2 o; o.x = pk2(ov[0], ov[1]); o.y = pk2(ov[2], ov[3]); *(u32x2*)(op + 16 * te) = o; }
        __syncthreads();
    }
}

__global__ void __launch_bounds__(512, 2) fwd_megakernel(Args args) {
    extern __shared__ __attribute__((aligned(16))) unsigned char lds_raw[];
    cg::grid_group grid = cg::this_grid();
    Frame F; F.lds = (LAS unsigned char*)lds_raw; F.tid = threadIdx.x; F.lane = F.tid & 63; F.wave = __builtin_amdgcn_readfirstlane(F.tid >> 6); F.G = gridDim.x; F.bid = blockIdx.x;
    unsigned char* ws = args.ws;
    bf16_t* XB = (bf16_t*)(ws + WS_XB); float* Y = (float*)(ws + WS_Y); bf16_t* MIX = (bf16_t*)(ws + WS_MIX);
    float* HALO = (float*)(ws + WS_HF); bf16_t* ACT = (bf16_t*)(ws + WS_ACT); bf16_t* H5 = (bf16_t*)(ws + WS_H5); bf16_t* QKV = (bf16_t*)(ws + WS_QKV);
    float* KVT = (float*)(ws + WS_KVT); bf16_t* PREVT = (bf16_t*)(ws + WS_PREVT); bf16_t* POOLED = (bf16_t*)(ws + WS_POOLED);
    float* XF = args.out;

    for (int u = F.tid; u < (LDS_BYTES - MISC_OFF) / 4; u += 512) ((LAS unsigned*)(F.lds + MISC_OFF))[u] = 0u;
    __syncthreads();
    const XcdBarrier bar = xcd_barrier_post((unsigned*)(ws + WS_CTL), (volatile LAS unsigned*)(F.lds + MISC_OFF));
#define GRID_BAR() xcd_barrier(bar)

    p0_prologue(F, args);
    grid.sync();

    for (int layer = 0; layer < 4; ++layer) {
        const int li = layer >> 1;
        const float* xres = (layer == 0) ? args.in[0] : XF;
        if ((layer & 1) == 0) {
            {
                pg8::Gemm g{XB, (const bf16_t*)(ws + WS_EIN) + (size_t)li * EIN * D, D, D, D, 0}; pg8::StaticOrder S; S.init(M, EIN, F.G, F.bid);
                pg8::EpiBf16 E{H5, EIN, nullptr, nullptr, 0};
                pg8::gemm_phase<pg8::EpiBf16, true>(F.lds, g, S, E);
            }
            GRID_BAR();
            ret_kv_phase(F, H5, KVT);
            pooled_phase(F, H5, POOLED);
            GRID_BAR();
            ret_scan_phase(F, KVT, PREVT);
            {
                pg8::Gemm g{POOLED, (const bf16_t*)(ws + WS_POOLW) + (size_t)li * 1024 * 256, 1024, 256, 256, 256}; pg8::StaticOrder S; S.init(M, 1024, F.G, F.bid);
                pg8::EpiBf16 E{MIX, D, nullptr, args.in[5] + (size_t)li * 1024, 1024};
                pg8::gemm_phase<pg8::EpiBf16, true>(F.lds, g, S, E);
            }
            GRID_BAR();
            ret_out_phase(F, H5, PREVT, MIX);
            GRID_BAR();
            {
                pg8::Gemm g{MIX, (const bf16_t*)(ws + WS_EOUT) + (size_t)li * D * D, D, D, D, 0}; pg8::StaticOrder S; S.init(M, D, F.G, F.bid);
                pg8::EpiRes E{xres, Y};
                pg8::gemm_phase<pg8::EpiRes, true>(F.lds, g, S, E);
            }
        } else {
            {
                pg8::Gemm g{XB, (const bf16_t*)(ws + WS_QKVW) + (size_t)li * OIN * D, D, D, D, 0}; pg8::StaticOrder S; S.init(M, OIN, F.G, F.bid);
                pg8::EpiBf16 E{QKV, OIN, args.in[8] + (size_t)li * OIN, nullptr, 0};
                pg8::gemm_phase<pg8::EpiBf16, true>(F.lds, g, S, E);
            }
            GRID_BAR();
            attn_phase(F, QKV, args.in[9] + li * 32, MIX);
            GRID_BAR();
            {
                pg8::Gemm g{MIX, (const bf16_t*)(ws + WS_AOUT) + (size_t)li * D * D, D, D, D, 0}; pg8::StaticOrder S; S.init(M, D, F.G, F.bid);
                pg8::EpiRes E{xres, Y};
                pg8::gemm_phase<pg8::EpiRes, true>(F.lds, g, S, E);
            }
        }
        GRID_BAR();
        ln_phase(F, Y, args.in[1] + (size_t)(layer * 2 + 0) * D, args.in[2] + (size_t)(layer * 2 + 0) * D, XF, XB);
        GRID_BAR();
        {
            pg8::Gemm g{XB, (const bf16_t*)(ws + WS_F1) + (size_t)layer * FF2 * D, D, D, D, 0}; pg8::StaticOrder S; S.init(M, FF2, F.G, F.bid);
            pg8::EpiConvGlu E{ACT, HALO, args.in[12] + (size_t)layer * 3 * FF2, args.in[13] + (size_t)layer * FF2, (LAS float*)(F.lds + 131072)};
            pg8::gemm_phase<pg8::EpiConvGlu, true>(F.lds, g, S, E);
        }
        GRID_BAR();
        conv_fixup_phase(F, HALO, args.in[12] + (size_t)layer * 3 * FF2, args.in[13] + (size_t)layer * FF2, ACT);
        GRID_BAR();
        {
            pg8::Gemm g{ACT, (const bf16_t*)(ws + WS_F2) + (size_t)layer * D * FF, FF, FF, FF, 0}; pg8::StaticOrder S; S.init(M, D, F.G, F.bid);
            pg8::EpiRes E{XF, Y};
            pg8::gemm_phase<pg8::EpiRes, true>(F.lds, g, S, E);
        }
        GRID_BAR();
        ln_phase(F, Y, args.in[1] + (size_t)(layer * 2 + 1) * D, args.in[2] + (size_t)(layer * 2 + 1) * D, XF, XB);
        GRID_BAR();
    }
}

extern "C" void kernel_launch(void* const* d_in, const int* in_sizes, int n_in, void* d_out, int out_size, void* d_ws, size_t ws_size, hipStream_t stream) {
    static int grid = 0;
    if (grid == 0) {
        if (n_in != 15 || out_size != M * D || ws_size < WS_END) { fprintf(stderr, "kernel_launch: unexpected problem: n_in %d out %d ws %zu (need %zu)\n", n_in, out_size, ws_size, (size_t)WS_END); grid = -1; return; }
        int dev = 0, cus = 0, per_cu = 0;
        hipGetDevice(&dev); hipDeviceGetAttribute(&cus, hipDeviceAttributeMultiprocessorCount, dev);
        if (hipFuncSetAttribute((const void*)fwd_megakernel, hipFuncAttributeMaxDynamicSharedMemorySize, LDS_BYTES) != hipSuccess) { fprintf(stderr, "kernel_launch: hipFuncSetAttribute failed\n"); grid = -1; return; }
        if (hipOccupancyMaxActiveBlocksPerMultiprocessor(&per_cu, (const void*)fwd_megakernel, 512, LDS_BYTES) != hipSuccess || per_cu < 1) { fprintf(stderr, "kernel_launch: occupancy query says %d\n", per_cu); per_cu = 1; }
        (void)hipGetLastError();
        grid = cus;
    }
    if (grid < 0) return;
    Args a{};
    for (int i = 0; i < 15; ++i) a.in[i] = (const float*)d_in[i];
    a.out = (float*)d_out; a.ws = (unsigned char*)d_ws;
    if (hipMemsetAsync((char*)d_ws + WS_CTL, 0, CTL_BYTES, stream) != hipSuccess) { fprintf(stderr, "kernel_launch: memset failed\n"); return; }
    void* kargs[] = {&a};
    hipError_t e = hipLaunchCooperativeKernel((const void*)fwd_megakernel, dim3(grid), dim3(512), kargs, LDS_BYTES, stream);
    if (e != hipSuccess) fprintf(stderr, "kernel_launch: cooperative launch failed: %s (grid %d)\n", hipGetErrorString(e), grid);
}
```

```cpp
#include <hip/hip_runtime.h>
#include <hip/hip_cooperative_groups.h>
#include <cstdio>
#include <cstdint>
namespace cg = cooperative_groups;

#define LAS __attribute__((address_space(3)))
typedef unsigned short bf16_t;
typedef short bf16x8 __attribute__((ext_vector_type(8)));
typedef short s16x4 __attribute__((ext_vector_type(4)));
typedef float f32x4 __attribute__((ext_vector_type(4)));
typedef float f32x2 __attribute__((ext_vector_type(2)));
typedef unsigned u32x4 __attribute__((ext_vector_type(4)));
typedef unsigned u32x2 __attribute__((ext_vector_type(2)));
typedef __bf16 bf16x2_t __attribute__((ext_vector_type(2)));

constexpr int NBATCH = 4, SEQ = 4096, M = NBATCH * SEQ, D = 2048;
constexpr int EIN = 5120, OIN = 2560, FF = 5632, FF2 = 11264;
constexpr float ALPHA = 1.6817928305074290f;
constexpr float LN_EPS = 1e-5f;
constexpr float LOG2E = 1.4426950408889634f;

constexpr size_t MiB = 1u << 20;
constexpr size_t WS_EIN = 0 * MiB;
constexpr size_t WS_EOUT = 40 * MiB;
constexpr size_t WS_POOLW = 56 * MiB;
constexpr size_t WS_QKVW = 57 * MiB;
constexpr size_t WS_AOUT = 77 * MiB;
constexpr size_t WS_F1 = 93 * MiB;
constexpr size_t WS_F2 = 269 * MiB;
constexpr size_t WS_XB = 357 * MiB;
constexpr size_t WS_Y = 421 * MiB;
constexpr size_t WS_MIX = 549 * MiB;
constexpr size_t WS_BIG = 613 * MiB;
constexpr size_t WS_HF = WS_BIG;
constexpr size_t WS_ACT = WS_BIG + 352 * MiB;
constexpr size_t WS_H5 = WS_BIG;
constexpr size_t WS_QKV = WS_BIG;
constexpr size_t WS_KVT = WS_BIG + 160 * MiB;
constexpr size_t WS_PREVT = WS_BIG + 288 * MiB;
constexpr size_t WS_POOLED = WS_BIG + 352 * MiB;
constexpr size_t WS_CTL = 1141 * MiB;
constexpr size_t CTL_BYTES = 256 * 1024;
constexpr int CW_LN = 4096;
constexpr size_t WS_XCH = 1142 * MiB;
constexpr size_t WS_END = 1150 * MiB;
constexpr int MISC_OFF = 143360;

constexpr int LDS_BYTES = 147456;

__device__ __forceinline__ unsigned pk2(float lo, float hi) { f32x2 v = {lo, hi}; bf16x2_t b = __builtin_convertvector(v, bf16x2_t); return __builtin_bit_cast(unsigned, b); }
__device__ __forceinline__ float bflo(unsigned w) { return __uint_as_float(w << 16); }
__device__ __forceinline__ float bfhi(unsigned w) { return __uint_as_float(w & 0xffff0000u); }
__device__ __forceinline__ float wave_sum(float v) {
#pragma unroll
    for (int o = 1; o < 64; o <<= 1) v += __shfl_xor(v, o);
    return v;
}
typedef short v4i16_t __attribute__((ext_vector_type(4)));
__device__ __forceinline__ s16x4 vtr(const LAS unsigned char* p) { return __builtin_bit_cast(s16x4, __builtin_amdgcn_ds_read_tr16_b64_v4i16((LAS v4i16_t*)p)); }
__device__ __forceinline__ bf16x8 cat8(s16x4 lo, s16x4 hi) { return (bf16x8){lo[0], lo[1], lo[2], lo[3], hi[0], hi[1], hi[2], hi[3]}; }
__device__ __forceinline__ f32x4 mfma16(bf16x8 a, bf16x8 b, f32x4 c) { return __builtin_amdgcn_mfma_f32_16x16x32_bf16(a, b, c, 0, 0, 0); }
__device__ __forceinline__ f32x2 gelu_pk(f32x2 v) {
    const f32x2 av = __builtin_elementwise_abs(v), d = av * 0.2316418882f + 1.0f;
    f32x2 t; t.x = __builtin_amdgcn_rcpf(d.x); t.y = __builtin_amdgcn_rcpf(d.y);
    f32x2 q = t * 0.5307027145f + (-0.7265760135f); q = q * t + 0.7107068705f; q = q * t + (-0.142248368f); q = q * t + 0.127414796f; q = q * t;
    const f32x2 s = (v * v) * (-0.72134752044f);
    f32x2 e; e.x = __builtin_amdgcn_exp2f(s.x); e.y = __builtin_amdgcn_exp2f(s.y);
    const f32x2 m = v * (q * e), r = v - m;
    f32x2 o; o.x = v.x < 0.f ? m.x : r.x; o.y = v.y < 0.f ? m.y : r.y; return o;
}

namespace pg8 {
constexpr int BM = 256, BK = 64, HALF = 128, HTB = HALF * BK * 2, STAGE_BYTES = 8 * HTB, NXCD = 8, WGM = 8;
__host__ __device__ __forceinline__ int lds_byte(int r, int c) { const int st = (r >> 4) * 2 + (c >> 5), rr = r & 15, cc = c & 31, ob = rr * 64 + cc * 2; return st * 1024 + (ob ^ (((ob >> 9) & 1) << 5)); }
__host__ __device__ __forceinline__ void stage_rc(int b, int& R, int& C) { const int st = b / 1024, sb = b % 1024, swz = sb ^ (((sb >> 9) & 1) << 5); R = (st >> 1) * 16 + swz / 64; C = (st & 1) * 32 + (swz % 64) / 2; }
__host__ __device__ __forceinline__ int perm32(int rho) { const int n = rho >> 4, i = rho & 15; return 8 * (i >> 2) + 4 * n + (i & 3); }

struct Unit { int pm, pn; };
struct Gemm { const bf16_t* A; const bf16_t* Bt; int lda, ldb, K, a_pn_off; };

struct StaticOrder {
    int nM, nN, nwg, G, c;
    __device__ void init(int M_, int N_, int G_, int c_) { nM = M_ / BM; nN = N_ / BM; nwg = nM * nN; G = G_; c = c_; }
    __device__ bool next(int i, Unit& u) const {
        const long L = (long)i * G + c; if (L >= nwg) return false;
        int wgid = (int)L; { const int q = nwg / NXCD, r = nwg % NXCD, xcd = wgid % NXCD, off = wgid / NXCD; wgid = (xcd < r ? xcd * (q + 1) : r * (q + 1) + (xcd - r) * q) + off; }
        const int nig = WGM * nN, gid = wgid / nig, fm = gid * WGM, gsz = (nM - fm) < WGM ? (nM - fm) : WGM;
        u.pm = fm + ((wgid % nig) % gsz); u.pn = (wgid % nig) / gsz; return true;
    }
};

struct EpiBf16 {
    static constexpr bool PERM = true;
    bf16_t* O; int ldc; const float* bias; const float* scale; int ocol_off;
    __device__ __forceinline__ void operator()(f32x4 (&acc)[2][2][4][2], const Unit& u, int wr, int wc, int fr, int fq, int wid, int lane) const {
        const int row0 = u.pm * BM + wr * 64 + fr; const int bcol0 = u.pn * BM + wc * 32 + 8 * fq; const int col0 = ocol_off + bcol0;
        f32x4 bv[2][2], sv[2][2];
#pragma unroll
        for (int bj = 0; bj < 2; ++bj)
#pragma unroll
            for (int n = 0; n < 2; ++n) { bv[bj][n] = bias ? *(const f32x4*)(bias + bcol0 + bj * HALF + 4 * n) : (f32x4){0.f, 0.f, 0.f, 0.f};
                                          sv[bj][n] = scale ? *(const f32x4*)(scale + bcol0 + bj * HALF + 4 * n) : (f32x4){1.f, 1.f, 1.f, 1.f}; }
#pragma unroll
        for (int ai = 0; ai < 2; ++ai)
#pragma unroll
            for (int m = 0; m < 4; ++m) { bf16_t* rowp = O + (size_t)(row0 + ai * HALF + m * 16) * ldc + col0;
#pragma unroll
                for (int bj = 0; bj < 2; ++bj) { f32x4 v0 = (acc[ai][bj][m][0] + bv[bj][0]) * sv[bj][0], v1 = (acc[ai][bj][m][1] + bv[bj][1]) * sv[bj][1];
                    u32x4 w; w.x = pk2(v0[0], v0[1]); w.y = pk2(v0[2], v0[3]); w.z = pk2(v1[0], v1[1]); w.w = pk2(v1[2], v1[3]);
                    *(u32x4*)(rowp + bj * HALF) = w; } }
    }
};
struct EpiRes {
    static constexpr bool PERM = false;
    const float* X; float* Y;
    __device__ __forceinline__ void operator()(f32x4 (&acc)[2][2][4][2], const Unit& u, int wr, int wc, int fr, int fq, int wid, int lane) const {
        const int row0 = u.pm * BM + wr * 64 + fr, col0 = u.pn * BM + wc * 32 + 4 * fq;
#pragma unroll
        for (int ai = 0; ai < 2; ++ai)
#pragma unroll
            for (int m = 0; m < 4; ++m) { const size_t off = (size_t)(row0 + ai * HALF + m * 16) * D + col0;
#pragma unroll
                for (int bj = 0; bj < 2; ++bj)
#pragma unroll
                    for (int n = 0; n < 2; ++n) { const f32x4 xv = *(const f32x4*)(X + off + bj * HALF + n * 16); *(f32x4*)(Y + off + bj * HALF + n * 16) = xv * ALPHA + acc[ai][bj][m][n]; }
                asm volatile("" ::: "memory"); }
    }
};

__device__ __forceinline__ float dpp_ror1(float v) { return __int_as_float(__builtin_amdgcn_update_dpp(0, __float_as_int(v), 0x121, 0xf, 0xf, false)); }
__device__ __forceinline__ float dpp_ror2(float v) { return __int_as_float(__builtin_amdgcn_update_dpp(0, __float_as_int(v), 0x122, 0xf, 0xf, false)); }
struct EpiConvGlu {
    static constexpr bool PERM = true;
    bf16_t* ACT; float* HALO; const float* cw; const float* cb; LAS float* xbuf;
    __device__ __forceinline__ void operator()(f32x4 (&acc)[2][2][4][2], const Unit& u, int wr, int wc, int fr, int fq, int wid, int lane) const {
        const int cl = 32 * wc + 8 * fq;
        if (fr >= 14) {
#pragma unroll
            for (int ai = 0; ai < 2; ++ai)
#pragma unroll
                for (int bj = 0; bj < 2; ++bj)
#pragma unroll
                    for (int n = 0; n < 2; ++n) *(LAS f32x4*)(xbuf + ((((ai * 2 + wr) * 2 + bj) * 2 + (fr - 14)) * 128 + cl + 4 * n)) = acc[ai][bj][3][n];
        }
        if (wr == 0 && fr < 2) {
#pragma unroll
            for (int bj = 0; bj < 2; ++bj)
#pragma unroll
                for (int n = 0; n < 2; ++n) *(f32x4*)(HALO + (size_t)(u.pm * 4 + fr) * FF2 + u.pn * 256 + bj * 128 + cl + 4 * n) = acc[0][bj][0][n];
        }
        if (wr == 1 && fr >= 14) {
#pragma unroll
            for (int bj = 0; bj < 2; ++bj)
#pragma unroll
                for (int n = 0; n < 2; ++n) *(f32x4*)(HALO + (size_t)(u.pm * 4 + fr - 12) * FF2 + u.pn * 256 + bj * 128 + cl + 4 * n) = acc[1][bj][3][n];
        }
        asm volatile("s_waitcnt lgkmcnt(0)" ::: "memory"); __builtin_amdgcn_s_barrier(); asm volatile("" ::: "memory");
        const int row0 = u.pm * BM + wr * 64 + fr;
#pragma unroll
        for (int n = 0; n < 2; ++n) {
            const int ch = u.pn * 128 + cl + 4 * n;
            f32x4 w[2][3], bb[2];
#pragma unroll
            for (int bj = 0; bj < 2; ++bj) { bb[bj] = *(const f32x4*)(cb + bj * FF + ch);
#pragma unroll
                for (int k = 0; k < 3; ++k) w[bj][k] = *(const f32x4*)(cw + (size_t)k * FF2 + bj * FF + ch); }
#pragma unroll
            for (int ai = 0; ai < 2; ++ai)
#pragma unroll
                for (int m = 0; m < 4; ++m) {
                    f32x4 cv[2];
#pragma unroll
                    for (int bj = 0; bj < 2; ++bj) {
                        const f32x4 cur = acc[ai][bj][m][n]; f32x4 p1, p2;
                        if (m > 0) { const f32x4 pb = acc[ai][bj][m > 0 ? m - 1 : 0][n];
#pragma unroll
                            for (int j = 0; j < 4; ++j) { const float a1 = dpp_ror1(cur[j]), a2 = dpp_ror2(cur[j]), b1 = dpp_ror1(pb[j]), b2 = dpp_ror2(pb[j]); p1[j] = fr >= 1 ? a1 : b1; p2[j] = fr >= 2 ? a2 : b2; }
                        } else {
                            f32x4 x1 = (f32x4){0.f, 0.f, 0.f, 0.f}, x2 = x1;
                            if (wr == 1 || ai == 1) { const int sai = (wr == 1) ? ai : 0, swr = (wr == 1) ? 0 : 1; const LAS float* xp = xbuf + (((sai * 2 + swr) * 2 + bj) * 2) * 128 + cl + 4 * n;
                                x1 = *(const LAS f32x4*)(xp + 128); x2 = *(const LAS f32x4*)(xp + (fr & 1) * 128); }
#pragma unroll
                            for (int j = 0; j < 4; ++j) { const float a1 = dpp_ror1(cur[j]), a2 = dpp_ror2(cur[j]); p1[j] = fr >= 1 ? a1 : x1[j]; p2[j] = fr >= 2 ? a2 : x2[j]; }
                        }
                        cv[bj] = bb[bj] + w[bj][0] * p2 + w[bj][1] * p1 + w[bj][2] * cur;
                    }
                    const f32x2 g0 = gelu_pk((f32x2){cv[0][0], cv[0][1]}), g1 = gelu_pk((f32x2){cv[0][2], cv[0][3]});
                    u32x2 o; o.x = pk2(g0.x * cv[1][0], g0.y * cv[1][1]); o.y = pk2(g1.x * cv[1][2], g1.y * cv[1][3]);
                    *(u32x2*)(ACT + (size_t)(row0 + ai * HALF + m * 16) * FF + ch) = o;
                }
        }
    }
};

struct PanelOrder {
    int c;
    __device__ bool next(int i, Unit& u) const { if (i >= 2) return false; const int x = c & 7, j = c >> 3; u.pm = 32 * i + 4 * x + (j & 3); u.pn = j >> 2; return true; }
};
struct EpiResLn {
    static constexpr bool PERM = false;
    const float* X; float* XF; bf16_t* XB; const float* g; const float* b; unsigned long long* slots; unsigned* cnt; LAS unsigned char* tl;
    __device__ __forceinline__ void operator()(f32x4 (&acc)[2][2][4][2], const Unit& u, int wr, int wc, int fr, int fq, int wid, int lane) const {
        LAS f32x2* P = (LAS f32x2*)tl; LAS f32x2* S = (LAS f32x2*)(tl + 8192);
        const int row0 = u.pm * BM + wr * 64 + fr, col0 = u.pn * BM + wc * 32 + 4 * fq;
#pragma unroll
        for (int ai = 0; ai < 2; ++ai)
#pragma unroll
            for (int m = 0; m < 4; ++m) { const size_t off = (size_t)(row0 + ai * HALF + m * 16) * D + col0;
#pragma unroll
                for (int bj = 0; bj < 2; ++bj)
#pragma unroll
                    for (int n = 0; n < 2; ++n) { const f32x4 xv = *(const f32x4*)(X + off + bj * HALF + n * 16); acc[ai][bj][m][n] = xv * ALPHA + acc[ai][bj][m][n]; }
                asm volatile("" : "+v"(acc[ai][0][m][0]), "+v"(acc[ai][0][m][1]), "+v"(acc[ai][1][m][0]), "+v"(acc[ai][1][m][1]));
                float s = 0.f;
#pragma unroll
                for (int bj = 0; bj < 2; ++bj)
#pragma unroll
                    for (int n = 0; n < 2; ++n) { const f32x4 x = acc[ai][bj][m][n]; s += (x[0] + x[1]) + (x[2] + x[3]); }
                s += __shfl_xor(s, 16); s += __shfl_xor(s, 32);
                const float mw = s * (1.0f / 64.0f); float q = 0.f;
#pragma unroll
                for (int bj = 0; bj < 2; ++bj)
#pragma unroll
                    for (int n = 0; n < 2; ++n) { const f32x4 d = acc[ai][bj][m][n] - mw; q += (d[0] * d[0] + d[1] * d[1]) + (d[2] * d[2] + d[3] * d[3]); }
                q += __shfl_xor(q, 16); q += __shfl_xor(q, 32);
                if (fq == 0) P[(ai * HALF + wr * 64 + m * 16 + fr) * 4 + wc] = (f32x2){mw, q};
            }
        asm volatile("s_waitcnt lgkmcnt(0)" ::: "memory"); __builtin_amdgcn_s_barrier(); asm volatile("" ::: "memory");
        const int row = wid * 32 + (lane & 31);
        unsigned long long* slot = slots + ((size_t)(u.pm * BM + row) * 8);
        if (lane < 32) {
            const f32x2 a = P[row * 4 + 0], b4 = P[row * 4 + 1], c = P[row * 4 + 2], d = P[row * 4 + 3];
            const float mt = (a.x + b4.x + c.x + d.x) * 0.25f;
            const float da = a.x - mt, db = b4.x - mt, dc = c.x - mt, dd = d.x - mt;
            const float m2 = (a.y + b4.y) + (c.y + d.y) + 64.0f * ((da * da + db * db) + (dc * dc + dd * dd));
            __hip_atomic_store(slot + u.pn, ((unsigned long long)__float_as_uint(m2) << 32) | __float_as_uint(mt), __ATOMIC_RELAXED, __HIP_MEMORY_SCOPE_AGENT);
        }
        asm volatile("s_waitcnt vmcnt(0)" ::: "memory");
        unsigned* cw = cnt + 64 * u.pm;
        if (lane == 0) __hip_atomic_fetch_add(cw, 1u, __ATOMIC_RELAXED, __HIP_MEMORY_SCOPE_AGENT);
        if (wid == 0) {
            unsigned sp = 0;
            while ((unsigned)__builtin_amdgcn_readfirstlane(__hip_atomic_load(cw, __ATOMIC_RELAXED, __HIP_MEMORY_SCOPE_AGENT)) < 64u) { __builtin_amdgcn_s_sleep(1); if (++sp > (1u << 24)) break; }
            __builtin_amdgcn_fence(__ATOMIC_ACQUIRE, "agent");
        }
        asm volatile("s_waitcnt vmcnt(0) lgkmcnt(0)" ::: "memory"); __builtin_amdgcn_s_barrier(); asm volatile("" ::: "memory");
        if (lane < 32) {
            float mt[8], m2[8]; float ms = 0.f;
#pragma unroll
            for (int t = 0; t < 8; ++t) { const unsigned long long w = __hip_atomic_load(slot + t, __ATOMIC_RELAXED, __HIP_MEMORY_SCOPE_AGENT); mt[t] = __uint_as_float((unsigned)w); m2[t] = __uint_as_float((unsigned)(w >> 32)); ms += mt[t]; }
            const float mean = ms * 0.125f; float q = 0.f;
#pragma unroll
            for (int t = 0; t < 8; ++t) { const float dm = mt[t] - mean; q += m2[t] + 256.0f * dm * dm; }
            S[row] = (f32x2){mean, 1.0f / sqrtf(q * (1.0f / 2048.0f) + LN_EPS)};
        }
        asm volatile("s_waitcnt lgkmcnt(0)" ::: "memory"); __builtin_amdgcn_s_barrier(); asm volatile("" ::: "memory");
#pragma unroll
        for (int bj = 0; bj < 2; ++bj)
#pragma unroll
            for (int n = 0; n < 2; ++n) { const f32x4 gg = *(const f32x4*)(g + col0 + bj * HALF + n * 16), bb = *(const f32x4*)(b + col0 + bj * HALF + n * 16);
#pragma unroll
                for (int ai = 0; ai < 2; ++ai)
#pragma unroll
                    for (int m = 0; m < 4; ++m) { const int r = ai * HALF + wr * 64 + m * 16 + fr; const f32x2 sr = S[r]; const size_t off = (size_t)(u.pm * BM + r) * D + col0 + bj * HALF + n * 16;
                        const f32x4 o = (acc[ai][bj][m][n] - sr.x) * sr.y * gg + bb; *(f32x4*)(XF + off) = o; u32x2 w; w.x = pk2(o[0], o[1]); w.y = pk2(o[2], o[3]); *(u32x2*)(XB + off) = w; } }
    }
};

template <class Epi, class Sched, bool ALIGN_EPI = true>
__device__ __forceinline__ void gemm_phase(LAS unsigned char* lds, const Gemm g, const Sched& S, const Epi& E) {
    int tid = threadIdx.x; asm volatile("" : "+v"(tid));
    const int wid = __builtin_amdgcn_readfirstlane(tid >> 6), lane = tid & 63, wr = wid >> 2, wc = wid & 3, fr = lane & 15, fq = lane >> 4;
    const int K = g.K, nt = K / BK;
    unsigned voffA[2], voffB[2];
#pragma unroll
    for (int i = 0; i < 2; ++i) { int R, C; stage_rc(tid * 16 + i * 8192, R, C); const int Rb = Epi::PERM ? ((R & ~31) + perm32(R & 31)) : R;
        voffA[i] = (unsigned)(R * g.lda + C) * 2u; voffB[i] = (unsigned)(Rb * g.ldb + C) * 2u; }
    const size_t kstep = (size_t)(BK * 2);
    const size_t hA = (size_t)HALF * g.lda * 2, hB = (size_t)HALF * g.ldb * 2;
    const unsigned ldsw = (unsigned)wid * 1024u;
    const int aoff = lds_byte(wr * 64 + fr, fq * 8), boff = lds_byte(wc * 32 + fr, fq * 8);
#define PG8_SA(b, h) (((b) * 2 + (h)) * HTB)
#define PG8_SB(b, h) ((4 + (b) * 2 + (h)) * HTB)
#define PG8_STAGE(bufoff, gbase, voff) do { _Pragma("unroll") for (int _i = 0; _i < 2; ++_i) \
        __builtin_amdgcn_global_load_lds((const unsigned*)((const char*)(gbase) + (voff)[_i]), (LAS unsigned*)(lds + (bufoff) + ldsw + _i * 8192), 16, 0, 0); } while (0)
#define PG8_LDA(dst, b, h) do { _Pragma("unroll") for (int m = 0; m < 4; ++m) _Pragma("unroll") for (int k = 0; k < 2; ++k) dst[m][k] = *(const LAS bf16x8*)(lds + PG8_SA(b, h) + aoff + m * 2048 + k * 1024); } while (0)
#define PG8_LDB(dst, b, h) do { _Pragma("unroll") for (int n = 0; n < 2; ++n) _Pragma("unroll") for (int k = 0; k < 2; ++k) dst[n][k] = *(const LAS bf16x8*)(lds + PG8_SB(b, h) + boff + n * 2048 + k * 1024); } while (0)
#define PG8_MMA(ai, bj, At, Bt) do { __builtin_amdgcn_s_setprio(1); _Pragma("unroll") for (int m = 0; m < 4; ++m) _Pragma("unroll") for (int n = 0; n < 2; ++n) _Pragma("unroll") for (int k = 0; k < 2; ++k) \
        acc[ai][bj][m][n] = __builtin_amdgcn_mfma_f32_16x16x32_bf16(Bt[n][k], At[m][k], acc[ai][bj][m][n], 0, 0, 0); __builtin_amdgcn_s_setprio(0); } while (0)
#define PG8_WAIT_V(n) asm volatile("s_waitcnt vmcnt(" #n ")" ::: "memory")
#define PG8_WAIT_L(n) asm volatile("s_waitcnt lgkmcnt(" #n ")" ::: "memory")
#define PG8_BAR __builtin_amdgcn_s_barrier()
#define PG8_SCHED __builtin_amdgcn_sched_barrier(0)
    Unit cur, nxt; int ui = 0;
    if (!S.next(0, cur)) return;
    f32x4 acc[2][2][4][2];
#pragma unroll
    for (int a = 0; a < 2; ++a)
#pragma unroll
        for (int b = 0; b < 2; ++b)
#pragma unroll
            for (int m = 0; m < 4; ++m)
#pragma unroll
                for (int n = 0; n < 2; ++n) acc[a][b][m][n] = (f32x4){0.f, 0.f, 0.f, 0.f};
    bf16x8 At[4][2], B0[2][2], B1[2][2];
    const char* cA = (const char*)g.A + ((size_t)cur.pm * BM * g.lda + (size_t)cur.pn * g.a_pn_off) * 2; const char* cB = (const char*)g.Bt + (size_t)cur.pn * BM * g.ldb * 2;
    PG8_STAGE(PG8_SB(0, 0), cB, voffB); PG8_STAGE(PG8_SB(0, 1), cB + hB, voffB); PG8_STAGE(PG8_SA(0, 0), cA, voffA); PG8_STAGE(PG8_SA(0, 1), cA + hA, voffA);
    if (wr == 1) PG8_BAR;
    PG8_WAIT_V(2); PG8_BAR;
    PG8_STAGE(PG8_SB(1, 0), cB + kstep, voffB); PG8_STAGE(PG8_SA(1, 0), cA + kstep, voffA); PG8_STAGE(PG8_SB(1, 1), cB + hB + kstep, voffB);
    PG8_WAIT_V(6); PG8_BAR;
    for (;;) {
        const bool has_next = S.next(ui + 1, nxt);
        const char* nA = has_next ? (const char*)g.A + ((size_t)nxt.pm * BM * g.lda + (size_t)nxt.pn * g.a_pn_off) * 2 : cA; const char* nB = has_next ? (const char*)g.Bt + (size_t)nxt.pn * BM * g.ldb * 2 : cB;
        for (int t = 0; t < nt; t += 2) {
            const bool last = (t == nt - 2);
            const char* a1 = cA + (size_t)(t + 1) * kstep;
            const char* a2 = last ? nA : cA + (size_t)(t + 2) * kstep; const char* b2 = last ? nB : cB + (size_t)(t + 2) * kstep;
            const char* a3 = a2 + kstep; const char* b3 = b2 + kstep;
            PG8_LDB(B0, 0, 0); PG8_LDB(B1, 0, 1); PG8_SCHED; PG8_LDA(At, 0, 0); PG8_STAGE(PG8_SA(1, 1), a1 + hA, voffA);
            PG8_WAIT_V(8); PG8_WAIT_L(0); PG8_BAR; PG8_MMA(0, 0, At, B0); PG8_MMA(0, 1, At, B1); PG8_BAR; PG8_SCHED;
            PG8_LDA(At, 0, 1); PG8_STAGE(PG8_SB(0, 0), b2, voffB); PG8_STAGE(PG8_SB(0, 1), b2 + hB, voffB); PG8_STAGE(PG8_SA(0, 0), a2, voffA);
            PG8_WAIT_V(8); PG8_WAIT_L(0); PG8_BAR; PG8_MMA(1, 0, At, B0); PG8_MMA(1, 1, At, B1); PG8_BAR; PG8_SCHED;
            PG8_LDB(B0, 1, 0); PG8_LDB(B1, 1, 1); PG8_SCHED; PG8_LDA(At, 1, 0); PG8_STAGE(PG8_SA(0, 1), a2 + hA, voffA);
            PG8_WAIT_V(8); PG8_WAIT_L(0); PG8_BAR; PG8_MMA(0, 0, At, B0); PG8_MMA(0, 1, At, B1); PG8_BAR; PG8_SCHED;
            PG8_LDA(At, 1, 1); PG8_STAGE(PG8_SB(1, 0), b3, voffB); PG8_STAGE(PG8_SB(1, 1), b3 + hB, voffB); PG8_STAGE(PG8_SA(1, 0), a3, voffA);
            PG8_WAIT_V(8); PG8_WAIT_L(0); PG8_BAR; PG8_MMA(1, 0, At, B0); PG8_MMA(1, 1, At, B1); PG8_BAR; PG8_SCHED;
        }
        if constexpr (ALIGN_EPI) { if (wr == 0) PG8_BAR; }
        E(acc, cur, wr, wc, fr, fq, wid, lane);
        if (!has_next) break;
#pragma unroll
        for (int a = 0; a < 2; ++a)
#pragma unroll
            for (int b = 0; b < 2; ++b)
#pragma unroll
                for (int m = 0; m < 4; ++m)
#pragma unroll
                    for (int n = 0; n < 2; ++n) acc[a][b][m][n] = (f32x4){0.f, 0.f, 0.f, 0.f};
        cur = nxt; cA = nA; cB = nB; ++ui;
        if constexpr (ALIGN_EPI) { if (wr == 1) PG8_BAR; }
    }
    PG8_WAIT_V(0);
    if constexpr (!ALIGN_EPI) { if (wr == 0) PG8_BAR; }
    PG8_BAR;
#undef PG8_SA
#undef PG8_SB
#undef PG8_STAGE
#undef PG8_LDA
#undef PG8_LDB
#undef PG8_MMA
#undef PG8_WAIT_V
#undef PG8_WAIT_L
#undef PG8_BAR
#undef PG8_SCHED
}
}

#define XB_TMO      128
#define XB_XCNT(j)  (256  + 64 * (j))
#define XB_XSUB(j)  (1280 + 64 * (j))
#define XB_XGEN(j)  (2304 + 64 * (j))
#define XB_TOP      3328
#define XB_TOPGEN   3392
#define XCD_BAR_WORDS 3456
#define XB_SPIN_CAP (1u << 22)
__device__ __forceinline__ unsigned xb_ld(unsigned* p)              { return __hip_atomic_load(p, __ATOMIC_RELAXED, __HIP_MEMORY_SCOPE_AGENT); }
__device__ __forceinline__ unsigned xb_add(unsigned* p, unsigned v) { return __hip_atomic_fetch_add(p, v, __ATOMIC_RELAXED, __HIP_MEMORY_SCOPE_AGENT); }
__device__ __forceinline__ unsigned xb_xcc_id() { return (unsigned)__builtin_amdgcn_s_getreg((3 << 11) | 20) & 0xFu; }
#define XB_SPIN(cond, bar) do { unsigned _sp = 0; while (cond) { __builtin_amdgcn_s_sleep(1); \
    if ((++_sp & 255u) == 0u) { if (xb_ld(&(bar)[XB_TMO])) break; if (_sp > XB_SPIN_CAP) { atomicAdd(&(bar)[XB_TMO], 1u); break; } } } } while (0)
struct XcdBarrier { unsigned* bar; unsigned x; volatile LAS unsigned* st; };
__device__ __forceinline__ XcdBarrier xcd_barrier_post(unsigned* bar, volatile LAS unsigned* st) {
    XcdBarrier b; b.bar = bar; b.x = xb_xcc_id(); b.st = st;
    if (threadIdx.x == 0) (void)xb_add(&bar[XB_XCNT(b.x)], 1u);
    return b;
}
__device__ __forceinline__ void xcd_barrier_complete(unsigned* bar, unsigned x, unsigned& nloc, unsigned& nx) {
    const unsigned G = gridDim.x * gridDim.y * gridDim.z;
    unsigned sum, cnt, mine, sp = 0u;
    for (;;) {
        sum = 0u; cnt = 0u; mine = 0u;
#pragma unroll
        for (unsigned j = 0; j < 16; ++j) { const unsigned c = xb_ld(&bar[XB_XCNT(j)]); sum += c; cnt += (c > 0u) ? 1u : 0u; mine = (j == x) ? c : mine; }
        if (sum == G) break;
        __builtin_amdgcn_s_sleep(1);
        if ((++sp & 255u) == 0u) { if (xb_ld(&bar[XB_TMO])) break; if (sp > XB_SPIN_CAP) { atomicAdd(&bar[XB_TMO], 1u); break; } }
    }
    nloc = mine > 0u ? mine : 1u; nx = cnt > 0u ? cnt : 1u;
}
__device__ __forceinline__ void xcd_barrier(const XcdBarrier& b) {
    asm volatile("s_waitcnt vmcnt(0)" ::: "memory");
    __syncthreads();
    if (threadIdx.x == 0) {
        unsigned* bar = b.bar;
        __builtin_amdgcn_s_waitcnt(0);
        unsigned nloc = b.st[0], nx = b.st[1];
        if (nloc == 0u) { xcd_barrier_complete(bar, b.x, nloc, nx); b.st[0] = nloc; b.st[1] = nx; }
        const unsigned old = xb_add(&bar[XB_XSUB(b.x)], 1u);
        const unsigned gen = old / nloc;
        if (old + 1u == (gen + 1u) * nloc) {
            __builtin_amdgcn_fence(__ATOMIC_RELEASE, "agent");
            asm volatile("s_waitcnt vmcnt(0)" ::: "memory");
            const unsigned og = xb_add(&bar[XB_TOP], 1u);
            const unsigned tg = og / nx;
            if (og + 1u == (tg + 1u) * nx) xb_add(&bar[XB_TOPGEN], 1u);
            else XB_SPIN(xb_ld(&bar[XB_TOPGEN]) == tg, bar);
            __builtin_amdgcn_fence(__ATOMIC_ACQUIRE, "agent");
            xb_add(&bar[XB_XGEN(b.x)], 1u);
            asm volatile("s_waitcnt vmcnt(0)" ::: "memory");
        } else {
            XB_SPIN(xb_ld(&bar[XB_XGEN(b.x)]) == gen, bar);
            __builtin_amdgcn_fence(__ATOMIC_ACQUIRE, "agent");
            asm volatile("s_waitcnt vmcnt(0)" ::: "memory");
        }
    }
    __syncthreads();
}

struct Args { const float* in[15]; float* out; unsigned char* ws; };
struct Frame { LAS unsigned char* lds; int tid, lane, wave, G, bid; };
__device__ __forceinline__ Frame relaunder(const Frame& F0) { Frame F = F0; int t = F0.tid; asm volatile("" : "+v"(t)); F.tid = t; F.lane = t & 63; F.wave = __builtin_amdgcn_readfirstlane(t >> 6); return F; }

__device__ __forceinline__ void p0_item(const float* W, int K, int N, bf16_t* WT, int row_off, bool permff, LAS float* scr, int item, int lane) {
    const int nblk = N >> 6, kb = item / nblk, nb = item - kb * nblk, k0 = kb << 6, n0 = nb << 6;
    const float* src = W + (size_t)k0 * N + n0 + lane;
#pragma unroll 16
    for (int kk = 0; kk < 64; ++kk) scr[kk * 65 + lane] = src[(size_t)kk * N];
    asm volatile("s_waitcnt lgkmcnt(0)" ::: "memory");
    int orow0 = row_off + n0;
    if (permff) { orow0 = (n0 < FF) ? ((n0 >> 7) * 256 + (n0 & 127)) : (((n0 - FF) >> 7) * 256 + 128 + ((n0 - FF) & 127)); }
#pragma unroll
    for (int j = 0; j < 8; ++j) { const int id = lane + 64 * j, n = id >> 3, c = id & 7; const LAS float* s = scr + (8 * c) * 65 + n;
        u32x4 o; o.x = pk2(s[0 * 65], s[1 * 65]); o.y = pk2(s[2 * 65], s[3 * 65]); o.z = pk2(s[4 * 65], s[5 * 65]); o.w = pk2(s[6 * 65], s[7 * 65]);
        *(u32x4*)(WT + (size_t)(orow0 + n) * K + k0 + 8 * c) = o; }
    asm volatile("s_waitcnt lgkmcnt(0)" ::: "memory");
}
__device__ __forceinline__ void p0_prologue(const Frame& F0, const Args& a) {
    const Frame F = relaunder(F0);
    LAS float* scr = (LAS float*)(F.lds + F.wave * 16640);
    const int gw = F.bid * 8 + F.wave, NGW = F.G * 8;
    unsigned char* ws = a.ws;
    constexpr int I_EIN = (D / 64) * (EIN / 64), I_SQ = (D / 64) * (D / 64), I_PW = 16, I_QKV = (D / 64) * (OIN / 64), I_F1 = (D / 64) * (FF2 / 64), I_F2 = (FF / 64) * (D / 64);
    constexpr int T0 = 2 * I_EIN, T1 = T0 + 2 * I_SQ, T2 = T1 + 8 * I_PW, T3 = T2 + 2 * I_QKV, T4 = T3 + 2 * I_SQ, T5 = T4 + 4 * I_F1, T6 = T5 + 4 * I_F2;
    for (int it = gw; it < T6; it += NGW) {
        if (it < T0) { const int li = it / I_EIN, r = it - li * I_EIN; p0_item(a.in[3] + (size_t)li * D * EIN, D, EIN, (bf16_t*)(ws + WS_EIN) + (size_t)li * EIN * D, 0, false, scr, r, F.lane); }
        else if (it < T1) { const int x = it - T0, li = x / I_SQ, r = x - li * I_SQ; p0_item(a.in[6] + (size_t)li * D * D, D, D, (bf16_t*)(ws + WS_EOUT) + (size_t)li * D * D, 0, false, scr, r, F.lane); }
        else if (it < T2) { const int x = it - T1, lg = x / I_PW, r = x - lg * I_PW, li = lg >> 2, g = lg & 3; p0_item(a.in[4] + (size_t)lg * 65536, 256, 256, (bf16_t*)(ws + WS_POOLW) + (size_t)li * 1024 * 256, g * 256, false, scr, r, F.lane); }
        else if (it < T3) { const int x = it - T2, li = x / I_QKV, r = x - li * I_QKV; p0_item(a.in[7] + (size_t)li * D * OIN, D, OIN, (bf16_t*)(ws + WS_QKVW) + (size_t)li * OIN * D, 0, false, scr, r, F.lane); }
        else if (it < T4) { const int x = it - T3, li = x / I_SQ, r = x - li * I_SQ; p0_item(a.in[10] + (size_t)li * D * D, D, D, (bf16_t*)(ws + WS_AOUT) + (size_t)li * D * D, 0, false, scr, r, F.lane); }
        else if (it < T5) { const int x = it - T4, l = x / I_F1, r = x - l * I_F1; p0_item(a.in[11] + (size_t)l * D * FF2, D, FF2, (bf16_t*)(ws + WS_F1) + (size_t)l * FF2 * D, 0, true, scr, r, F.lane); }
        else { const int x = it - T5, l = x / I_F2, r = x - l * I_F2; p0_item(a.in[14] + (size_t)l * FF * D, FF, D, (bf16_t*)(ws + WS_F2) + (size_t)l * D * FF, 0, false, scr, r, F.lane); }
    }
    const f32x4* x4 = (const f32x4*)a.in[0]; u32x2* xb = (u32x2*)(ws + WS_XB);
    for (size_t i = (size_t)F.bid * 512 + F.tid; i < (size_t)M * D / 4; i += (size_t)F.G * 512) { const f32x4 v = x4[i]; u32x2 o; o.x = pk2(v[0], v[1]); o.y = pk2(v[2], v[3]); xb[i] = o; }
}

__device__ __forceinline__ void ln_phase(const Frame& F0, const float* Y, const float* g, const float* b, float* XF, bf16_t* XB) {
    const Frame F = relaunder(F0);
    const int gw = F.bid * 8 + F.wave, NGW = F.G * 8;
    for (int row = gw; row < M; row += NGW) {
        const f32x4* yr = (const f32x4*)(Y + (size_t)row * D) + F.lane;
        f32x4 v[8]; float s = 0.f;
#pragma unroll
        for (int j = 0; j < 8; ++j) { v[j] = yr[64 * j]; s += (v[j][0] + v[j][1]) + (v[j][2] + v[j][3]); }
        const float mean = wave_sum(s) * (1.f / D); float s2 = 0.f;
#pragma unroll
        for (int j = 0; j < 8; ++j) { v[j] = v[j] - mean; s2 += (v[j][0] * v[j][0] + v[j][1] * v[j][1]) + (v[j][2] * v[j][2] + v[j][3] * v[j][3]); }
        const float rstd = 1.0f / sqrtf(wave_sum(s2) * (1.f / D) + LN_EPS);
        f32x4* xo = (f32x4*)(XF + (size_t)row * D) + F.lane; u32x2* bo = (u32x2*)(XB + (size_t)row * D) + F.lane;
#pragma unroll
        for (int j = 0; j < 8; ++j) { const f32x4 gg = ((const f32x4*)g)[F.lane + 64 * j], bb = ((const f32x4*)b)[F.lane + 64 * j];
            const f32x4 o = v[j] * rstd * gg + bb; xo[64 * j] = o; u32x2 w; w.x = pk2(o[0], o[1]); w.y = pk2(o[2], o[3]); bo[64 * j] = w; }
    }
}

__device__ __forceinline__ void conv_fixup_phase(const Frame& F0, const float* HALO, const float* cw, const float* cb, bf16_t* ACT) {
    const Frame F = relaunder(F0);
    constexpr int NCQ = FF / 4;
    for (int it = F.bid * 512 + F.tid; it < 64 * NCQ; it += F.G * 512) {
        const int pm = it / NCQ, cq = it - pm * NCQ; if ((pm & 15) == 0) continue;
        const int c = cq * 4, col = (c >> 7) * 256 + (c & 127);
        f32x4 cv[2][2];
#pragma unroll
        for (int bj = 0; bj < 2; ++bj) {
            const float* hp = HALO + (size_t)(pm * 4) * FF2 + col + bj * 128;
            const f32x4 hm2 = *(const f32x4*)(hp - 2 * FF2), hm1 = *(const f32x4*)(hp - FF2), h0 = *(const f32x4*)hp, h1 = *(const f32x4*)(hp + FF2);
            const f32x4 w0 = *(const f32x4*)(cw + bj * FF + c), w1 = *(const f32x4*)(cw + (size_t)FF2 + bj * FF + c), w2 = *(const f32x4*)(cw + (size_t)2 * FF2 + bj * FF + c), b = *(const f32x4*)(cb + bj * FF + c);
            cv[bj][0] = b + w0 * hm2 + w1 * hm1 + w2 * h0; cv[bj][1] = b + w0 * hm1 + w1 * h0 + w2 * h1;
        }
#pragma unroll
        for (int rr = 0; rr < 2; ++rr) { const f32x2 g0 = gelu_pk((f32x2){cv[0][rr][0], cv[0][rr][1]}), g1 = gelu_pk((f32x2){cv[0][rr][2], cv[0][rr][3]});
            u32x2 o; o.x = pk2(g0.x * cv[1][rr][0], g0.y * cv[1][rr][1]); o.y = pk2(g1.x * cv[1][rr][2], g1.y * cv[1][rr][3]);
            *(u32x2*)(ACT + (size_t)(pm * 256 + rr) * FF + c) = o; }
    }
}

__device__ __forceinline__ void attn_phase(const Frame& F0, const bf16_t* QKV, const float* sinks, bf16_t* MIX) {
    const Frame F = relaunder(F0);
    constexpr int RS = 144;
    LAS unsigned char* Kt = F.lds; LAS unsigned char* Vt = F.lds + 256 * RS;
    const int lane = F.lane, r = lane & 15, g4 = lane >> 4, qq = r >> 2, pp = r & 3;
    for (int u = F.bid; u < 512; u += F.G) {
        const int kvh = u & 3, n = (u >> 2) & 31, b = u >> 7, tok0 = b * SEQ + n * 128;
        for (int c = F.tid; c < 256 * 8; c += 512) { const int row = c >> 3, ch = c & 7; const bool valid = (n > 0) || (row >= 128);
            u32x4 kv = (u32x4){0u, 0u, 0u, 0u}, vv = kv;
            if (valid) { const bf16_t* src = QKV + (size_t)(tok0 - 128 + row) * OIN + 2048 + kvh * 64 + ch * 8; kv = *(const u32x4*)src; vv = *(const u32x4*)(src + 256); }
            *(LAS u32x4*)(Kt + row * RS + ch * 16) = kv; *(LAS u32x4*)(Vt + row * RS + ch * 16) = vv; }
        __syncthreads();
        const int head = kvh * 8 + F.wave;
        const float slope2 = __builtin_amdgcn_exp2f(-0.25f * (float)(head + 1)) * LOG2E, sink2 = sinks[head] * LOG2E;
        for (int rb = 0; rb < 8; ++rb) {
            const bf16_t* qp = QKV + (size_t)(tok0 + 16 * rb + r) * OIN + head * 64 + 8 * g4;
            const bf16x8 q0 = *(const bf16x8*)qp, q1 = *(const bf16x8*)(qp + 32);
            f32x4 s[9];
#pragma unroll
            for (int tt = 0; tt < 9; ++tt) { const LAS unsigned char* kp = Kt + (16 * (rb + tt) + r) * RS + 16 * g4;
                f32x4 acc = (f32x4){0.f, 0.f, 0.f, 0.f};
                acc = mfma16(*(const LAS bf16x8*)kp, q0, acc); acc = mfma16(*(const LAS bf16x8*)(kp + 64), q1, acc); s[tt] = acc; }
            const int i = 16 * rb + r; float mx = -INFINITY;
#pragma unroll
            for (int tt = 0; tt < 9; ++tt)
#pragma unroll
                for (int jj = 0; jj < 4; ++jj) { const int j = 16 * (rb + tt) + 4 * g4 + jj, delta = 128 + i - j; const bool valid = (delta >= 0) && (delta < 128) && ((n > 0) || (j >= 128));
                    const float v = s[tt][jj] * (0.125f * LOG2E) - slope2 * (float)delta; s[tt][jj] = valid ? v : -INFINITY; mx = fmaxf(mx, s[tt][jj]); }
            mx = fmaxf(mx, __shfl_xor(mx, 16)); mx = fmaxf(mx, __shfl_xor(mx, 32)); mx = fmaxf(mx, sink2);
            float sum = 0.f;
#pragma unroll
            for (int tt = 0; tt < 9; ++tt)
#pragma unroll
                for (int jj = 0; jj < 4; ++jj) { const float p = __builtin_amdgcn_exp2f(s[tt][jj] - mx); s[tt][jj] = p; sum += p; }
            sum += __shfl_xor(sum, 16); sum += __shfl_xor(sum, 32);
            const float inv = 1.0f / (sum + __builtin_amdgcn_exp2f(sink2 - mx));
            u32x2 P[10];
#pragma unroll
            for (int tt = 0; tt < 9; ++tt) { P[tt].x = pk2(s[tt][0] * inv, s[tt][1] * inv); P[tt].y = pk2(s[tt][2] * inv, s[tt][3] * inv); }
            P[9] = (u32x2){0u, 0u};
            f32x4 o[4];
#pragma unroll
            for (int te = 0; te < 4; ++te) o[te] = (f32x4){0.f, 0.f, 0.f, 0.f};
#pragma unroll
            for (int pr = 0; pr < 5; ++pr) { const int t0 = 2 * pr, t1 = (pr < 4) ? 2 * pr + 1 : 2 * pr;
                const u32x4 bw = (u32x4){P[t0].x, P[t0].y, P[2 * pr + 1].x, P[2 * pr + 1].y}; const bf16x8 bfrag = __builtin_bit_cast(bf16x8, bw);
                const LAS unsigned char* v0 = Vt + (16 * (rb + t0) + 4 * g4 + qq) * RS + 8 * pp; const LAS unsigned char* v1 = Vt + (16 * (rb + t1) + 4 * g4 + qq) * RS + 8 * pp;
#pragma unroll
                for (int te = 0; te < 4; ++te) o[te] = mfma16(cat8(vtr(v0 + 32 * te), vtr(v1 + 32 * te)), bfrag, o[te]); }
            bf16_t* op = MIX + (size_t)(tok0 + i) * D + head * 64 + 4 * g4;
#pragma unroll
            for (int te = 0; te < 4; ++te) { u32x2 w; w.x = pk2(o[te][0], o[te][1]); w.y = pk2(o[te][2], o[te][3]); *(u32x2*)(op + 16 * te) = w; }
        }
        __syncthreads();
    }
}

__device__ __forceinline__ float ret_lg2(int h) { return __builtin_amdgcn_logf(1.0f - __builtin_amdgcn_exp2f(-5.0f - (float)h)); }
constexpr int RRS = 528;

__device__ __forceinline__ void ret_kv_phase(const Frame& F0, const bf16_t* H5, float* KVT) {
    const Frame F = relaunder(F0);
    LAS unsigned char* Kt = F.lds; LAS unsigned char* Vt = F.lds + 128 * RRS;
    const int lane = F.lane, r = lane & 15, g4 = lane >> 4, qq = r >> 2, pp = r & 3, w = F.wave;
    for (int u = F.bid; u < 512; u += F.G) {
        const int h = u & 3, n = (u >> 2) & 31, b = u >> 7, tok0 = b * SEQ + n * 128; const float lg2 = ret_lg2(h);
        for (int c = F.tid; c < 128 * 32; c += 512) { const int row = c >> 5, ch = c & 31; const bf16_t* src = H5 + (size_t)(tok0 + row) * EIN + 1024 + h * 256 + ch * 8;
            const u32x4 kv = *(const u32x4*)src, vv = *(const u32x4*)(src + 1024); const float z = __builtin_amdgcn_exp2f(lg2 * (float)(127 - row)) * 0.0625f;
            u32x4 ks;
#pragma unroll
            for (int e = 0; e < 4; ++e) ks[e] = pk2(bflo(kv[e]) * z, bfhi(kv[e]) * z);
            *(LAS u32x4*)(Kt + row * RRS + ch * 16) = ks; *(LAS u32x4*)(Vt + row * RRS + ch * 16) = vv; }
        __syncthreads();
        for (int dh = 0; dh < 2; ++dh) {
            f32x4 acc[2][8];
#pragma unroll
            for (int a = 0; a < 2; ++a)
#pragma unroll
                for (int d = 0; d < 8; ++d) acc[a][d] = (f32x4){0.f, 0.f, 0.f, 0.f};
#pragma unroll
            for (int ks = 0; ks < 4; ++ks) { const int R0 = 32 * ks + 8 * g4 + qq;
                const LAS unsigned char* vb = Vt + R0 * RRS + 8 * pp; const LAS unsigned char* kb = Kt + R0 * RRS + 8 * pp + 256 * dh;
                const bf16x8 vf0 = cat8(vtr(vb + 64 * w), vtr(vb + 4 * RRS + 64 * w)), vf1 = cat8(vtr(vb + 64 * w + 32), vtr(vb + 4 * RRS + 64 * w + 32));
#pragma unroll
                for (int dt = 0; dt < 8; ++dt) { const bf16x8 kf = cat8(vtr(kb + 32 * dt), vtr(kb + 4 * RRS + 32 * dt)); acc[0][dt] = mfma16(kf, vf0, acc[0][dt]); acc[1][dt] = mfma16(kf, vf1, acc[1][dt]); } }
            float* op = KVT + (size_t)u * 65536 + (size_t)(32 * w + r) * 256 + 128 * dh + 4 * g4;
#pragma unroll
            for (int a = 0; a < 2; ++a)
#pragma unroll
                for (int dt = 0; dt < 8; ++dt) *(f32x4*)(op + a * 16 * 256 + 16 * dt) = acc[a][dt];
        }
        __syncthreads();
    }
}
__device__ __forceinline__ void pooled_phase(const Frame& F0, const bf16_t* H5, bf16_t* PO) {
    const Frame F = relaunder(F0);
    for (int it = F.bid * 512 + F.tid; it < 1024 * 128; it += F.G * 512) {
        const int cgp = it & 127, run = it >> 7, c = cgp * 8, w = 2 << (c >> 8), t0 = run * 16, p0 = t0 & (SEQ - 1);
        const bf16_t* U = H5 + 4096 + c;
        float S[8];
#pragma unroll
        for (int e = 0; e < 8; ++e) S[e] = 0.f;
        for (int s = 1; s < w; ++s) if (p0 - s >= 0) { const u32x4 x = *(const u32x4*)(U + (size_t)(t0 - s) * EIN);
#pragma unroll
            for (int e = 0; e < 4; ++e) { S[2 * e] += bflo(x[e]); S[2 * e + 1] += bfhi(x[e]); } }
        for (int k = 0; k < 16; ++k) { const int t = t0 + k, p = p0 + k; const u32x4 x = *(const u32x4*)(U + (size_t)t * EIN);
            const float rc = 1.0f / (float)((p + 1 < w) ? p + 1 : w); u32x4 o;
#pragma unroll
            for (int e = 0; e < 4; ++e) { const float a0 = bflo(x[e]), a1 = bfhi(x[e]); S[2 * e] += a0; S[2 * e + 1] += a1; o[e] = pk2(S[2 * e] * rc - a0, S[2 * e + 1] * rc - a1); }
            *(u32x4*)(PO + (size_t)t * 1024 + c) = o;
            if (p - (w - 1) >= 0) { const u32x4 y = *(const u32x4*)(U + (size_t)(t - (w - 1)) * EIN);
#pragma unroll
                for (int e = 0; e < 4; ++e) { S[2 * e] -= bflo(y[e]); S[2 * e + 1] -= bfhi(y[e]); } }
        }
    }
}
__device__ __forceinline__ void ret_scan_phase(const Frame& F0, const float* KVT, bf16_t* PREVT) {
    const Frame F = relaunder(F0);
    for (int it = F.bid * 512 + F.tid; it < 16 * 16384; it += F.G * 512) {
        const int bh = it >> 14, e4 = it & 16383, b = bh >> 2, h = bh & 3; const float cd = __builtin_amdgcn_exp2f(ret_lg2(h) * 128.0f);
        f32x4 st = (f32x4){0.f, 0.f, 0.f, 0.f};
#pragma unroll 4
        for (int n = 0; n < 31; ++n) { const size_t u = (size_t)((b * 32 + n) * 4 + h);
            st = st * cd + *(const f32x4*)(KVT + u * 65536 + (size_t)e4 * 4);
            u32x2 o; o.x = pk2(st[0], st[1]); o.y = pk2(st[2], st[3]); *(u32x2*)(PREVT + (u + 4) * 65536 + (size_t)e4 * 4) = o; }
    }
}
__device__ __forceinline__ void ret_out_phase(const Frame& F0, const bf16_t* H5, const bf16_t* PREVT, bf16_t* MIX) {
    const Frame F = relaunder(F0);
    LAS unsigned char* Kt = F.lds; LAS unsigned char* Vt = F.lds + 128 * RRS;
    const int lane = F.lane, r = lane & 15, g4 = lane >> 4, qq = r >> 2, pp = r & 3, w = F.wave;
    for (int u = F.bid; u < 512; u += F.G) {
        const int h = u & 3, n = (u >> 2) & 31, b = u >> 7, tok0 = b * SEQ + n * 128; const float lg2 = ret_lg2(h);
        for (int c = F.tid; c < 128 * 32; c += 512) { const int row = c >> 5, ch = c & 31; const bf16_t* src = H5 + (size_t)(tok0 + row) * EIN + 1024 + h * 256 + ch * 8;
            *(LAS u32x4*)(Kt + row * RRS + ch * 16) = *(const u32x4*)src; *(LAS u32x4*)(Vt + row * RRS + ch * 16) = *(const u32x4*)(src + 1024); }
        const int i = 16 * w + r;
        bf16x8 Qf[8];
        { const bf16_t* qp = H5 + (size_t)(tok0 + i) * EIN + h * 256 + 8 * g4;
#pragma unroll
          for (int kk = 0; kk < 8; ++kk) Qf[kk] = *(const bf16x8*)(qp + 32 * kk); }
        __syncthreads();
        u32x2 P[8];
#pragma unroll
        for (int tj = 0; tj < 8; ++tj) {
            P[tj] = (u32x2){0u, 0u};
            if (tj <= w) { f32x4 acc = (f32x4){0.f, 0.f, 0.f, 0.f}; const LAS unsigned char* kp = Kt + (16 * tj + r) * RRS + 16 * g4;
#pragma unroll
                for (int kk = 0; kk < 8; ++kk) acc = mfma16(*(const LAS bf16x8*)(kp + 64 * kk), Qf[kk], acc);
                float pv[4];
#pragma unroll
                for (int jj = 0; jj < 4; ++jj) { const int j = 16 * tj + 4 * g4 + jj; pv[jj] = (i >= j) ? acc[jj] * 0.0625f * __builtin_amdgcn_exp2f(lg2 * (float)(i - j)) : 0.f; }
                P[tj].x = pk2(pv[0], pv[1]); P[tj].y = pk2(pv[2], pv[3]); }
        }
        __syncthreads();
        f32x4 acc[16];
#pragma unroll
        for (int te = 0; te < 16; ++te) acc[te] = (f32x4){0.f, 0.f, 0.f, 0.f};
        if (n > 0) {
#pragma unroll
            for (int half = 0; half < 2; ++half) {
                for (int c = F.tid; c < 128 * 32; c += 512) { const int row = c >> 5, ch = c & 31;
                    *(LAS u32x4*)(Kt + row * RRS + ch * 16) = *(const u32x4*)(PREVT + (size_t)u * 65536 + (size_t)(128 * half + row) * 256 + ch * 8); }
                __syncthreads();
#pragma unroll
                for (int te = 0; te < 8; ++te) { const LAS unsigned char* pq = Kt + (16 * te + r) * RRS + 16 * g4;
#pragma unroll
                    for (int kk = 0; kk < 8; ++kk) acc[8 * half + te] = mfma16(*(const LAS bf16x8*)(pq + 64 * kk), Qf[kk], acc[8 * half + te]);
                    asm volatile("" : "+v"(acc[8 * half + te])); }
                __syncthreads();
            }
            const float xi = __builtin_amdgcn_exp2f(lg2 * (float)(i + 1));
#pragma unroll
            for (int te = 0; te < 16; ++te) acc[te] = acc[te] * xi;
        }
#pragma unroll
        for (int pr = 0; pr < 4; ++pr) {
            if (2 * pr <= w) { const u32x4 bw = (u32x4){P[2 * pr].x, P[2 * pr].y, P[2 * pr + 1].x, P[2 * pr + 1].y}; const bf16x8 bfrag = __builtin_bit_cast(bf16x8, bw);
                const LAS unsigned char* v0 = Vt + (32 * pr + 4 * g4 + qq) * RRS + 8 * pp;
#pragma unroll
                for (int te = 0; te < 16; ++te) { acc[te] = mfma16(cat8(vtr(v0 + 32 * te), vtr(v0 + 16 * RRS + 32 * te)), bfrag, acc[te]); if ((te & 3) == 3) asm volatile("" : "+v"(acc[te])); } }
        }
        float s = 0.f;
#pragma unroll
        for (int te = 0; te < 16; ++te) s += (acc[te][0] + acc[te][1]) + (acc[te][2] + acc[te][3]);
        s += __shfl_xor(s, 16); s += __shfl_xor(s, 32);
        const float mean = s * (1.f / 256.f); float s2 = 0.f;
#pragma unroll
        for (int te = 0; te < 16; ++te) { acc[te] = acc[te] - mean; s2 += (acc[te][0] * acc[te][0] + acc[te][1] * acc[te][1]) + (acc[te][2] * acc[te][2] + acc[te][3] * acc[te][3]); }
        s2 += __shfl_xor(s2, 16); s2 += __shfl_xor(s2, 32);
        const float rstd = 1.0f / sqrtf(s2 * (1.f / 256.f) + LN_EPS);
        const bf16_t* gp = H5 + (size_t)(tok0 + i) * EIN + 3072 + h * 256 + 4 * g4; bf16_t* op = MIX + (size_t)(tok0 + i) * D + h * 256 + 4 * g4;
#pragma unroll
        for (int te = 0; te < 16; ++te) { const u32x2 gw = *(const u32x2*)(gp + 16 * te); float gv[4] = {bflo(gw.x), bfhi(gw.x), bflo(gw.y), bfhi(gw.y)}; float ov[4];
#pragma unroll
            for (int jj = 0; jj < 4; ++jj) { const float sg = gv[jj] / (1.0f + __builtin_amdgcn_exp2f(-gv[jj] * LOG2E)); ov[jj] = sg * acc[te][jj] * rstd; }
            u32x2 o; o.x = pk2(ov[0], ov[1]); o.y = pk2(ov[2], ov[3]); *(u32x2*)(op + 16 * te) = o; }
        __syncthreads();
    }
}

__device__ __forceinline__ void gemm_res_ln(const Frame& F, const XcdBarrier& bar, const bf16_t* A, const bf16_t* Bt, int K, const float* xres, float* Y, float* XF, bf16_t* XB,
                                            const float* g, const float* b, unsigned char* ws, int inst) {
    pg8::Gemm gm{A, Bt, K, K, K, 0};
    if (F.G == 256) {
        pg8::PanelOrder S{F.bid};
        pg8::EpiResLn E{xres, XF, XB, g, b, (unsigned long long*)(ws + WS_XCH) + (size_t)inst * 131072, (unsigned*)(ws + WS_CTL) + CW_LN + inst * 4096, F.lds + 131072};
        pg8::gemm_phase<pg8::EpiResLn, pg8::PanelOrder, true>(F.lds, gm, S, E);
        xcd_barrier(bar);
    } else {
        pg8::StaticOrder S; S.init(M, D, F.G, F.bid);
        pg8::EpiRes E{xres, Y};
        pg8::gemm_phase<pg8::EpiRes, pg8::StaticOrder, true>(F.lds, gm, S, E);
        xcd_barrier(bar);
        ln_phase(F, Y, g, b, XF, XB);
        xcd_barrier(bar);
    }
}

__global__ void __launch_bounds__(512, 2) fwd_megakernel(Args args) {
    extern __shared__ __attribute__((aligned(16))) unsigned char lds_raw[];
    cg::grid_group grid = cg::this_grid();
    Frame F; F.lds = (LAS unsigned char*)lds_raw; F.tid = threadIdx.x; F.lane = F.tid & 63; F.wave = __builtin_amdgcn_readfirstlane(F.tid >> 6); F.G = gridDim.x; F.bid = blockIdx.x;
    unsigned char* ws = args.ws;
    bf16_t* XB = (bf16_t*)(ws + WS_XB); float* Y = (float*)(ws + WS_Y); bf16_t* MIX = (bf16_t*)(ws + WS_MIX);
    float* HALO = (float*)(ws + WS_HF); bf16_t* ACT = (bf16_t*)(ws + WS_ACT); bf16_t* H5 = (bf16_t*)(ws + WS_H5); bf16_t* QKV = (bf16_t*)(ws + WS_QKV);
    float* KVT = (float*)(ws + WS_KVT); bf16_t* PREVT = (bf16_t*)(ws + WS_PREVT); bf16_t* POOLED = (bf16_t*)(ws + WS_POOLED);
    float* XF = args.out;

    for (int u = F.tid; u < (LDS_BYTES - MISC_OFF) / 4; u += 512) ((LAS unsigned*)(F.lds + MISC_OFF))[u] = 0u;
    __syncthreads();
    const XcdBarrier bar = xcd_barrier_post((unsigned*)(ws + WS_CTL), (volatile LAS unsigned*)(F.lds + MISC_OFF));
#define GRID_BAR() xcd_barrier(bar)

    p0_prologue(F, args);
    grid.sync();

    for (int layer = 0; layer < 4; ++layer) {
        const int li = layer >> 1;
        const float* xres = (layer == 0) ? args.in[0] : XF;
        if ((layer & 1) == 0) {
            {
                pg8::Gemm g{XB, (const bf16_t*)(ws + WS_EIN) + (size_t)li * EIN * D, D, D, D, 0}; pg8::StaticOrder S; S.init(M, EIN, F.G, F.bid);
                pg8::EpiBf16 E{H5, EIN, nullptr, nullptr, 0};
                pg8::gemm_phase<pg8::EpiBf16, pg8::StaticOrder, true>(F.lds, g, S, E);
            }
            GRID_BAR();
            ret_kv_phase(F, H5, KVT);
            pooled_phase(F, H5, POOLED);
            GRID_BAR();
            ret_scan_phase(F, KVT, PREVT);
            {
                pg8::Gemm g{POOLED, (const bf16_t*)(ws + WS_POOLW) + (size_t)li * 1024 * 256, 1024, 256, 256, 256}; pg8::StaticOrder S; S.init(M, 1024, F.G, F.bid);
                pg8::EpiBf16 E{MIX, D, nullptr, args.in[5] + (size_t)li * 1024, 1024};
                pg8::gemm_phase<pg8::EpiBf16, pg8::StaticOrder, true>(F.lds, g, S, E);
            }
            GRID_BAR();
            ret_out_phase(F, H5, PREVT, MIX);
            GRID_BAR();
        } else {
            {
                pg8::Gemm g{XB, (const bf16_t*)(ws + WS_QKVW) + (size_t)li * OIN * D, D, D, D, 0}; pg8::StaticOrder S; S.init(M, OIN, F.G, F.bid);
                pg8::EpiBf16 E{QKV, OIN, args.in[8] + (size_t)li * OIN, nullptr, 0};
                pg8::gemm_phase<pg8::EpiBf16, pg8::StaticOrder, true>(F.lds, g, S, E);
            }
            GRID_BAR();
            attn_phase(F, QKV, args.in[9] + li * 32, MIX);
            GRID_BAR();
        }
        gemm_res_ln(F, bar, MIX, ((layer & 1) == 0) ? (const bf16_t*)(ws + WS_EOUT) + (size_t)li * D * D : (const bf16_t*)(ws + WS_AOUT) + (size_t)li * D * D, D, xres, Y, XF, XB,
                    args.in[1] + (size_t)(layer * 2 + 0) * D, args.in[2] + (size_t)(layer * 2 + 0) * D, ws, layer * 2 + 0);
        {
            pg8::Gemm g{XB, (const bf16_t*)(ws + WS_F1) + (size_t)layer * FF2 * D, D, D, D, 0}; pg8::StaticOrder S; S.init(M, FF2, F.G, F.bid);
            pg8::EpiConvGlu E{ACT, HALO, args.in[12] + (size_t)layer * 3 * FF2, args.in[13] + (size_t)layer * FF2, (LAS float*)(F.lds + 131072)};
            pg8::gemm_phase<pg8::EpiConvGlu, pg8::StaticOrder, true>(F.lds, g, S, E);
        }
        GRID_BAR();
        conv_fixup_phase(F, HALO, args.in[12] + (size_t)layer * 3 * FF2, args.in[13] + (size_t)layer * FF2, ACT);
        GRID_BAR();
        gemm_res_ln(F, bar, ACT, (const bf16_t*)(ws + WS_F2) + (size_t)layer * D * FF, FF, XF, Y, XF, XB,
                    args.in[1] + (size_t)(layer * 2 + 1) * D, args.in[2] + (size_t)(layer * 2 + 1) * D, ws, layer * 2 + 1);
    }
}

extern "C" void kernel_launch(void* const* d_in, const int* in_sizes, int n_in, void* d_out, int out_size, void* d_ws, size_t ws_size, hipStream_t stream) {
    static int grid = 0;
    if (grid == 0) {
        if (n_in != 15 || out_size != M * D || ws_size < WS_END) { fprintf(stderr, "kernel_launch: unexpected problem: n_in %d out %d ws %zu (need %zu)\n", n_in, out_size, ws_size, (size_t)WS_END); grid = -1; return; }
        int dev = 0, cus = 0, per_cu = 0;
        hipGetDevice(&dev); hipDeviceGetAttribute(&cus, hipDeviceAttributeMultiprocessorCount, dev);
        if (hipFuncSetAttribute((const void*)fwd_megakernel, hipFuncAttributeMaxDynamicSharedMemorySize, LDS_BYTES) != hipSuccess) { fprintf(stderr, "kernel_launch: hipFuncSetAttribute failed\n"); grid = -1; return; }
        if (hipOccupancyMaxActiveBlocksPerMultiprocessor(&per_cu, (const void*)fwd_megakernel, 512, LDS_BYTES) != hipSuccess || per_cu < 1) { fprintf(stderr, "kernel_launch: occupancy query says %d\n", per_cu); per_cu = 1; }
        (void)hipGetLastError();
        grid = cus;
    }
    if (grid < 0) return;
    Args a{};
    for (int i = 0; i < 15; ++i) a.in[i] = (const float*)d_in[i];
    a.out = (float*)d_out; a.ws = (unsigned char*)d_ws;
    if (hipMemsetAsync((char*)d_ws + WS_CTL, 0, CTL_BYTES, stream) != hipSuccess) { fprintf(stderr, "kernel_launch: memset failed\n"); return; }
    void* kargs[] = {&a};
    hipError_t e = hipLaunchCooperativeKernel((const void*)fwd_megakernel, dim3(grid), dim3(512), kargs, LDS_BYTES, stream);
    if (e != hipSuccess) fprintf(stderr, "kernel_launch: cooperative launch failed: %s (grid %d)\n", hipGetErrorString(e), grid);
}
```

```cpp
#include <hip/hip_runtime.h>
#include <hip/hip_cooperative_groups.h>
#include <cstdio>
#include <cstdint>
namespace cg = cooperative_groups;
#ifndef EXP_REP_P0
#define EXP_REP_P0 1
#endif
#ifndef EXP_REP_RET
#define EXP_REP_RET 1
#endif
#ifndef EXP_REP_F1
#define EXP_REP_F1 1
#endif
#ifndef EXP_REP_INP
#define EXP_REP_INP 1
#endif
#ifndef EXP_REP_ATT
#define EXP_REP_ATT 1
#endif

#define LAS __attribute__((address_space(3)))
typedef unsigned short bf16_t;
typedef short bf16x8 __attribute__((ext_vector_type(8)));
typedef short s16x4 __attribute__((ext_vector_type(4)));
typedef float f32x4 __attribute__((ext_vector_type(4)));
typedef float f32x2 __attribute__((ext_vector_type(2)));
typedef unsigned u32x4 __attribute__((ext_vector_type(4)));
typedef unsigned u32x2 __attribute__((ext_vector_type(2)));
typedef __bf16 bf16x2_t __attribute__((ext_vector_type(2)));

constexpr int NBATCH = 4, SEQ = 4096, M = NBATCH * SEQ, D = 2048;
constexpr int EIN = 5120, OIN = 2560, FF = 5632, FF2 = 11264;
constexpr float ALPHA = 1.6817928305074290f;
constexpr float LN_EPS = 1e-5f;
constexpr float LOG2E = 1.4426950408889634f;

constexpr size_t MiB = 1u << 20;
constexpr size_t WS_EIN = 0 * MiB;
constexpr size_t WS_EOUT = 40 * MiB;
constexpr size_t WS_POOLW = 56 * MiB;
constexpr size_t WS_QKVW = 57 * MiB;
constexpr size_t WS_AOUT = 77 * MiB;
constexpr size_t WS_F1 = 93 * MiB;
constexpr size_t WS_F2 = 269 * MiB;
constexpr size_t WS_XB = 357 * MiB;
constexpr size_t WS_Y = 421 * MiB;
constexpr size_t WS_MIX = 549 * MiB;
constexpr size_t WS_BIG = 613 * MiB;
constexpr size_t WS_HF = WS_BIG;
constexpr size_t WS_ACT = WS_BIG + 352 * MiB;
constexpr size_t WS_H5 = WS_BIG;
constexpr size_t WS_QKV = WS_BIG;
constexpr size_t WS_KVT = WS_BIG + 160 * MiB;
constexpr size_t WS_PREVT = WS_BIG + 288 * MiB;
constexpr size_t WS_POOLED = WS_BIG + 352 * MiB;
constexpr size_t WS_CTL = 1141 * MiB;
constexpr size_t CTL_BYTES = 256 * 1024;
constexpr int CW_LN = 4096;
constexpr size_t WS_XCH = 1142 * MiB;
constexpr size_t WS_END = 1150 * MiB;
constexpr int MISC_OFF = 143360;

constexpr int LDS_BYTES = 147456;

__device__ __forceinline__ unsigned pk2(float lo, float hi) { f32x2 v = {lo, hi}; bf16x2_t b = __builtin_convertvector(v, bf16x2_t); return __builtin_bit_cast(unsigned, b); }
__device__ __forceinline__ float bflo(unsigned w) { return __uint_as_float(w << 16); }
__device__ __forceinline__ float bfhi(unsigned w) { return __uint_as_float(w & 0xffff0000u); }
__device__ __forceinline__ float wave_sum(float v) {
#pragma unroll
    for (int o = 1; o < 64; o <<= 1) v += __shfl_xor(v, o);
    return v;
}
typedef short v4i16_t __attribute__((ext_vector_type(4)));
__device__ __forceinline__ s16x4 vtr(const LAS unsigned char* p) { return __builtin_bit_cast(s16x4, __builtin_amdgcn_ds_read_tr16_b64_v4i16((LAS v4i16_t*)p)); }
__device__ __forceinline__ bf16x8 cat8(s16x4 lo, s16x4 hi) { return (bf16x8){lo[0], lo[1], lo[2], lo[3], hi[0], hi[1], hi[2], hi[3]}; }
__device__ __forceinline__ f32x4 mfma16(bf16x8 a, bf16x8 b, f32x4 c) { return __builtin_amdgcn_mfma_f32_16x16x32_bf16(a, b, c, 0, 0, 0); }
__device__ __forceinline__ f32x2 gelu_pk(f32x2 v) {
    const f32x2 av = __builtin_elementwise_abs(v), d = av * 0.2316418882f + 1.0f;
    f32x2 t; t.x = __builtin_amdgcn_rcpf(d.x); t.y = __builtin_amdgcn_rcpf(d.y);
    f32x2 q = t * 0.5307027145f + (-0.7265760135f); q = q * t + 0.7107068705f; q = q * t + (-0.142248368f); q = q * t + 0.127414796f; q = q * t;
    const f32x2 s = (v * v) * (-0.72134752044f);
    f32x2 e; e.x = __builtin_amdgcn_exp2f(s.x); e.y = __builtin_amdgcn_exp2f(s.y);
    const f32x2 m = v * (q * e), r = v - m;
    f32x2 o; o.x = v.x < 0.f ? m.x : r.x; o.y = v.y < 0.f ? m.y : r.y; return o;
}

namespace pg8 {
constexpr int BM = 256, BK = 64, HALF = 128, HTB = HALF * BK * 2, STAGE_BYTES = 8 * HTB, NXCD = 8, WGM = 8;
__host__ __device__ __forceinline__ int lds_byte(int r, int c) { const int st = (r >> 4) * 2 + (c >> 5), rr = r & 15, cc = c & 31, ob = rr * 64 + cc * 2; return st * 1024 + (ob ^ (((ob >> 9) & 1) << 5)); }
__host__ __device__ __forceinline__ void stage_rc(int b, int& R, int& C) { const int st = b / 1024, sb = b % 1024, swz = sb ^ (((sb >> 9) & 1) << 5); R = (st >> 1) * 16 + swz / 64; C = (st & 1) * 32 + (swz % 64) / 2; }
__host__ __device__ __forceinline__ int perm32(int rho) { const int n = rho >> 4, i = rho & 15; return 8 * (i >> 2) + 4 * n + (i & 3); }

struct Unit { int pm, pn; };
struct Gemm { const bf16_t* A; const bf16_t* Bt; int lda, ldb, K, a_pn_off; };

struct StaticOrder {
    int nM, nN, nwg, G, c;
    __device__ void init(int M_, int N_, int G_, int c_) { nM = M_ / BM; nN = N_ / BM; nwg = nM * nN; G = G_; c = c_; }
    __device__ bool next(int i, Unit& u) const {
        const long L = (long)i * G + c; if (L >= nwg) return false;
        int wgid = (int)L; { const int q = nwg / NXCD, r = nwg % NXCD, xcd = wgid % NXCD, off = wgid / NXCD; wgid = (xcd < r ? xcd * (q + 1) : r * (q + 1) + (xcd - r) * q) + off; }
        const int nig = WGM * nN, gid = wgid / nig, fm = gid * WGM, gsz = (nM - fm) < WGM ? (nM - fm) : WGM;
        u.pm = fm + ((wgid % nig) % gsz); u.pn = (wgid % nig) / gsz; return true;
    }
};

struct EpiBf16 {
    static constexpr bool PERM = true;
    bf16_t* O; int ldc; const float* bias; const float* scale; int ocol_off;
    __device__ __forceinline__ void operator()(f32x4 (&acc)[2][2][4][2], const Unit& u, int wr, int wc, int fr, int fq, int wid, int lane) const {
        const int row0 = u.pm * BM + wr * 64 + fr; const int bcol0 = u.pn * BM + wc * 32 + 8 * fq; const int col0 = ocol_off + bcol0;
        f32x4 bv[2][2], sv[2][2];
#pragma unroll
        for (int bj = 0; bj < 2; ++bj)
#pragma unroll
            for (int n = 0; n < 2; ++n) { bv[bj][n] = bias ? *(const f32x4*)(bias + bcol0 + bj * HALF + 4 * n) : (f32x4){0.f, 0.f, 0.f, 0.f};
                                          sv[bj][n] = scale ? *(const f32x4*)(scale + bcol0 + bj * HALF + 4 * n) : (f32x4){1.f, 1.f, 1.f, 1.f}; }
#pragma unroll
        for (int ai = 0; ai < 2; ++ai)
#pragma unroll
            for (int m = 0; m < 4; ++m) { bf16_t* rowp = O + (size_t)(row0 + ai * HALF + m * 16) * ldc + col0;
#pragma unroll
                for (int bj = 0; bj < 2; ++bj) { f32x4 v0 = (acc[ai][bj][m][0] + bv[bj][0]) * sv[bj][0], v1 = (acc[ai][bj][m][1] + bv[bj][1]) * sv[bj][1];
                    u32x4 w; w.x = pk2(v0[0], v0[1]); w.y = pk2(v0[2], v0[3]); w.z = pk2(v1[0], v1[1]); w.w = pk2(v1[2], v1[3]);
                    *(u32x4*)(rowp + bj * HALF) = w; } }
    }
};
struct EpiRes {
    static constexpr bool PERM = false;
    const float* X; float* Y;
    __device__ __forceinline__ void operator()(f32x4 (&acc)[2][2][4][2], const Unit& u, int wr, int wc, int fr, int fq, int wid, int lane) const {
        const int row0 = u.pm * BM + wr * 64 + fr, col0 = u.pn * BM + wc * 32 + 4 * fq;
#pragma unroll
        for (int ai = 0; ai < 2; ++ai)
#pragma unroll
            for (int m = 0; m < 4; ++m) { const size_t off = (size_t)(row0 + ai * HALF + m * 16) * D + col0;
#pragma unroll
                for (int bj = 0; bj < 2; ++bj)
#pragma unroll
                    for (int n = 0; n < 2; ++n) { const f32x4 xv = *(const f32x4*)(X + off + bj * HALF + n * 16); *(f32x4*)(Y + off + bj * HALF + n * 16) = xv * ALPHA + acc[ai][bj][m][n]; }
                asm volatile("" ::: "memory"); }
    }
};

__device__ __forceinline__ float dpp_ror1(float v) { return __int_as_float(__builtin_amdgcn_update_dpp(0, __float_as_int(v), 0x121, 0xf, 0xf, false)); }
__device__ __forceinline__ float dpp_ror2(float v) { return __int_as_float(__builtin_amdgcn_update_dpp(0, __float_as_int(v), 0x122, 0xf, 0xf, false)); }
struct EpiConvGlu {
    static constexpr bool PERM = true;
    bf16_t* ACT; float* HALO; const float* cw; const float* cb; LAS float* xbuf;
    __device__ __forceinline__ void operator()(f32x4 (&acc)[2][2][4][2], const Unit& u, int wr, int wc, int fr, int fq, int wid, int lane) const {
        const int cl = 32 * wc + 8 * fq;
        if (fr >= 14) {
#pragma unroll
            for (int ai = 0; ai < 2; ++ai)
#pragma unroll
                for (int bj = 0; bj < 2; ++bj)
#pragma unroll
                    for (int n = 0; n < 2; ++n) *(LAS f32x4*)(xbuf + ((((ai * 2 + wr) * 2 + bj) * 2 + (fr - 14)) * 128 + cl + 4 * n)) = acc[ai][bj][3][n];
        }
        if (wr == 0 && fr < 2) {
#pragma unroll
            for (int bj = 0; bj < 2; ++bj)
#pragma unroll
                for (int n = 0; n < 2; ++n) *(f32x4*)(HALO + (size_t)(u.pm * 4 + fr) * FF2 + u.pn * 256 + bj * 128 + cl + 4 * n) = acc[0][bj][0][n];
        }
        if (wr == 1 && fr >= 14) {
#pragma unroll
            for (int bj = 0; bj < 2; ++bj)
#pragma unroll
                for (int n = 0; n < 2; ++n) *(f32x4*)(HALO + (size_t)(u.pm * 4 + fr - 12) * FF2 + u.pn * 256 + bj * 128 + cl + 4 * n) = acc[1][bj][3][n];
        }
        asm volatile("s_waitcnt lgkmcnt(0)" ::: "memory"); __builtin_amdgcn_s_barrier(); asm volatile("" ::: "memory");
        const int row0 = u.pm * BM + wr * 64 + fr;
#pragma unroll
        for (int n = 0; n < 2; ++n) {
            const int ch = u.pn * 128 + cl + 4 * n;
            f32x4 w[2][3], bb[2];
#pragma unroll
            for (int bj = 0; bj < 2; ++bj) { bb[bj] = *(const f32x4*)(cb + bj * FF + ch);
#pragma unroll
                for (int k = 0; k < 3; ++k) w[bj][k] = *(const f32x4*)(cw + (size_t)k * FF2 + bj * FF + ch); }
#pragma unroll
            for (int ai = 0; ai < 2; ++ai)
#pragma unroll
                for (int m = 0; m < 4; ++m) {
                    f32x4 cv[2];
#pragma unroll
                    for (int bj = 0; bj < 2; ++bj) {
                        const f32x4 cur = acc[ai][bj][m][n]; f32x4 p1, p2;
                        if (m > 0) { const f32x4 pb = acc[ai][bj][m > 0 ? m - 1 : 0][n];
#pragma unroll
                            for (int j = 0; j < 4; ++j) { const float a1 = dpp_ror1(cur[j]), a2 = dpp_ror2(cur[j]), b1 = dpp_ror1(pb[j]), b2 = dpp_ror2(pb[j]); p1[j] = fr >= 1 ? a1 : b1; p2[j] = fr >= 2 ? a2 : b2; }
                        } else {
                            f32x4 x1 = (f32x4){0.f, 0.f, 0.f, 0.f}, x2 = x1;
                            if (wr == 1 || ai == 1) { const int sai = (wr == 1) ? ai : 0, swr = (wr == 1) ? 0 : 1; const LAS float* xp = xbuf + (((sai * 2 + swr) * 2 + bj) * 2) * 128 + cl + 4 * n;
                                x1 = *(const LAS f32x4*)(xp + 128); x2 = *(const LAS f32x4*)(xp + (fr & 1) * 128); }
#pragma unroll
                            for (int j = 0; j < 4; ++j) { const float a1 = dpp_ror1(cur[j]), a2 = dpp_ror2(cur[j]); p1[j] = fr >= 1 ? a1 : x1[j]; p2[j] = fr >= 2 ? a2 : x2[j]; }
                        }
                        cv[bj] = bb[bj] + w[bj][0] * p2 + w[bj][1] * p1 + w[bj][2] * cur;
                    }
                    const f32x2 g0 = gelu_pk((f32x2){cv[0][0], cv[0][1]}), g1 = gelu_pk((f32x2){cv[0][2], cv[0][3]});
                    u32x2 o; o.x = pk2(g0.x * cv[1][0], g0.y * cv[1][1]); o.y = pk2(g1.x * cv[1][2], g1.y * cv[1][3]);
                    *(u32x2*)(ACT + (size_t)(row0 + ai * HALF + m * 16) * FF + ch) = o;
                }
        }
    }
};

struct PanelOrder {
    int c;
    __device__ bool next(int i, Unit& u) const { if (i >= 2) return false; const int x = c & 7, j = c >> 3; u.pm = 32 * i + 4 * x + (j & 3); u.pn = j >> 2; return true; }
};
struct EpiResLn {
    static constexpr bool PERM = false;
    const float* X; float* XF; bf16_t* XB; const float* g; const float* b; unsigned long long* slots; unsigned* cnt; LAS unsigned char* tl;
    __device__ __forceinline__ void operator()(f32x4 (&acc)[2][2][4][2], const Unit& u, int wr, int wc, int fr, int fq, int wid, int lane) const {
        LAS f32x2* P = (LAS f32x2*)tl; LAS f32x2* S = (LAS f32x2*)(tl + 8192);
        const int row0 = u.pm * BM + wr * 64 + fr, col0 = u.pn * BM + wc * 32 + 4 * fq;
#pragma unroll
        for (int ai = 0; ai < 2; ++ai)
#pragma unroll
            for (int m = 0; m < 4; ++m) { const size_t off = (size_t)(row0 + ai * HALF + m * 16) * D + col0;
#pragma unroll
                for (int bj = 0; bj < 2; ++bj)
#pragma unroll
                    for (int n = 0; n < 2; ++n) { f32x4 xv;
                        if (X) xv = *(const f32x4*)(X + off + bj * HALF + n * 16);
                        else { const u32x2 xw = *(const u32x2*)(XB + off + bj * HALF + n * 16); xv = (f32x4){bflo(xw.x), bfhi(xw.x), bflo(xw.y), bfhi(xw.y)}; }
                        acc[ai][bj][m][n] = xv * ALPHA + acc[ai][bj][m][n]; }
                asm volatile("" : "+v"(acc[ai][0][m][0]), "+v"(acc[ai][0][m][1]), "+v"(acc[ai][1][m][0]), "+v"(acc[ai][1][m][1]));
                float s = 0.f;
#pragma unroll
                for (int bj = 0; bj < 2; ++bj)
#pragma unroll
                    for (int n = 0; n < 2; ++n) { const f32x4 x = acc[ai][bj][m][n]; s += (x[0] + x[1]) + (x[2] + x[3]); }
                s += __shfl_xor(s, 16); s += __shfl_xor(s, 32);
                const float mw = s * (1.0f / 64.0f); float q = 0.f;
#pragma unroll
                for (int bj = 0; bj < 2; ++bj)
#pragma unroll
                    for (int n = 0; n < 2; ++n) { const f32x4 d = acc[ai][bj][m][n] - mw; q += (d[0] * d[0] + d[1] * d[1]) + (d[2] * d[2] + d[3] * d[3]); }
                q += __shfl_xor(q, 16); q += __shfl_xor(q, 32);
                if (fq == 0) P[(ai * HALF + wr * 64 + m * 16 + fr) * 4 + wc] = (f32x2){mw, q};
            }
        asm volatile("s_waitcnt lgkmcnt(0)" ::: "memory"); __builtin_amdgcn_s_barrier(); asm volatile("" ::: "memory");
        const int row = wid * 32 + (lane & 31);
        unsigned long long* slot = slots + ((size_t)(u.pm * BM + row) * 8);
        if (lane < 32) {
            const f32x2 a = P[row * 4 + 0], b4 = P[row * 4 + 1], c = P[row * 4 + 2], d = P[row * 4 + 3];
            const float mt = (a.x + b4.x + c.x + d.x) * 0.25f;
            const float da = a.x - mt, db = b4.x - mt, dc = c.x - mt, dd = d.x - mt;
            const float m2 = (a.y + b4.y) + (c.y + d.y) + 64.0f * ((da * da + db * db) + (dc * dc + dd * dd));
            __hip_atomic_store(slot + u.pn, ((unsigned long long)__float_as_uint(m2) << 32) | __float_as_uint(mt), __ATOMIC_RELAXED, __HIP_MEMORY_SCOPE_AGENT);
        }
        asm volatile("s_waitcnt vmcnt(0)" ::: "memory");
        unsigned* cw = cnt + 64 * u.pm;
        if (lane == 0) __hip_atomic_fetch_add(cw, 1u, __ATOMIC_RELAXED, __HIP_MEMORY_SCOPE_AGENT);
        if (wid == 0) {
            unsigned sp = 0;
            while ((unsigned)__builtin_amdgcn_readfirstlane(__hip_atomic_load(cw, __ATOMIC_RELAXED, __HIP_MEMORY_SCOPE_AGENT)) < 64u) { __builtin_amdgcn_s_sleep(1); if (++sp > (1u << 24)) break; }
            __builtin_amdgcn_fence(__ATOMIC_ACQUIRE, "agent");
        }
        asm volatile("s_waitcnt vmcnt(0) lgkmcnt(0)" ::: "memory"); __builtin_amdgcn_s_barrier(); asm volatile("" ::: "memory");
        if (lane < 32) {
            float mt[8], m2[8]; float ms = 0.f;
#pragma unroll
            for (int t = 0; t < 8; ++t) { const unsigned long long w = __hip_atomic_load(slot + t, __ATOMIC_RELAXED, __HIP_MEMORY_SCOPE_AGENT); mt[t] = __uint_as_float((unsigned)w); m2[t] = __uint_as_float((unsigned)(w >> 32)); ms += mt[t]; }
            const float mean = ms * 0.125f; float q = 0.f;
#pragma unroll
            for (int t = 0; t < 8; ++t) { const float dm = mt[t] - mean; q += m2[t] + 256.0f * dm * dm; }
            S[row] = (f32x2){mean, 1.0f / sqrtf(q * (1.0f / 2048.0f) + LN_EPS)};
        }
        asm volatile("s_waitcnt lgkmcnt(0)" ::: "memory"); __builtin_amdgcn_s_barrier(); asm volatile("" ::: "memory");
#pragma unroll
        for (int bj = 0; bj < 2; ++bj)
#pragma unroll
            for (int n = 0; n < 2; ++n) { const f32x4 gg = *(const f32x4*)(g + col0 + bj * HALF + n * 16), bb = *(const f32x4*)(b + col0 + bj * HALF + n * 16);
#pragma unroll
                for (int ai = 0; ai < 2; ++ai)
#pragma unroll
                    for (int m = 0; m < 4; ++m) { const int r = ai * HALF + wr * 64 + m * 16 + fr; const f32x2 sr = S[r]; const size_t off = (size_t)(u.pm * BM + r) * D + col0 + bj * HALF + n * 16;
                        const f32x4 o = (acc[ai][bj][m][n] - sr.x) * sr.y * gg + bb; if (XF) *(f32x4*)(XF + off) = o; u32x2 w; w.x = pk2(o[0], o[1]); w.y = pk2(o[2], o[3]); *(u32x2*)(XB + off) = w; } }
    }
};

template <class Epi, class Sched, bool ALIGN_EPI = true>
__device__ __forceinline__ void gemm_phase(LAS unsigned char* lds, const Gemm g, const Sched& S, const Epi& E) {
    int tid = threadIdx.x; asm volatile("" : "+v"(tid));
    const int wid = __builtin_amdgcn_readfirstlane(tid >> 6), lane = tid & 63, wr = wid >> 2, wc = wid & 3, fr = lane & 15, fq = lane >> 4;
    const int K = g.K, nt = K / BK;
    unsigned voffA[2], voffB[2];
#pragma unroll
    for (int i = 0; i < 2; ++i) { int R, C; stage_rc(tid * 16 + i * 8192, R, C); const int Rb = Epi::PERM ? ((R & ~31) + perm32(R & 31)) : R;
        voffA[i] = (unsigned)(R * g.lda + C) * 2u; voffB[i] = (unsigned)(Rb * g.ldb + C) * 2u; }
    const size_t kstep = (size_t)(BK * 2);
    const size_t hA = (size_t)HALF * g.lda * 2, hB = (size_t)HALF * g.ldb * 2;
    const unsigned ldsw = (unsigned)wid * 1024u;
    const int aoff = lds_byte(wr * 64 + fr, fq * 8), boff = lds_byte(wc * 32 + fr, fq * 8);
#define PG8_SA(b, h) (((b) * 2 + (h)) * HTB)
#define PG8_SB(b, h) ((4 + (b) * 2 + (h)) * HTB)
#define PG8_STAGE(bufoff, gbase, voff) do { _Pragma("unroll") for (int _i = 0; _i < 2; ++_i) \
        __builtin_amdgcn_global_load_lds((const unsigned*)((const char*)(gbase) + (voff)[_i]), (LAS unsigned*)(lds + (bufoff) + ldsw + _i * 8192), 16, 0, 0); } while (0)
#define PG8_LDA(dst, b, h) do { _Pragma("unroll") for (int m = 0; m < 4; ++m) _Pragma("unroll") for (int k = 0; k < 2; ++k) dst[m][k] = *(const LAS bf16x8*)(lds + PG8_SA(b, h) + aoff + m * 2048 + k * 1024); } while (0)
#define PG8_LDB(dst, b, h) do { _Pragma("unroll") for (int n = 0; n < 2; ++n) _Pragma("unroll") for (int k = 0; k < 2; ++k) dst[n][k] = *(const LAS bf16x8*)(lds + PG8_SB(b, h) + boff + n * 2048 + k * 1024); } while (0)
#define PG8_MMA(ai, bj, At, Bt) do { __builtin_amdgcn_s_setprio(1); _Pragma("unroll") for (int m = 0; m < 4; ++m) _Pragma("unroll") for (int n = 0; n < 2; ++n) _Pragma("unroll") for (int k = 0; k < 2; ++k) \
        acc[ai][bj][m][n] = __builtin_amdgcn_mfma_f32_16x16x32_bf16(Bt[n][k], At[m][k], acc[ai][bj][m][n], 0, 0, 0); __builtin_amdgcn_s_setprio(0); } while (0)
#define PG8_WAIT_V(n) asm volatile("s_waitcnt vmcnt(" #n ")" ::: "memory")
#define PG8_WAIT_L(n) asm volatile("s_waitcnt lgkmcnt(" #n ")" ::: "memory")
#define PG8_BAR __builtin_amdgcn_s_barrier()
#define PG8_SCHED __builtin_amdgcn_sched_barrier(0)
    Unit cur, nxt; int ui = 0;
    if (!S.next(0, cur)) return;
    f32x4 acc[2][2][4][2];
#pragma unroll
    for (int a = 0; a < 2; ++a)
#pragma unroll
        for (int b = 0; b < 2; ++b)
#pragma unroll
            for (int m = 0; m < 4; ++m)
#pragma unroll
                for (int n = 0; n < 2; ++n) acc[a][b][m][n] = (f32x4){0.f, 0.f, 0.f, 0.f};
    bf16x8 At[4][2], B0[2][2], B1[2][2];
    const char* cA = (const char*)g.A + ((size_t)cur.pm * BM * g.lda + (size_t)cur.pn * g.a_pn_off) * 2; const char* cB = (const char*)g.Bt + (size_t)cur.pn * BM * g.ldb * 2;
    PG8_STAGE(PG8_SB(0, 0), cB, voffB); PG8_STAGE(PG8_SB(0, 1), cB + hB, voffB); PG8_STAGE(PG8_SA(0, 0), cA, voffA); PG8_STAGE(PG8_SA(0, 1), cA + hA, voffA);
    if (wr == 1) PG8_BAR;
    PG8_WAIT_V(2); PG8_BAR;
    PG8_STAGE(PG8_SB(1, 0), cB + kstep, voffB); PG8_STAGE(PG8_SA(1, 0), cA + kstep, voffA); PG8_STAGE(PG8_SB(1, 1), cB + hB + kstep, voffB);
    PG8_WAIT_V(6); PG8_BAR;
    for (;;) {
        const bool has_next = S.next(ui + 1, nxt);
        const char* nA = has_next ? (const char*)g.A + ((size_t)nxt.pm * BM * g.lda + (size_t)nxt.pn * g.a_pn_off) * 2 : cA; const char* nB = has_next ? (const char*)g.Bt + (size_t)nxt.pn * BM * g.ldb * 2 : cB;
        for (int t = 0; t < nt; t += 2) {
            const bool last = (t == nt - 2);
            const char* a1 = cA + (size_t)(t + 1) * kstep;
            const char* a2 = last ? nA : cA + (size_t)(t + 2) * kstep; const char* b2 = last ? nB : cB + (size_t)(t + 2) * kstep;
            const char* a3 = a2 + kstep; const char* b3 = b2 + kstep;
            PG8_LDB(B0, 0, 0); PG8_LDB(B1, 0, 1); PG8_SCHED; PG8_LDA(At, 0, 0); PG8_STAGE(PG8_SA(1, 1), a1 + hA, voffA);
            PG8_WAIT_V(8); PG8_WAIT_L(0); PG8_BAR; PG8_MMA(0, 0, At, B0); PG8_MMA(0, 1, At, B1); PG8_BAR; PG8_SCHED;
            PG8_LDA(At, 0, 1); PG8_STAGE(PG8_SB(0, 0), b2, voffB); PG8_STAGE(PG8_SB(0, 1), b2 + hB, voffB); PG8_STAGE(PG8_SA(0, 0), a2, voffA);
            PG8_WAIT_V(8); PG8_WAIT_L(0); PG8_BAR; PG8_MMA(1, 0, At, B0); PG8_MMA(1, 1, At, B1); PG8_BAR; PG8_SCHED;
            PG8_LDB(B0, 1, 0); PG8_LDB(B1, 1, 1); PG8_SCHED; PG8_LDA(At, 1, 0); PG8_STAGE(PG8_SA(0, 1), a2 + hA, voffA);
            PG8_WAIT_V(8); PG8_WAIT_L(0); PG8_BAR; PG8_MMA(0, 0, At, B0); PG8_MMA(0, 1, At, B1); PG8_BAR; PG8_SCHED;
            PG8_LDA(At, 1, 1); PG8_STAGE(PG8_SB(1, 0), b3, voffB); PG8_STAGE(PG8_SB(1, 1), b3 + hB, voffB); PG8_STAGE(PG8_SA(1, 0), a3, voffA);
            PG8_WAIT_V(8); PG8_WAIT_L(0); PG8_BAR; PG8_MMA(1, 0, At, B0); PG8_MMA(1, 1, At, B1); PG8_BAR; PG8_SCHED;
        }
        if constexpr (ALIGN_EPI) { if (wr == 0) PG8_BAR; }
        E(acc, cur, wr, wc, fr, fq, wid, lane);
        if (!has_next) break;
#pragma unroll
        for (int a = 0; a < 2; ++a)
#pragma unroll
            for (int b = 0; b < 2; ++b)
#pragma unroll
                for (int m = 0; m < 4; ++m)
#pragma unroll
                    for (int n = 0; n < 2; ++n) acc[a][b][m][n] = (f32x4){0.f, 0.f, 0.f, 0.f};
        cur = nxt; cA = nA; cB = nB; ++ui;
        if constexpr (ALIGN_EPI) { if (wr == 1) PG8_BAR; }
    }
    PG8_WAIT_V(0);
    if constexpr (!ALIGN_EPI) { if (wr == 0) PG8_BAR; }
    PG8_BAR;
#undef PG8_SA
#undef PG8_SB
#undef PG8_STAGE
#undef PG8_LDA
#undef PG8_LDB
#undef PG8_MMA
#undef PG8_WAIT_V
#undef PG8_WAIT_L
#undef PG8_BAR
#undef PG8_SCHED
}
}

#define XB_TMO      128
#define XB_XCNT(j)  (256  + 64 * (j))
#define XB_XSUB(j)  (1280 + 64 * (j))
#define XB_XGEN(j)  (2304 + 64 * (j))
#define XB_TOP      3328
#define XB_TOPGEN   3392
#define XCD_BAR_WORDS 3456
#define XB_SPIN_CAP (1u << 22)
__device__ __forceinline__ unsigned xb_ld(unsigned* p)              { return __hip_atomic_load(p, __ATOMIC_RELAXED, __HIP_MEMORY_SCOPE_AGENT); }
__device__ __forceinline__ unsigned xb_add(unsigned* p, unsigned v) { return __hip_atomic_fetch_add(p, v, __ATOMIC_RELAXED, __HIP_MEMORY_SCOPE_AGENT); }
__device__ __forceinline__ unsigned xb_xcc_id() { return (unsigned)__builtin_amdgcn_s_getreg((3 << 11) | 20) & 0xFu; }
#define XB_SPIN(cond, bar) do { unsigned _sp = 0; while (cond) { __builtin_amdgcn_s_sleep(1); \
    if ((++_sp & 255u) == 0u) { if (xb_ld(&(bar)[XB_TMO])) break; if (_sp > XB_SPIN_CAP) { atomicAdd(&(bar)[XB_TMO], 1u); break; } } } } while (0)
struct XcdBarrier { unsigned* bar; unsigned x; volatile LAS unsigned* st; };
__device__ __forceinline__ XcdBarrier xcd_barrier_post(unsigned* bar, volatile LAS unsigned* st) {
    XcdBarrier b; b.bar = bar; b.x = xb_xcc_id(); b.st = st;
    if (threadIdx.x == 0) (void)xb_add(&bar[XB_XCNT(b.x)], 1u);
    return b;
}
__device__ __forceinline__ void xcd_barrier_complete(unsigned* bar, unsigned x, unsigned& nloc, unsigned& nx) {
    const unsigned G = gridDim.x * gridDim.y * gridDim.z;
    unsigned sum, cnt, mine, sp = 0u;
    for (;;) {
        sum = 0u; cnt = 0u; mine = 0u;
#pragma unroll
        for (unsigned j = 0; j < 16; ++j) { const unsigned c = xb_ld(&bar[XB_XCNT(j)]); sum += c; cnt += (c > 0u) ? 1u : 0u; mine = (j == x) ? c : mine; }
        if (sum == G) break;
        __builtin_amdgcn_s_sleep(1);
        if ((++sp & 255u) == 0u) { if (xb_ld(&bar[XB_TMO])) break; if (sp > XB_SPIN_CAP) { atomicAdd(&bar[XB_TMO], 1u); break; } }
    }
    nloc = mine > 0u ? mine : 1u; nx = cnt > 0u ? cnt : 1u;
}
__device__ __forceinline__ void xcd_barrier(const XcdBarrier& b) {
    asm volatile("s_waitcnt vmcnt(0)" ::: "memory");
    __syncthreads();
    if (threadIdx.x == 0) {
        unsigned* bar = b.bar;
        __builtin_amdgcn_s_waitcnt(0);
        unsigned nloc = b.st[0], nx = b.st[1];
        if (nloc == 0u) { xcd_barrier_complete(bar, b.x, nloc, nx); b.st[0] = nloc; b.st[1] = nx; }
        const unsigned old = xb_add(&bar[XB_XSUB(b.x)], 1u);
        const unsigned gen = old / nloc;
        if (old + 1u == (gen + 1u) * nloc) {
            __builtin_amdgcn_fence(__ATOMIC_RELEASE, "agent");
            asm volatile("s_waitcnt vmcnt(0)" ::: "memory");
            const unsigned og = xb_add(&bar[XB_TOP], 1u);
            const unsigned tg = og / nx;
            if (og + 1u == (tg + 1u) * nx) xb_add(&bar[XB_TOPGEN], 1u);
            else XB_SPIN(xb_ld(&bar[XB_TOPGEN]) == tg, bar);
            __builtin_amdgcn_fence(__ATOMIC_ACQUIRE, "agent");
            xb_add(&bar[XB_XGEN(b.x)], 1u);
            asm volatile("s_waitcnt vmcnt(0)" ::: "memory");
        } else {
            XB_SPIN(xb_ld(&bar[XB_XGEN(b.x)]) == gen, bar);
            __builtin_amdgcn_fence(__ATOMIC_ACQUIRE, "agent");
            asm volatile("s_waitcnt vmcnt(0)" ::: "memory");
        }
    }
    __syncthreads();
}

struct Args { const float* in[15]; float* out; unsigned char* ws; };
struct Frame { LAS unsigned char* lds; int tid, lane, wave, G, bid; };
__device__ __forceinline__ Frame relaunder(const Frame& F0) { Frame F = F0; int t = F0.tid; asm volatile("" : "+v"(t)); F.tid = t; F.lane = t & 63; F.wave = __builtin_amdgcn_readfirstlane(t >> 6); return F; }

__device__ __forceinline__ void p0_item(const float* W, int K, int N, bf16_t* WT, int row_off, bool permff, LAS float* scr, int item, int lane) {
    const int nblk = N >> 6, kb = item / nblk, nb = item - kb * nblk, k0 = kb << 6, n0 = nb << 6;
    const float* src = W + (size_t)k0 * N + n0 + lane;
#pragma unroll 16
    for (int kk = 0; kk < 64; ++kk) scr[kk * 65 + lane] = src[(size_t)kk * N];
    asm volatile("s_waitcnt lgkmcnt(0)" ::: "memory");
    int orow0 = row_off + n0;
    if (permff) { orow0 = (n0 < FF) ? ((n0 >> 7) * 256 + (n0 & 127)) : (((n0 - FF) >> 7) * 256 + 128 + ((n0 - FF) & 127)); }
#pragma unroll
    for (int j = 0; j < 8; ++j) { const int id = lane + 64 * j, n = id >> 3, c = id & 7; const LAS float* s = scr + (8 * c) * 65 + n;
        u32x4 o; o.x = pk2(s[0 * 65], s[1 * 65]); o.y = pk2(s[2 * 65], s[3 * 65]); o.z = pk2(s[4 * 65], s[5 * 65]); o.w = pk2(s[6 * 65], s[7 * 65]);
        *(u32x4*)(WT + (size_t)(orow0 + n) * K + k0 + 8 * c) = o; }
    asm volatile("s_waitcnt lgkmcnt(0)" ::: "memory");
}
__device__ __forceinline__ void p0_prologue(const Frame& F0, const Args& a) {
    const Frame F = relaunder(F0);
    LAS float* scr = (LAS float*)(F.lds + F.wave * 16640);
    const int gw = F.bid * 8 + F.wave, NGW = F.G * 8;
    unsigned char* ws = a.ws;
    constexpr int I_EIN = (D / 64) * (EIN / 64), I_SQ = (D / 64) * (D / 64), I_PW = 16, I_QKV = (D / 64) * (OIN / 64), I_F1 = (D / 64) * (FF2 / 64), I_F2 = (FF / 64) * (D / 64);
    constexpr int T0 = 2 * I_EIN, T1 = T0 + 2 * I_SQ, T2 = T1 + 8 * I_PW, T3 = T2 + 2 * I_QKV, T4 = T3 + 2 * I_SQ, T5 = T4 + 4 * I_F1, T6 = T5 + 4 * I_F2;
    for (int it = gw; it < T6; it += NGW) {
        if (it < T0) { const int li = it / I_EIN, r = it - li * I_EIN; p0_item(a.in[3] + (size_t)li * D * EIN, D, EIN, (bf16_t*)(ws + WS_EIN) + (size_t)li * EIN * D, 0, false, scr, r, F.lane); }
        else if (it < T1) { const int x = it - T0, li = x / I_SQ, r = x - li * I_SQ; p0_item(a.in[6] + (size_t)li * D * D, D, D, (bf16_t*)(ws + WS_EOUT) + (size_t)li * D * D, 0, false, scr, r, F.lane); }
        else if (it < T2) { const int x = it - T1, lg = x / I_PW, r = x - lg * I_PW, li = lg >> 2, g = lg & 3; p0_item(a.in[4] + (size_t)lg * 65536, 256, 256, (bf16_t*)(ws + WS_POOLW) + (size_t)li * 1024 * 256, g * 256, false, scr, r, F.lane); }
        else if (it < T3) { const int x = it - T2, li = x / I_QKV, r = x - li * I_QKV; p0_item(a.in[7] + (size_t)li * D * OIN, D, OIN, (bf16_t*)(ws + WS_QKVW) + (size_t)li * OIN * D, 0, false, scr, r, F.lane); }
        else if (it < T4) { const int x = it - T3, li = x / I_SQ, r = x - li * I_SQ; p0_item(a.in[10] + (size_t)li * D * D, D, D, (bf16_t*)(ws + WS_AOUT) + (size_t)li * D * D, 0, false, scr, r, F.lane); }
        else if (it < T5) { const int x = it - T4, l = x / I_F1, r = x - l * I_F1; p0_item(a.in[11] + (size_t)l * D * FF2, D, FF2, (bf16_t*)(ws + WS_F1) + (size_t)l * FF2 * D, 0, true, scr, r, F.lane); }
        else { const int x = it - T5, l = x / I_F2, r = x - l * I_F2; p0_item(a.in[14] + (size_t)l * FF * D, FF, D, (bf16_t*)(ws + WS_F2) + (size_t)l * D * FF, 0, false, scr, r, F.lane); }
    }
    const f32x4* x4 = (const f32x4*)a.in[0]; u32x2* xb = (u32x2*)(ws + WS_XB);
    for (size_t i = (size_t)F.bid * 512 + F.tid; i < (size_t)M * D / 4; i += (size_t)F.G * 512) { const f32x4 v = x4[i]; u32x2 o; o.x = pk2(v[0], v[1]); o.y = pk2(v[2], v[3]); xb[i] = o; }
}

__device__ __forceinline__ void ln_phase(const Frame& F0, const float* Y, const float* g, const float* b, float* XF, bf16_t* XB) {
    const Frame F = relaunder(F0);
    const int gw = F.bid * 8 + F.wave, NGW = F.G * 8;
    for (int row = gw; row < M; row += NGW) {
        const f32x4* yr = (const f32x4*)(Y + (size_t)row * D) + F.lane;
        f32x4 v[8]; float s = 0.f;
#pragma unroll
        for (int j = 0; j < 8; ++j) { v[j] = yr[64 * j]; s += (v[j][0] + v[j][1]) + (v[j][2] + v[j][3]); }
        const float mean = wave_sum(s) * (1.f / D); float s2 = 0.f;
#pragma unroll
        for (int j = 0; j < 8; ++j) { v[j] = v[j] - mean; s2 += (v[j][0] * v[j][0] + v[j][1] * v[j][1]) + (v[j][2] * v[j][2] + v[j][3] * v[j][3]); }
        const float rstd = 1.0f / sqrtf(wave_sum(s2) * (1.f / D) + LN_EPS);
        f32x4* xo = (f32x4*)(XF + (size_t)row * D) + F.lane; u32x2* bo = (u32x2*)(XB + (size_t)row * D) + F.lane;
#pragma unroll
        for (int j = 0; j < 8; ++j) { const f32x4 gg = ((const f32x4*)g)[F.lane + 64 * j], bb = ((const f32x4*)b)[F.lane + 64 * j];
            const f32x4 o = v[j] * rstd * gg + bb; xo[64 * j] = o; u32x2 w; w.x = pk2(o[0], o[1]); w.y = pk2(o[2], o[3]); bo[64 * j] = w; }
    }
}

__device__ __forceinline__ void conv_fixup_phase(const Frame& F0, const float* HALO, const float* cw, const float* cb, bf16_t* ACT) {
    const Frame F = relaunder(F0);
    constexpr int NCQ = FF / 4;
    for (int it = F.bid * 512 + F.tid; it < 64 * NCQ; it += F.G * 512) {
        const int pm = it / NCQ, cq = it - pm * NCQ; if ((pm & 15) == 0) continue;
        const int c = cq * 4, col = (c >> 7) * 256 + (c & 127);
        f32x4 cv[2][2];
#pragma unroll
        for (int bj = 0; bj < 2; ++bj) {
            const float* hp = HALO + (size_t)(pm * 4) * FF2 + col + bj * 128;
            const f32x4 hm2 = *(const f32x4*)(hp - 2 * FF2), hm1 = *(const f32x4*)(hp - FF2), h0 = *(const f32x4*)hp, h1 = *(const f32x4*)(hp + FF2);
            const f32x4 w0 = *(const f32x4*)(cw + bj * FF + c), w1 = *(const f32x4*)(cw + (size_t)FF2 + bj * FF + c), w2 = *(const f32x4*)(cw + (size_t)2 * FF2 + bj * FF + c), b = *(const f32x4*)(cb + bj * FF + c);
            cv[bj][0] = b + w0 * hm2 + w1 * hm1 + w2 * h0; cv[bj][1] = b + w0 * hm1 + w1 * h0 + w2 * h1;
        }
#pragma unroll
        for (int rr = 0; rr < 2; ++rr) { const f32x2 g0 = gelu_pk((f32x2){cv[0][rr][0], cv[0][rr][1]}), g1 = gelu_pk((f32x2){cv[0][rr][2], cv[0][rr][3]});
            u32x2 o; o.x = pk2(g0.x * cv[1][rr][0], g0.y * cv[1][rr][1]); o.y = pk2(g1.x * cv[1][rr][2], g1.y * cv[1][rr][3]);
            *(u32x2*)(ACT + (size_t)(pm * 256 + rr) * FF + c) = o; }
    }
}

__device__ __forceinline__ void attn_phase(const Frame& F0, const bf16_t* QKV, const float* sinks, bf16_t* MIX) {
    const Frame F = relaunder(F0);
    constexpr int RS = 144;
    LAS unsigned char* Kt = F.lds; LAS unsigned char* Vt = F.lds + 256 * RS;
    const int lane = F.lane, r = lane & 15, g4 = lane >> 4, qq = r >> 2, pp = r & 3;
    for (int u = F.bid; u < 512; u += F.G) {
        const int kvh = u & 3, n = (u >> 2) & 31, b = u >> 7, tok0 = b * SEQ + n * 128;
        for (int c = F.tid; c < 256 * 8; c += 512) { const int row = c >> 3, ch = c & 7; const bool valid = (n > 0) || (row >= 128);
            u32x4 kv = (u32x4){0u, 0u, 0u, 0u}, vv = kv;
            if (valid) { const bf16_t* src = QKV + (size_t)(tok0 - 128 + row) * OIN + 2048 + kvh * 64 + ch * 8; kv = *(const u32x4*)src; vv = *(const u32x4*)(src + 256); }
            *(LAS u32x4*)(Kt + row * RS + ch * 16) = kv; *(LAS u32x4*)(Vt + row * RS + ch * 16) = vv; }
        __syncthreads();
        const int head = kvh * 8 + F.wave;
        const float slope2 = __builtin_amdgcn_exp2f(-0.25f * (float)(head + 1)) * LOG2E, sink2 = sinks[head] * LOG2E;
        for (int rb = 0; rb < 8; ++rb) {
            const bf16_t* qp = QKV + (size_t)(tok0 + 16 * rb + r) * OIN + head * 64 + 8 * g4;
            const bf16x8 q0 = *(const bf16x8*)qp, q1 = *(const bf16x8*)(qp + 32);
            f32x4 s[9];
#pragma unroll
            for (int tt = 0; tt < 9; ++tt) { const LAS unsigned char* kp = Kt + (16 * (rb + tt) + r) * RS + 16 * g4;
                f32x4 acc = (f32x4){0.f, 0.f, 0.f, 0.f};
                acc = mfma16(*(const LAS bf16x8*)kp, q0, acc); acc = mfma16(*(const LAS bf16x8*)(kp + 64), q1, acc); s[tt] = acc; }
            const int i = 16 * rb + r; float mx = -INFINITY;
#pragma unroll
            for (int tt = 0; tt < 9; ++tt)
#pragma unroll
                for (int jj = 0; jj < 4; ++jj) { const int j = 16 * (rb + tt) + 4 * g4 + jj, delta = 128 + i - j; const bool valid = (delta >= 0) && (delta < 128) && ((n > 0) || (j >= 128));
                    const float v = s[tt][jj] * (0.125f * LOG2E) - slope2 * (float)delta; s[tt][jj] = valid ? v : -INFINITY; mx = fmaxf(mx, s[tt][jj]); }
            mx = fmaxf(mx, __shfl_xor(mx, 16)); mx = fmaxf(mx, __shfl_xor(mx, 32)); mx = fmaxf(mx, sink2);
            float sum = 0.f;
#pragma unroll
            for (int tt = 0; tt < 9; ++tt)
#pragma unroll
                for (int jj = 0; jj < 4; ++jj) { const float p = __builtin_amdgcn_exp2f(s[tt][jj] - mx); s[tt][jj] = p; sum += p; }
            sum += __shfl_xor(sum, 16); sum += __shfl_xor(sum, 32);
            const float inv = 1.0f / (sum + __builtin_amdgcn_exp2f(sink2 - mx));
            u32x2 P[10];
#pragma unroll
            for (int tt = 0; tt < 9; ++tt) { P[tt].x = pk2(s[tt][0] * inv, s[tt][1] * inv); P[tt].y = pk2(s[tt][2] * inv, s[tt][3] * inv); }
            P[9] = (u32x2){0u, 0u};
            f32x4 o[4];
#pragma unroll
            for (int te = 0; te < 4; ++te) o[te] = (f32x4){0.f, 0.f, 0.f, 0.f};
#pragma unroll
            for (int pr = 0; pr < 5; ++pr) { const int t0 = 2 * pr, t1 = (pr < 4) ? 2 * pr + 1 : 2 * pr;
                const u32x4 bw = (u32x4){P[t0].x, P[t0].y, P[2 * pr + 1].x, P[2 * pr + 1].y}; const bf16x8 bfrag = __builtin_bit_cast(bf16x8, bw);
                const LAS unsigned char* v0 = Vt + (16 * (rb + t0) + 4 * g4 + qq) * RS + 8 * pp; const LAS unsigned char* v1 = Vt + (16 * (rb + t1) + 4 * g4 + qq) * RS + 8 * pp;
#pragma unroll
                for (int te = 0; te < 4; ++te) o[te] = mfma16(cat8(vtr(v0 + 32 * te), vtr(v1 + 32 * te)), bfrag, o[te]); }
            bf16_t* op = MIX + (size_t)(tok0 + i) * D + head * 64 + 4 * g4;
#pragma unroll
            for (int te = 0; te < 4; ++te) { u32x2 w; w.x = pk2(o[te][0], o[te][1]); w.y = pk2(o[te][2], o[te][3]); *(u32x2*)(op + 16 * te) = w; }
        }
        __syncthreads();
    }
}

__device__ __forceinline__ float ret_lg2(int h) { return __builtin_amdgcn_logf(1.0f - __builtin_amdgcn_exp2f(-5.0f - (float)h)); }
constexpr int RRS = 528;

__device__ __forceinline__ void ret_kv_phase(const Frame& F0, const bf16_t* H5, float* KVT) {
    const Frame F = relaunder(F0);
    LAS unsigned char* Kt = F.lds; LAS unsigned char* Vt = F.lds + 128 * RRS;
    const int lane = F.lane, r = lane & 15, g4 = lane >> 4, qq = r >> 2, pp = r & 3, w = F.wave;
    for (int u = F.bid; u < 512; u += F.G) {
        const int h = u & 3, n = (u >> 2) & 31, b = u >> 7, tok0 = b * SEQ + n * 128; const float lg2 = ret_lg2(h);
        for (int c = F.tid; c < 128 * 32; c += 512) { const int row = c >> 5, ch = c & 31; const bf16_t* src = H5 + (size_t)(tok0 + row) * EIN + 1024 + h * 256 + ch * 8;
            const u32x4 kv = *(const u32x4*)src, vv = *(const u32x4*)(src + 1024); const float z = __builtin_amdgcn_exp2f(lg2 * (float)(127 - row)) * 0.0625f;
            u32x4 ks;
#pragma unroll
            for (int e = 0; e < 4; ++e) ks[e] = pk2(bflo(kv[e]) * z, bfhi(kv[e]) * z);
            *(LAS u32x4*)(Kt + row * RRS + ch * 16) = ks; *(LAS u32x4*)(Vt + row * RRS + ch * 16) = vv; }
        __syncthreads();
        for (int dh = 0; dh < 2; ++dh) {
            f32x4 acc[2][8];
#pragma unroll
            for (int a = 0; a < 2; ++a)
#pragma unroll
                for (int d = 0; d < 8; ++d) acc[a][d] = (f32x4){0.f, 0.f, 0.f, 0.f};
#pragma unroll
            for (int ks = 0; ks < 4; ++ks) { const int R0 = 32 * ks + 8 * g4 + qq;
                const LAS unsigned char* vb = Vt + R0 * RRS + 8 * pp; const LAS unsigned char* kb = Kt + R0 * RRS + 8 * pp + 256 * dh;
                const bf16x8 vf0 = cat8(vtr(vb + 64 * w), vtr(vb + 4 * RRS + 64 * w)), vf1 = cat8(vtr(vb + 64 * w + 32), vtr(vb + 4 * RRS + 64 * w + 32));
#pragma unroll
                for (int dt = 0; dt < 8; ++dt) { const bf16x8 kf = cat8(vtr(kb + 32 * dt), vtr(kb + 4 * RRS + 32 * dt)); acc[0][dt] = mfma16(kf, vf0, acc[0][dt]); acc[1][dt] = mfma16(kf, vf1, acc[1][dt]); } }
            float* op = KVT + (size_t)u * 65536 + (size_t)(32 * w + r) * 256 + 128 * dh + 4 * g4;
#pragma unroll
            for (int a = 0; a < 2; ++a)
#pragma unroll
                for (int dt = 0; dt < 8; ++dt) *(f32x4*)(op + a * 16 * 256 + 16 * dt) = acc[a][dt];
        }
        __syncthreads();
    }
}
__device__ __forceinline__ void pooled_phase(const Frame& F0, const bf16_t* H5, bf16_t* PO) {
    const Frame F = relaunder(F0);
    for (int it = F.bid * 512 + F.tid; it < 1024 * 128; it += F.G * 512) {
        const int cgp = it & 127, run = it >> 7, c = cgp * 8, w = 2 << (c >> 8), t0 = run * 16, p0 = t0 & (SEQ - 1);
        const bf16_t* U = H5 + 4096 + c;
        float S[8];
#pragma unroll
        for (int e = 0; e < 8; ++e) S[e] = 0.f;
        for (int s = 1; s < w; ++s) if (p0 - s >= 0) { const u32x4 x = *(const u32x4*)(U + (size_t)(t0 - s) * EIN);
#pragma unroll
            for (int e = 0; e < 4; ++e) { S[2 * e] += bflo(x[e]); S[2 * e + 1] += bfhi(x[e]); } }
        for (int k = 0; k < 16; ++k) { const int t = t0 + k, p = p0 + k; const u32x4 x = *(const u32x4*)(U + (size_t)t * EIN);
            const float rc = 1.0f / (float)((p + 1 < w) ? p + 1 : w); u32x4 o;
#pragma unroll
            for (int e = 0; e < 4; ++e) { const float a0 = bflo(x[e]), a1 = bfhi(x[e]); S[2 * e] += a0; S[2 * e + 1] += a1; o[e] = pk2(S[2 * e] * rc - a0, S[2 * e + 1] * rc - a1); }
            *(u32x4*)(PO + (size_t)t * 1024 + c) = o;
            if (p - (w - 1) >= 0) { const u32x4 y = *(const u32x4*)(U + (size_t)(t - (w - 1)) * EIN);
#pragma unroll
                for (int e = 0; e < 4; ++e) { S[2 * e] -= bflo(y[e]); S[2 * e + 1] -= bfhi(y[e]); } }
        }
    }
}
__device__ __forceinline__ void ret_scan_phase(const Frame& F0, const float* KVT, bf16_t* PREVT) {
    const Frame F = relaunder(F0);
    for (int it = F.bid * 512 + F.tid; it < 16 * 16384; it += F.G * 512) {
        const int bh = it >> 14, e4 = it & 16383, b = bh >> 2, h = bh & 3; const float cd = __builtin_amdgcn_exp2f(ret_lg2(h) * 128.0f);
        f32x4 st = (f32x4){0.f, 0.f, 0.f, 0.f};
#pragma unroll 4
        for (int n = 0; n < 31; ++n) { const size_t u = (size_t)((b * 32 + n) * 4 + h);
            st = st * cd + *(const f32x4*)(KVT + u * 65536 + (size_t)e4 * 4);
            u32x2 o; o.x = pk2(st[0], st[1]); o.y = pk2(st[2], st[3]); *(u32x2*)(PREVT + (u + 4) * 65536 + (size_t)e4 * 4) = o; }
    }
}
__device__ __forceinline__ void ret_out_phase(const Frame& F0, const bf16_t* H5, const bf16_t* PREVT, bf16_t* MIX) {
    const Frame F = relaunder(F0);
    LAS unsigned char* Kt = F.lds; LAS unsigned char* Vt = F.lds + 128 * RRS;
    const int lane = F.lane, r = lane & 15, g4 = lane >> 4, qq = r >> 2, pp = r & 3, w = F.wave;
    for (int u = F.bid; u < 512; u += F.G) {
        const int h = u & 3, n = (u >> 2) & 31, b = u >> 7, tok0 = b * SEQ + n * 128; const float lg2 = ret_lg2(h);
        for (int c = F.tid; c < 128 * 32; c += 512) { const int row = c >> 5, ch = c & 31; const bf16_t* src = H5 + (size_t)(tok0 + row) * EIN + 1024 + h * 256 + ch * 8;
            *(LAS u32x4*)(Kt + row * RRS + ch * 16) = *(const u32x4*)src; *(LAS u32x4*)(Vt + row * RRS + ch * 16) = *(const u32x4*)(src + 1024); }
        const int i = 16 * w + r;
        bf16x8 Qf[8];
        { const bf16_t* qp = H5 + (size_t)(tok0 + i) * EIN + h * 256 + 8 * g4;
#pragma unroll
          for (int kk = 0; kk < 8; ++kk) Qf[kk] = *(const bf16x8*)(qp + 32 * kk); }
        __syncthreads();
        u32x2 P[8];
#pragma unroll
        for (int tj = 0; tj < 8; ++tj) {
            P[tj] = (u32x2){0u, 0u};
            if (tj <= w) { f32x4 acc = (f32x4){0.f, 0.f, 0.f, 0.f}; const LAS unsigned char* kp = Kt + (16 * tj + r) * RRS + 16 * g4;
#pragma unroll
                for (int kk = 0; kk < 8; ++kk) acc = mfma16(*(const LAS bf16x8*)(kp + 64 * kk), Qf[kk], acc);
                float pv[4];
#pragma unroll
                for (int jj = 0; jj < 4; ++jj) { const int j = 16 * tj + 4 * g4 + jj; pv[jj] = (i >= j) ? acc[jj] * 0.0625f * __builtin_amdgcn_exp2f(lg2 * (float)(i - j)) : 0.f; }
                P[tj].x = pk2(pv[0], pv[1]); P[tj].y = pk2(pv[2], pv[3]); }
        }
        __syncthreads();
        f32x4 acc[16];
#pragma unroll
        for (int te = 0; te < 16; ++te) acc[te] = (f32x4){0.f, 0.f, 0.f, 0.f};
        if (n > 0) {
#pragma unroll
            for (int half = 0; half < 2; ++half) {
                for (int c = F.tid; c < 128 * 32; c += 512) { const int row = c >> 5, ch = c & 31;
                    *(LAS u32x4*)(Kt + row * RRS + ch * 16) = *(const u32x4*)(PREVT + (size_t)u * 65536 + (size_t)(128 * half + row) * 256 + ch * 8); }
                __syncthreads();
#pragma unroll
                for (int te = 0; te < 8; ++te) { const LAS unsigned char* pq = Kt + (16 * te + r) * RRS + 16 * g4;
#pragma unroll
                    for (int kk = 0; kk < 8; ++kk) acc[8 * half + te] = mfma16(*(const LAS bf16x8*)(pq + 64 * kk), Qf[kk], acc[8 * half + te]);
                    asm volatile("" : "+v"(acc[8 * half + te])); }
                __syncthreads();
            }
            const float xi = __builtin_amdgcn_exp2f(lg2 * (float)(i + 1));
#pragma unroll
            for (int te = 0; te < 16; ++te) acc[te] = acc[te] * xi;
        }
#pragma unroll
        for (int pr = 0; pr < 4; ++pr) {
            if (2 * pr <= w) { const u32x4 bw = (u32x4){P[2 * pr].x, P[2 * pr].y, P[2 * pr + 1].x, P[2 * pr + 1].y}; const bf16x8 bfrag = __builtin_bit_cast(bf16x8, bw);
                const LAS unsigned char* v0 = Vt + (32 * pr + 4 * g4 + qq) * RRS + 8 * pp;
#pragma unroll
                for (int te = 0; te < 16; ++te) { acc[te] = mfma16(cat8(vtr(v0 + 32 * te), vtr(v0 + 16 * RRS + 32 * te)), bfrag, acc[te]); if ((te & 3) == 3) asm volatile("" : "+v"(acc[te])); } }
        }
        float s = 0.f;
#pragma unroll
        for (int te = 0; te < 16; ++te) s += (acc[te][0] + acc[te][1]) + (acc[te][2] + acc[te][3]);
        s += __shfl_xor(s, 16); s += __shfl_xor(s, 32);
        const float mean = s * (1.f / 256.f); float s2 = 0.f;
#pragma unroll
        for (int te = 0; te < 16; ++te) { acc[te] = acc[te] - mean; s2 += (acc[te][0] * acc[te][0] + acc[te][1] * acc[te][1]) + (acc[te][2] * acc[te][2] + acc[te][3] * acc[te][3]); }
        s2 += __shfl_xor(s2, 16); s2 += __shfl_xor(s2, 32);
        const float rstd = 1.0f / sqrtf(s2 * (1.f / 256.f) + LN_EPS);
        const bf16_t* gp = H5 + (size_t)(tok0 + i) * EIN + 3072 + h * 256 + 4 * g4; bf16_t* op = MIX + (size_t)(tok0 + i) * D + h * 256 + 4 * g4;
#pragma unroll
        for (int te = 0; te < 16; ++te) { const u32x2 gw = *(const u32x2*)(gp + 16 * te); float gv[4] = {bflo(gw.x), bfhi(gw.x), bflo(gw.y), bfhi(gw.y)}; float ov[4];
#pragma unroll
            for (int jj = 0; jj < 4; ++jj) { const float sg = gv[jj] / (1.0f + __builtin_amdgcn_exp2f(-gv[jj] * LOG2E)); ov[jj] = sg * acc[te][jj] * rstd; }
            u32x2 o; o.x = pk2(ov[0], ov[1]); o.y = pk2(ov[2], ov[3]); *(u32x2*)(op + 16 * te) = o; }
        __syncthreads();
    }
}

__device__ __forceinline__ void gemm_res_ln(const Frame& F, const XcdBarrier& bar, const bf16_t* A, const bf16_t* Bt, int K, const float* xres, float* Y, float* XF, bf16_t* XB,
                                            const float* g, const float* b, unsigned char* ws, int inst, bool last) {
    pg8::Gemm gm{A, Bt, K, K, K, 0};
    if (F.G == 256) {
        pg8::PanelOrder S{F.bid};
        pg8::EpiResLn E{xres, last ? XF : nullptr, XB, g, b, (unsigned long long*)(ws + WS_XCH) + (size_t)inst * 131072, (unsigned*)(ws + WS_CTL) + CW_LN + inst * 4096, F.lds + 131072};
        pg8::gemm_phase<pg8::EpiResLn, pg8::PanelOrder, true>(F.lds, gm, S, E);
        xcd_barrier(bar);
    } else {
        pg8::StaticOrder S; S.init(M, D, F.G, F.bid);
        pg8::EpiRes E{xres ? xres : XF, Y};
        pg8::gemm_phase<pg8::EpiRes, pg8::StaticOrder, true>(F.lds, gm, S, E);
        xcd_barrier(bar);
        ln_phase(F, Y, g, b, XF, XB);
        xcd_barrier(bar);
    }
}

__global__ void __launch_bounds__(512, 2) fwd_megakernel(Args args) {
    extern __shared__ __attribute__((aligned(16))) unsigned char lds_raw[];
    cg::grid_group grid = cg::this_grid();
    Frame F; F.lds = (LAS unsigned char*)lds_raw; F.tid = threadIdx.x; F.lane = F.tid & 63; F.wave = __builtin_amdgcn_readfirstlane(F.tid >> 6); F.G = gridDim.x; F.bid = blockIdx.x;
    unsigned char* ws = args.ws;
    bf16_t* XB = (bf16_t*)(ws + WS_XB); float* Y = (float*)(ws + WS_Y); bf16_t* MIX = (bf16_t*)(ws + WS_MIX);
    float* HALO = (float*)(ws + WS_HF); bf16_t* ACT = (bf16_t*)(ws + WS_ACT); bf16_t* H5 = (bf16_t*)(ws + WS_H5); bf16_t* QKV = (bf16_t*)(ws + WS_QKV);
    float* KVT = (float*)(ws + WS_KVT); bf16_t* PREVT = (bf16_t*)(ws + WS_PREVT); bf16_t* POOLED = (bf16_t*)(ws + WS_POOLED);
    float* XF = args.out;

    for (int u = F.tid; u < (LDS_BYTES - MISC_OFF) / 4; u += 512) ((LAS unsigned*)(F.lds + MISC_OFF))[u] = 0u;
    __syncthreads();
    const XcdBarrier bar = xcd_barrier_post((unsigned*)(ws + WS_CTL), (volatile LAS unsigned*)(F.lds + MISC_OFF));
#define GRID_BAR() xcd_barrier(bar)

    for (int rep = 0; rep < EXP_REP_P0; ++rep) p0_prologue(F, args);
    grid.sync();

    for (int layer = 0; layer < 4; ++layer) {
        const int li = layer >> 1;
        const float* xres = (layer == 0) ? args.in[0] : nullptr;
        if ((layer & 1) == 0) {
            for (int rep = 0; rep < EXP_REP_INP; ++rep)
            {
                pg8::Gemm g{XB, (const bf16_t*)(ws + WS_EIN) + (size_t)li * EIN * D, D, D, D, 0}; pg8::StaticOrder S; S.init(M, EIN, F.G, F.bid);
                pg8::EpiBf16 E{H5, EIN, nullptr, nullptr, 0};
                pg8::gemm_phase<pg8::EpiBf16, pg8::StaticOrder, true>(F.lds, g, S, E);
            }
            GRID_BAR();
            for (int rep = 0; rep < EXP_REP_RET; ++rep) {
            ret_kv_phase(F, H5, KVT);
            pooled_phase(F, H5, POOLED);
            GRID_BAR();
            ret_scan_phase(F, KVT, PREVT);
            {
                pg8::Gemm g{POOLED, (const bf16_t*)(ws + WS_POOLW) + (size_t)li * 1024 * 256, 1024, 256, 256, 256}; pg8::StaticOrder S; S.init(M, 1024, F.G, F.bid);
                pg8::EpiBf16 E{MIX, D, nullptr, args.in[5] + (size_t)li * 1024, 1024};
                pg8::gemm_phase<pg8::EpiBf16, pg8::StaticOrder, true>(F.lds, g, S, E);
            }
            GRID_BAR();
            ret_out_phase(F, H5, PREVT, MIX);
            GRID_BAR();
            }
        } else {
            {
                pg8::Gemm g{XB, (const bf16_t*)(ws + WS_QKVW) + (size_t)li * OIN * D, D, D, D, 0}; pg8::StaticOrder S; S.init(M, OIN, F.G, F.bid);
                pg8::EpiBf16 E{QKV, OIN, args.in[8] + (size_t)li * OIN, nullptr, 0};
                pg8::gemm_phase<pg8::EpiBf16, pg8::StaticOrder, true>(F.lds, g, S, E);
            }
            GRID_BAR();
            for (int rep = 0; rep < EXP_REP_ATT; ++rep) {
            attn_phase(F, QKV, args.in[9] + li * 32, MIX);
            GRID_BAR();
            }
        }
        gemm_res_ln(F, bar, MIX, ((layer & 1) == 0) ? (const bf16_t*)(ws + WS_EOUT) + (size_t)li * D * D : (const bf16_t*)(ws + WS_AOUT) + (size_t)li * D * D, D, xres, Y, XF, XB,
                    args.in[1] + (size_t)(layer * 2 + 0) * D, args.in[2] + (size_t)(layer * 2 + 0) * D, ws, layer * 2 + 0, false);
        for (int rep = 0; rep < EXP_REP_F1; ++rep)
        {
            pg8::Gemm g{XB, (const bf16_t*)(ws + WS_F1) + (size_t)layer * FF2 * D, D, D, D, 0}; pg8::StaticOrder S; S.init(M, FF2, F.G, F.bid);
            pg8::EpiConvGlu E{ACT, HALO, args.in[12] + (size_t)layer * 3 * FF2, args.in[13] + (size_t)layer * FF2, (LAS float*)(F.lds + 131072)};
            pg8::gemm_phase<pg8::EpiConvGlu, pg8::StaticOrder, true>(F.lds, g, S, E);
        }
        GRID_BAR();
        conv_fixup_phase(F, HALO, args.in[12] + (size_t)layer * 3 * FF2, args.in[13] + (size_t)layer * FF2, ACT);
        GRID_BAR();
        gemm_res_ln(F, bar, ACT, (const bf16_t*)(ws + WS_F2) + (size_t)layer * D * FF, FF, nullptr, Y, XF, XB,
                    args.in[1] + (size_t)(layer * 2 + 1) * D, args.in[2] + (size_t)(layer * 2 + 1) * D, ws, layer * 2 + 1, layer == 3);
    }
}

extern "C" void kernel_launch(void* const* d_in, const int* in_sizes, int n_in, void* d_out, int out_size, void* d_ws, size_t ws_size, hipStream_t stream) {
    static int grid = 0;
    if (grid == 0) {
        if (n_in != 15 || out_size != M * D || ws_size < WS_END) { fprintf(stderr, "kernel_launch: unexpected problem: n_in %d out %d ws %zu (need %zu)\n", n_in, out_size, ws_size, (size_t)WS_END); grid = -1; return; }
        int dev = 0, cus = 0, per_cu = 0;
        hipGetDevice(&dev); hipDeviceGetAttribute(&cus, hipDeviceAttributeMultiprocessorCount, dev);
        if (hipFuncSetAttribute((const void*)fwd_megakernel, hipFuncAttributeMaxDynamicSharedMemorySize, LDS_BYTES) != hipSuccess) { fprintf(stderr, "kernel_launch: hipFuncSetAttribute failed\n"); grid = -1; return; }
        if (hipOccupancyMaxActiveBlocksPerMultiprocessor(&per_cu, (const void*)fwd_megakernel, 512, LDS_BYTES) != hipSuccess || per_cu < 1) { fprintf(stderr, "kernel_launch: occupancy query says %d\n", per_cu); per_cu = 1; }
        (void)hipGetLastError();
        grid = cus;
    }
    if (grid < 0) return;
    Args a{};
    for (int i = 0; i < 15; ++i) a.in[i] = (const float*)d_in[i];
    a.out = (float*)d_out; a.ws = (unsigned char*)d_ws;
    if (hipMemsetAsync((char*)d_ws + WS_CTL, 0, CTL_BYTES, stream) != hipSuccess) { fprintf(stderr, "kernel_launch: memset failed\n"); return; }
    void* kargs[] = {&a};
    hipError_t e = hipLaunchCooperativeKernel((const void*)fwd_megakernel, dim3(grid), dim3(512), kargs, LDS_BYTES, stream);
    if (e != hipSuccess) fprintf(stderr, "kernel_launch: cooperative launch failed: %s (grid %d)\n", hipGetErrorString(e), grid);
}
```

```cpp
#include <hip/hip_runtime.h>
#include <hip/hip_cooperative_groups.h>
#include <cstdio>
#include <cstdint>
namespace cg = cooperative_groups;
#ifndef EXP_REP_P0
#define EXP_REP_P0 1
#endif
#ifndef EXP_REP_RET
#define EXP_REP_RET 1
#endif
#ifndef EXP_REP_F1
#define EXP_REP_F1 1
#endif
#ifndef EXP_REP_INP
#define EXP_REP_INP 1
#endif
#ifndef EXP_REP_ATT
#define EXP_REP_ATT 1
#endif

#define LAS __attribute__((address_space(3)))
typedef unsigned short bf16_t;
typedef short bf16x8 __attribute__((ext_vector_type(8)));
typedef short s16x4 __attribute__((ext_vector_type(4)));
typedef float f32x4 __attribute__((ext_vector_type(4)));
typedef float f32x2 __attribute__((ext_vector_type(2)));
typedef unsigned u32x4 __attribute__((ext_vector_type(4)));
typedef unsigned u32x2 __attribute__((ext_vector_type(2)));
typedef __bf16 bf16x2_t __attribute__((ext_vector_type(2)));

constexpr int NBATCH = 4, SEQ = 4096, M = NBATCH * SEQ, D = 2048;
constexpr int EIN = 5120, OIN = 2560, FF = 5632, FF2 = 11264;
constexpr float ALPHA = 1.6817928305074290f;
constexpr float LN_EPS = 1e-5f;
constexpr float LOG2E = 1.4426950408889634f;

constexpr size_t MiB = 1u << 20;
constexpr size_t WS_EIN = 0 * MiB;
constexpr size_t WS_EOUT = 40 * MiB;
constexpr size_t WS_POOLW = 56 * MiB;
constexpr size_t WS_QKVW = 57 * MiB;
constexpr size_t WS_AOUT = 77 * MiB;
constexpr size_t WS_F1 = 93 * MiB;
constexpr size_t WS_F2 = 269 * MiB;
constexpr size_t WS_XB = 357 * MiB;
constexpr size_t WS_Y = 421 * MiB;
constexpr size_t WS_MIX = 549 * MiB;
constexpr size_t WS_BIG = 613 * MiB;
constexpr size_t WS_HF = WS_BIG;
constexpr size_t WS_ACT = WS_BIG + 352 * MiB;
constexpr size_t WS_H5 = WS_BIG;
constexpr size_t WS_QKV = WS_BIG;
constexpr size_t WS_KVT = WS_BIG + 160 * MiB;
constexpr size_t WS_PREVT = WS_BIG + 288 * MiB;
constexpr size_t WS_POOLED = WS_BIG + 352 * MiB;
constexpr size_t WS_CTL = 1141 * MiB;
constexpr size_t CTL_BYTES = 256 * 1024;
constexpr int CW_LN = 4096;
constexpr size_t WS_XCH = 1142 * MiB;
constexpr size_t WS_END = 1150 * MiB;
constexpr int MISC_OFF = 143360;

constexpr int LDS_BYTES = 147456;

__device__ __forceinline__ unsigned pk2(float lo, float hi) { f32x2 v = {lo, hi}; bf16x2_t b = __builtin_convertvector(v, bf16x2_t); return __builtin_bit_cast(unsigned, b); }
__device__ __forceinline__ float bflo(unsigned w) { return __uint_as_float(w << 16); }
__device__ __forceinline__ float bfhi(unsigned w) { return __uint_as_float(w & 0xffff0000u); }
__device__ __forceinline__ float wave_sum(float v) {
#pragma unroll
    for (int o = 1; o < 64; o <<= 1) v += __shfl_xor(v, o);
    return v;
}
typedef short v4i16_t __attribute__((ext_vector_type(4)));
__device__ __forceinline__ s16x4 vtr(const LAS unsigned char* p) { return __builtin_bit_cast(s16x4, __builtin_amdgcn_ds_read_tr16_b64_v4i16((LAS v4i16_t*)p)); }
__device__ __forceinline__ bf16x8 cat8(s16x4 lo, s16x4 hi) { return (bf16x8){lo[0], lo[1], lo[2], lo[3], hi[0], hi[1], hi[2], hi[3]}; }
__device__ __forceinline__ f32x4 mfma16(bf16x8 a, bf16x8 b, f32x4 c) { return __builtin_amdgcn_mfma_f32_16x16x32_bf16(a, b, c, 0, 0, 0); }
__device__ __forceinline__ f32x2 gelu_pk(f32x2 v) {
    const f32x2 av = __builtin_elementwise_abs(v), d = av * 0.2316418882f + 1.0f;
    f32x2 t; t.x = __builtin_amdgcn_rcpf(d.x); t.y = __builtin_amdgcn_rcpf(d.y);
    f32x2 q = t * 0.5307027145f + (-0.7265760135f); q = q * t + 0.7107068705f; q = q * t + (-0.142248368f); q = q * t + 0.127414796f; q = q * t;
    const f32x2 s = (v * v) * (-0.72134752044f);
    f32x2 e; e.x = __builtin_amdgcn_exp2f(s.x); e.y = __builtin_amdgcn_exp2f(s.y);
    const f32x2 m = v * (q * e), r = v - m;
    f32x2 o; o.x = v.x < 0.f ? m.x : r.x; o.y = v.y < 0.f ? m.y : r.y; return o;
}

namespace pg8 {
constexpr int BM = 256, BK = 64, HALF = 128, HTB = HALF * BK * 2, STAGE_BYTES = 8 * HTB, NXCD = 8, WGM = 8;
__host__ __device__ __forceinline__ int lds_byte(int r, int c) { const int st = (r >> 4) * 2 + (c >> 5), rr = r & 15, cc = c & 31, ob = rr * 64 + cc * 2; return st * 1024 + (ob ^ (((ob >> 9) & 1) << 5)); }
__host__ __device__ __forceinline__ void stage_rc(int b, int& R, int& C) { const int st = b / 1024, sb = b % 1024, swz = sb ^ (((sb >> 9) & 1) << 5); R = (st >> 1) * 16 + swz / 64; C = (st & 1) * 32 + (swz % 64) / 2; }
__host__ __device__ __forceinline__ int perm32(int rho) { const int n = rho >> 4, i = rho & 15; return 8 * (i >> 2) + 4 * n + (i & 3); }

struct Unit { int pm, pn; };
struct Gemm { const bf16_t* A; const bf16_t* Bt; int lda, ldb, K, a_pn_off; };

struct StaticOrder {
    int nM, nN, nwg, G, c;
    __device__ void init(int M_, int N_, int G_, int c_) { nM = M_ / BM; nN = N_ / BM; nwg = nM * nN; G = G_; c = c_; }
    __device__ bool next(int i, Unit& u) const {
        const long L = (long)i * G + c; if (L >= nwg) return false;
        int wgid = (int)L; { const int q = nwg / NXCD, r = nwg % NXCD, xcd = wgid % NXCD, off = wgid / NXCD; wgid = (xcd < r ? xcd * (q + 1) : r * (q + 1) + (xcd - r) * q) + off; }
        const int nig = WGM * nN, gid = wgid / nig, fm = gid * WGM, gsz = (nM - fm) < WGM ? (nM - fm) : WGM;
        u.pm = fm + ((wgid % nig) % gsz); u.pn = (wgid % nig) / gsz; return true;
    }
};

struct EpiBf16 {
    static constexpr bool PERM = true;
    bf16_t* O; int ldc; const float* bias; const float* scale; int ocol_off;
    __device__ __forceinline__ void operator()(f32x4 (&acc)[2][2][4][2], const Unit& u, int wr, int wc, int fr, int fq, int wid, int lane) const {
        const int row0 = u.pm * BM + wr * 64 + fr; const int bcol0 = u.pn * BM + wc * 32 + 8 * fq; const int col0 = ocol_off + bcol0;
        f32x4 bv[2][2], sv[2][2];
#pragma unroll
        for (int bj = 0; bj < 2; ++bj)
#pragma unroll
            for (int n = 0; n < 2; ++n) { bv[bj][n] = bias ? *(const f32x4*)(bias + bcol0 + bj * HALF + 4 * n) : (f32x4){0.f, 0.f, 0.f, 0.f};
                                          sv[bj][n] = scale ? *(const f32x4*)(scale + bcol0 + bj * HALF + 4 * n) : (f32x4){1.f, 1.f, 1.f, 1.f}; }
#pragma unroll
        for (int ai = 0; ai < 2; ++ai)
#pragma unroll
            for (int m = 0; m < 4; ++m) { bf16_t* rowp = O + (size_t)(row0 + ai * HALF + m * 16) * ldc + col0;
#pragma unroll
                for (int bj = 0; bj < 2; ++bj) { f32x4 v0 = (acc[ai][bj][m][0] + bv[bj][0]) * sv[bj][0], v1 = (acc[ai][bj][m][1] + bv[bj][1]) * sv[bj][1];
                    u32x4 w; w.x = pk2(v0[0], v0[1]); w.y = pk2(v0[2], v0[3]); w.z = pk2(v1[0], v1[1]); w.w = pk2(v1[2], v1[3]);
                    *(u32x4*)(rowp + bj * HALF) = w; } }
    }
};
struct EpiRes {
    static constexpr bool PERM = false;
    const float* X; float* Y;
    __device__ __forceinline__ void operator()(f32x4 (&acc)[2][2][4][2], const Unit& u, int wr, int wc, int fr, int fq, int wid, int lane) const {
        const int row0 = u.pm * BM + wr * 64 + fr, col0 = u.pn * BM + wc * 32 + 4 * fq;
#pragma unroll
        for (int ai = 0; ai < 2; ++ai)
#pragma unroll
            for (int m = 0; m < 4; ++m) { const size_t off = (size_t)(row0 + ai * HALF + m * 16) * D + col0;
#pragma unroll
                for (int bj = 0; bj < 2; ++bj)
#pragma unroll
                    for (int n = 0; n < 2; ++n) { const f32x4 xv = *(const f32x4*)(X + off + bj * HALF + n * 16); *(f32x4*)(Y + off + bj * HALF + n * 16) = xv * ALPHA + acc[ai][bj][m][n]; }
                asm volatile("" ::: "memory"); }
    }
};

__device__ __forceinline__ float dpp_ror1(float v) { return __int_as_float(__builtin_amdgcn_update_dpp(0, __float_as_int(v), 0x121, 0xf, 0xf, true)); }
__device__ __forceinline__ float dpp_ror2(float v) { return __int_as_float(__builtin_amdgcn_update_dpp(0, __float_as_int(v), 0x122, 0xf, 0xf, true)); }
struct EpiConvGlu {
    static constexpr bool PERM = true;
    bf16_t* ACT; float* HALO; const float* cw; const float* cb; LAS float* xbuf;
    __device__ __forceinline__ void operator()(f32x4 (&acc)[2][2][4][2], const Unit& u, int wr, int wc, int fr_, int fq_, int wid, int lane_) const {
        int lane = lane_; asm volatile("" : "+v"(lane));
        const int fr = lane & 15, fq = lane >> 4;
        const int cl = 32 * wc + 8 * fq;
        LAS float* wl = xbuf + 2048;
        {
            const int t = wid * 64 + lane, kind = t >> 6, pr = t & 63, bj = kind >> 2, tap = kind & 3;
            const float* src = (tap < 3) ? (cw + (size_t)tap * FF2 + bj * FF + u.pn * 128 + 2 * pr) : (cb + bj * FF + u.pn * 128 + 2 * pr);
            const f32x2 wv = *(const f32x2*)src;
            if (fr >= 14) {
                unsigned xo = (unsigned)(wr * 512 + (fr - 14) * 128 + cl) * 4u; asm volatile("" : "+v"(xo));
                LAS unsigned char* xb = (LAS unsigned char*)xbuf + xo;
#pragma unroll
                for (int ai = 0; ai < 2; ++ai)
#pragma unroll
                    for (int bj2 = 0; bj2 < 2; ++bj2)
#pragma unroll
                        for (int n = 0; n < 2; ++n) *(LAS f32x4*)(xb + (ai * 1024 + bj2 * 256 + 4 * n) * 4) = acc[ai][bj2][3][n];
            }
            if (wr == 0 && fr < 2) {
#pragma unroll
                for (int bj2 = 0; bj2 < 2; ++bj2)
#pragma unroll
                    for (int n = 0; n < 2; ++n) *(f32x4*)(HALO + (size_t)(u.pm * 4 + fr) * FF2 + u.pn * 256 + bj2 * 128 + cl + 4 * n) = acc[0][bj2][0][n];
            }
            if (wr == 1 && fr >= 14) {
#pragma unroll
                for (int bj2 = 0; bj2 < 2; ++bj2)
#pragma unroll
                    for (int n = 0; n < 2; ++n) *(f32x4*)(HALO + (size_t)(u.pm * 4 + fr - 12) * FF2 + u.pn * 256 + bj2 * 128 + cl + 4 * n) = acc[1][bj2][3][n];
            }
            *(LAS f32x2*)(wl + kind * 128 + 2 * pr) = wv;
        }
        asm volatile("s_waitcnt lgkmcnt(0)" ::: "memory"); __builtin_amdgcn_s_barrier(); asm volatile("" ::: "memory");
        const int row0 = u.pm * BM + wr * 64 + fr;
        const float k1a = fr >= 1 ? 1.f : 0.f, k1b = 1.f - k1a, k0a = fr >= 2 ? 1.f : 0.f, k0b = 1.f - k0a;
#pragma unroll
        for (int n = 0; n < 2; ++n)
#pragma unroll
            for (int bj = 0; bj < 2; ++bj) {
                const LAS float* wp = wl + bj * 512 + cl + 4 * n;
                const f32x4 t0 = *(const LAS f32x4*)wp, t1 = *(const LAS f32x4*)(wp + 128), w2 = *(const LAS f32x4*)(wp + 256), bb = *(const LAS f32x4*)(wp + 384);
                const f32x4 w1a = t1 * k1a, w1b = t1 * k1b, w0a = t0 * k0a, w0b = t0 * k0b;
#pragma unroll
                for (int ai = 0; ai < 2; ++ai) {
                    f32x4 r1p = (f32x4){0.f, 0.f, 0.f, 0.f}, r2p = r1p;
                    if (wr == 1 || ai == 1) { const int sai = (wr == 1) ? ai : 0, swr = (wr == 1) ? 0 : 1; const LAS float* xp = xbuf + (((sai * 2 + swr) * 2 + bj) * 2) * 128 + cl + 4 * n;
                        r1p = *(const LAS f32x4*)(xp + 128); r2p = *(const LAS f32x4*)(xp + (fr & 1) * 128); }
#pragma unroll
                    for (int m = 0; m < 4; ++m) {
                        const f32x4 cur = acc[ai][bj][m][n]; f32x4 r1, r2;
#pragma unroll
                        for (int j = 0; j < 4; ++j) { r1[j] = dpp_ror1(cur[j]); r2[j] = dpp_ror2(cur[j]); }
                        acc[ai][bj][m][n] = bb + w2 * cur + w1a * r1 + w0a * r2 + w1b * r1p + w0b * r2p;
                        r1p = r1; r2p = r2;
                        asm volatile("" : "+v"(acc[ai][bj][m][n]));
                    }
                }
            }
        const int ch = u.pn * 128 + cl;
#pragma unroll
        for (int ai = 0; ai < 2; ++ai)
#pragma unroll
            for (int m = 0; m < 4; ++m) {
                u32x4 o;
#pragma unroll
                for (int n = 0; n < 2; ++n) { const f32x4 gv = acc[ai][0][m][n], vv = acc[ai][1][m][n];
                    const f32x2 g0 = gelu_pk((f32x2){gv[0], gv[1]}), g1 = gelu_pk((f32x2){gv[2], gv[3]});
                    o[2 * n] = pk2(g0.x * vv[0], g0.y * vv[1]); o[2 * n + 1] = pk2(g1.x * vv[2], g1.y * vv[3]); }
                *(u32x4*)(ACT + (size_t)(row0 + ai * HALF + m * 16) * FF + ch) = o;
            }
    }
};

struct PanelOrder {
    int c;
    __device__ bool next(int i, Unit& u) const { if (i >= 2) return false; const int x = c & 7, j = c >> 3; u.pm = 32 * i + 4 * x + (j & 3); u.pn = j >> 2; return true; }
};
struct EpiResLn {
    static constexpr bool PERM = false;
    const float* X; float* XF; bf16_t* XB; const float* g; const float* b; unsigned long long* slots; unsigned* cnt; LAS unsigned char* tl;
    __device__ __forceinline__ void operator()(f32x4 (&acc)[2][2][4][2], const Unit& u, int wr, int wc, int fr, int fq, int wid, int lane) const {
        LAS f32x2* P = (LAS f32x2*)tl; LAS f32x2* S = (LAS f32x2*)(tl + 8192);
        const int row0 = u.pm * BM + wr * 64 + fr, col0 = u.pn * BM + wc * 32 + 4 * fq;
#pragma unroll
        for (int ai = 0; ai < 2; ++ai)
#pragma unroll
            for (int m = 0; m < 4; ++m) { const size_t off = (size_t)(row0 + ai * HALF + m * 16) * D + col0;
#pragma unroll
                for (int bj = 0; bj < 2; ++bj)
#pragma unroll
                    for (int n = 0; n < 2; ++n) { f32x4 xv;
                        if (X) xv = *(const f32x4*)(X + off + bj * HALF + n * 16);
                        else { const u32x2 xw = *(const u32x2*)(XB + off + bj * HALF + n * 16); xv = (f32x4){bflo(xw.x), bfhi(xw.x), bflo(xw.y), bfhi(xw.y)}; }
                        acc[ai][bj][m][n] = xv * ALPHA + acc[ai][bj][m][n]; }
                asm volatile("" : "+v"(acc[ai][0][m][0]), "+v"(acc[ai][0][m][1]), "+v"(acc[ai][1][m][0]), "+v"(acc[ai][1][m][1]));
                float s = 0.f;
#pragma unroll
                for (int bj = 0; bj < 2; ++bj)
#pragma unroll
                    for (int n = 0; n < 2; ++n) { const f32x4 x = acc[ai][bj][m][n]; s += (x[0] + x[1]) + (x[2] + x[3]); }
                s += __shfl_xor(s, 16); s += __shfl_xor(s, 32);
                const float mw = s * (1.0f / 64.0f); float q = 0.f;
#pragma unroll
                for (int bj = 0; bj < 2; ++bj)
#pragma unroll
                    for (int n = 0; n < 2; ++n) { const f32x4 d = acc[ai][bj][m][n] - mw; q += (d[0] * d[0] + d[1] * d[1]) + (d[2] * d[2] + d[3] * d[3]); }
                q += __shfl_xor(q, 16); q += __shfl_xor(q, 32);
                if (fq == 0) P[(ai * HALF + wr * 64 + m * 16 + fr) * 4 + wc] = (f32x2){mw, q};
            }
        asm volatile("s_waitcnt lgkmcnt(0)" ::: "memory"); __builtin_amdgcn_s_barrier(); asm volatile("" ::: "memory");
        const int row = wid * 32 + (lane & 31);
        unsigned long long* slot = slots + ((size_t)(u.pm * BM + row) * 8);
        if (lane < 32) {
            const f32x2 a = P[row * 4 + 0], b4 = P[row * 4 + 1], c = P[row * 4 + 2], d = P[row * 4 + 3];
            const float mt = (a.x + b4.x + c.x + d.x) * 0.25f;
            const float da = a.x - mt, db = b4.x - mt, dc = c.x - mt, dd = d.x - mt;
            const float m2 = (a.y + b4.y) + (c.y + d.y) + 64.0f * ((da * da + db * db) + (dc * dc + dd * dd));
            __hip_atomic_store(slot + u.pn, ((unsigned long long)__float_as_uint(m2) << 32) | __float_as_uint(mt), __ATOMIC_RELAXED, __HIP_MEMORY_SCOPE_AGENT);
        }
        asm volatile("s_waitcnt vmcnt(0)" ::: "memory");
        unsigned* cw = cnt + 64 * u.pm;
        if (lane == 0) __hip_atomic_fetch_add(cw, 1u, __ATOMIC_RELAXED, __HIP_MEMORY_SCOPE_AGENT);
        if (wid == 0) {
            unsigned sp = 0;
            while ((unsigned)__builtin_amdgcn_readfirstlane(__hip_atomic_load(cw, __ATOMIC_RELAXED, __HIP_MEMORY_SCOPE_AGENT)) < 64u) { __builtin_amdgcn_s_sleep(1); if (++sp > (1u << 24)) break; }
            __builtin_amdgcn_fence(__ATOMIC_ACQUIRE, "agent");
        }
        asm volatile("s_waitcnt vmcnt(0) lgkmcnt(0)" ::: "memory"); __builtin_amdgcn_s_barrier(); asm volatile("" ::: "memory");
        if (lane < 32) {
            float mt[8], m2[8]; float ms = 0.f;
#pragma unroll
            for (int t = 0; t < 8; ++t) { const unsigned long long w = __hip_atomic_load(slot + t, __ATOMIC_RELAXED, __HIP_MEMORY_SCOPE_AGENT); mt[t] = __uint_as_float((unsigned)w); m2[t] = __uint_as_float((unsigned)(w >> 32)); ms += mt[t]; }
            const float mean = ms * 0.125f; float q = 0.f;
#pragma unroll
            for (int t = 0; t < 8; ++t) { const float dm = mt[t] - mean; q += m2[t] + 256.0f * dm * dm; }
            S[row] = (f32x2){mean, 1.0f / sqrtf(q * (1.0f / 2048.0f) + LN_EPS)};
        }
        asm volatile("s_waitcnt lgkmcnt(0)" ::: "memory"); __builtin_amdgcn_s_barrier(); asm volatile("" ::: "memory");
#pragma unroll
        for (int bj = 0; bj < 2; ++bj)
#pragma unroll
            for (int n = 0; n < 2; ++n) { const f32x4 gg = *(const f32x4*)(g + col0 + bj * HALF + n * 16), bb = *(const f32x4*)(b + col0 + bj * HALF + n * 16);
#pragma unroll
                for (int ai = 0; ai < 2; ++ai)
#pragma unroll
                    for (int m = 0; m < 4; ++m) { const int r = ai * HALF + wr * 64 + m * 16 + fr; const f32x2 sr = S[r]; const size_t off = (size_t)(u.pm * BM + r) * D + col0 + bj * HALF + n * 16;
                        const f32x4 o = (acc[ai][bj][m][n] - sr.x) * sr.y * gg + bb; if (XF) *(f32x4*)(XF + off) = o; u32x2 w; w.x = pk2(o[0], o[1]); w.y = pk2(o[2], o[3]); *(u32x2*)(XB + off) = w; } }
    }
};

template <class Epi, class Sched, bool ALIGN_EPI = true>
__device__ __forceinline__ void gemm_phase(LAS unsigned char* lds, const Gemm g, const Sched& S, const Epi& E) {
    int tid = threadIdx.x; asm volatile("" : "+v"(tid));
    const int wid = __builtin_amdgcn_readfirstlane(tid >> 6), lane = tid & 63, wr = wid >> 2, wc = wid & 3, fr = lane & 15, fq = lane >> 4;
    const int K = g.K, nt = K / BK;
    unsigned voffA[2], voffB[2];
#pragma unroll
    for (int i = 0; i < 2; ++i) { int R, C; stage_rc(tid * 16 + i * 8192, R, C); const int Rb = Epi::PERM ? ((R & ~31) + perm32(R & 31)) : R;
        voffA[i] = (unsigned)(R * g.lda + C) * 2u; voffB[i] = (unsigned)(Rb * g.ldb + C) * 2u; }
    const size_t kstep = (size_t)(BK * 2);
    const size_t hA = (size_t)HALF * g.lda * 2, hB = (size_t)HALF * g.ldb * 2;
    const unsigned ldsw = (unsigned)wid * 1024u;
    const int aoff = lds_byte(wr * 64 + fr, fq * 8), boff = lds_byte(wc * 32 + fr, fq * 8);
#define PG8_SA(b, h) (((b) * 2 + (h)) * HTB)
#define PG8_SB(b, h) ((4 + (b) * 2 + (h)) * HTB)
#define PG8_STAGE(bufoff, gbase, voff) do { _Pragma("unroll") for (int _i = 0; _i < 2; ++_i) \
        __builtin_amdgcn_global_load_lds((const unsigned*)((const char*)(gbase) + (voff)[_i]), (LAS unsigned*)(lds + (bufoff) + ldsw + _i * 8192), 16, 0, 0); } while (0)
#define PG8_LDA(dst, b, h) do { _Pragma("unroll") for (int m = 0; m < 4; ++m) _Pragma("unroll") for (int k = 0; k < 2; ++k) dst[m][k] = *(const LAS bf16x8*)(lds + PG8_SA(b, h) + aoff + m * 2048 + k * 1024); } while (0)
#define PG8_LDB(dst, b, h) do { _Pragma("unroll") for (int n = 0; n < 2; ++n) _Pragma("unroll") for (int k = 0; k < 2; ++k) dst[n][k] = *(const LAS bf16x8*)(lds + PG8_SB(b, h) + boff + n * 2048 + k * 1024); } while (0)
#define PG8_MMA(ai, bj, At, Bt) do { __builtin_amdgcn_s_setprio(1); _Pragma("unroll") for (int m = 0; m < 4; ++m) _Pragma("unroll") for (int n = 0; n < 2; ++n) _Pragma("unroll") for (int k = 0; k < 2; ++k) \
        acc[ai][bj][m][n] = __builtin_amdgcn_mfma_f32_16x16x32_bf16(Bt[n][k], At[m][k], acc[ai][bj][m][n], 0, 0, 0); __builtin_amdgcn_s_setprio(0); } while (0)
#define PG8_WAIT_V(n) asm volatile("s_waitcnt vmcnt(" #n ")" ::: "memory")
#define PG8_WAIT_L(n) asm volatile("s_waitcnt lgkmcnt(" #n ")" ::: "memory")
#define PG8_BAR __builtin_amdgcn_s_barrier()
#define PG8_SCHED __builtin_amdgcn_sched_barrier(0)
    Unit cur, nxt; int ui = 0;
    if (!S.next(0, cur)) return;
    f32x4 acc[2][2][4][2];
#pragma unroll
    for (int a = 0; a < 2; ++a)
#pragma unroll
        for (int b = 0; b < 2; ++b)
#pragma unroll
            for (int m = 0; m < 4; ++m)
#pragma unroll
                for (int n = 0; n < 2; ++n) acc[a][b][m][n] = (f32x4){0.f, 0.f, 0.f, 0.f};
    bf16x8 At[4][2], B0[2][2], B1[2][2];
    const char* cA = (const char*)g.A + ((size_t)cur.pm * BM * g.lda + (size_t)cur.pn * g.a_pn_off) * 2; const char* cB = (const char*)g.Bt + (size_t)cur.pn * BM * g.ldb * 2;
    PG8_STAGE(PG8_SB(0, 0), cB, voffB); PG8_STAGE(PG8_SB(0, 1), cB + hB, voffB); PG8_STAGE(PG8_SA(0, 0), cA, voffA); PG8_STAGE(PG8_SA(0, 1), cA + hA, voffA);
    if (wr == 1) PG8_BAR;
    PG8_WAIT_V(2); PG8_BAR;
    PG8_STAGE(PG8_SB(1, 0), cB + kstep, voffB); PG8_STAGE(PG8_SA(1, 0), cA + kstep, voffA); PG8_STAGE(PG8_SB(1, 1), cB + hB + kstep, voffB);
    PG8_WAIT_V(6); PG8_BAR;
    for (;;) {
        const bool has_next = S.next(ui + 1, nxt);
        const char* nA = has_next ? (const char*)g.A + ((size_t)nxt.pm * BM * g.lda + (size_t)nxt.pn * g.a_pn_off) * 2 : cA; const char* nB = has_next ? (const char*)g.Bt + (size_t)nxt.pn * BM * g.ldb * 2 : cB;
        for (int t = 0; t < nt; t += 2) {
            const bool last = (t == nt - 2);
            const char* a1 = cA + (size_t)(t + 1) * kstep;
            const char* a2 = last ? nA : cA + (size_t)(t + 2) * kstep; const char* b2 = last ? nB : cB + (size_t)(t + 2) * kstep;
            const char* a3 = a2 + kstep; const char* b3 = b2 + kstep;
            PG8_LDB(B0, 0, 0); PG8_LDB(B1, 0, 1); PG8_SCHED; PG8_LDA(At, 0, 0); PG8_STAGE(PG8_SA(1, 1), a1 + hA, voffA);
            PG8_WAIT_V(8); PG8_WAIT_L(0); PG8_BAR; PG8_MMA(0, 0, At, B0); PG8_MMA(0, 1, At, B1); PG8_BAR; PG8_SCHED;
            PG8_LDA(At, 0, 1); PG8_STAGE(PG8_SB(0, 0), b2, voffB); PG8_STAGE(PG8_SB(0, 1), b2 + hB, voffB); PG8_STAGE(PG8_SA(0, 0), a2, voffA);
            PG8_WAIT_V(8); PG8_WAIT_L(0); PG8_BAR; PG8_MMA(1, 0, At, B0); PG8_MMA(1, 1, At, B1); PG8_BAR; PG8_SCHED;
            PG8_LDB(B0, 1, 0); PG8_LDB(B1, 1, 1); PG8_SCHED; PG8_LDA(At, 1, 0); PG8_STAGE(PG8_SA(0, 1), a2 + hA, voffA);
            PG8_WAIT_V(8); PG8_WAIT_L(0); PG8_BAR; PG8_MMA(0, 0, At, B0); PG8_MMA(0, 1, At, B1); PG8_BAR; PG8_SCHED;
            PG8_LDA(At, 1, 1); PG8_STAGE(PG8_SB(1, 0), b3, voffB); PG8_STAGE(PG8_SB(1, 1), b3 + hB, voffB); PG8_STAGE(PG8_SA(1, 0), a3, voffA);
            PG8_WAIT_V(8); PG8_WAIT_L(0); PG8_BAR; PG8_MMA(1, 0, At, B0); PG8_MMA(1, 1, At, B1); PG8_BAR; PG8_SCHED;
        }
        if constexpr (ALIGN_EPI) { if (wr == 0) PG8_BAR; }
        E(acc, cur, wr, wc, fr, fq, wid, lane);
        if (!has_next) break;
#pragma unroll
        for (int a = 0; a < 2; ++a)
#pragma unroll
            for (int b = 0; b < 2; ++b)
#pragma unroll
                for (int m = 0; m < 4; ++m)
#pragma unroll
                    for (int n = 0; n < 2; ++n) acc[a][b][m][n] = (f32x4){0.f, 0.f, 0.f, 0.f};
        cur = nxt; cA = nA; cB = nB; ++ui;
        if constexpr (ALIGN_EPI) { if (wr == 1) PG8_BAR; }
    }
    PG8_WAIT_V(0);
    if constexpr (!ALIGN_EPI) { if (wr == 0) PG8_BAR; }
    PG8_BAR;
#undef PG8_SA
#undef PG8_SB
#undef PG8_STAGE
#undef PG8_LDA
#undef PG8_LDB
#undef PG8_MMA
#undef PG8_WAIT_V
#undef PG8_WAIT_L
#undef PG8_BAR
#undef PG8_SCHED
}
}

#define XB_TMO      128
#define XB_XCNT(j)  (256  + 64 * (j))
#define XB_XSUB(j)  (1280 + 64 * (j))
#define XB_XGEN(j)  (2304 + 64 * (j))
#define XB_TOP      3328
#define XB_TOPGEN   3392
#define XCD_BAR_WORDS 3456
#define XB_SPIN_CAP (1u << 22)
__device__ __forceinline__ unsigned xb_ld(unsigned* p)              { return __hip_atomic_load(p, __ATOMIC_RELAXED, __HIP_MEMORY_SCOPE_AGENT); }
__device__ __forceinline__ unsigned xb_add(unsigned* p, unsigned v) { return __hip_atomic_fetch_add(p, v, __ATOMIC_RELAXED, __HIP_MEMORY_SCOPE_AGENT); }
__device__ __forceinline__ unsigned xb_xcc_id() { return (unsigned)__builtin_amdgcn_s_getreg((3 << 11) | 20) & 0xFu; }
#define XB_SPIN(cond, bar) do { unsigned _sp = 0; while (cond) { __builtin_amdgcn_s_sleep(1); \
    if ((++_sp & 255u) == 0u) { if (xb_ld(&(bar)[XB_TMO])) break; if (_sp > XB_SPIN_CAP) { atomicAdd(&(bar)[XB_TMO], 1u); break; } } } } while (0)
struct XcdBarrier { unsigned* bar; unsigned x; volatile LAS unsigned* st; };
__device__ __forceinline__ XcdBarrier xcd_barrier_post(unsigned* bar, volatile LAS unsigned* st) {
    XcdBarrier b; b.bar = bar; b.x = xb_xcc_id(); b.st = st;
    if (threadIdx.x == 0) (void)xb_add(&bar[XB_XCNT(b.x)], 1u);
    return b;
}
__device__ __forceinline__ void xcd_barrier_complete(unsigned* bar, unsigned x, unsigned& nloc, unsigned& nx) {
    const unsigned G = gridDim.x * gridDim.y * gridDim.z;
    unsigned sum, cnt, mine, sp = 0u;
    for (;;) {
        sum = 0u; cnt = 0u; mine = 0u;
#pragma unroll
        for (unsigned j = 0; j < 16; ++j) { const unsigned c = xb_ld(&bar[XB_XCNT(j)]); sum += c; cnt += (c > 0u) ? 1u : 0u; mine = (j == x) ? c : mine; }
        if (sum == G) break;
        __builtin_amdgcn_s_sleep(1);
        if ((++sp & 255u) == 0u) { if (xb_ld(&bar[XB_TMO])) break; if (sp > XB_SPIN_CAP) { atomicAdd(&bar[XB_TMO], 1u); break; } }
    }
    nloc = mine > 0u ? mine : 1u; nx = cnt > 0u ? cnt : 1u;
}
__device__ __forceinline__ void xcd_barrier(const XcdBarrier& b) {
    asm volatile("s_waitcnt vmcnt(0)" ::: "memory");
    __syncthreads();
    if (threadIdx.x == 0) {
        unsigned* bar = b.bar;
        __builtin_amdgcn_s_waitcnt(0);
        unsigned nloc = b.st[0], nx = b.st[1];
        if (nloc == 0u) { xcd_barrier_complete(bar, b.x, nloc, nx); b.st[0] = nloc; b.st[1] = nx; }
        const unsigned old = xb_add(&bar[XB_XSUB(b.x)], 1u);
        const unsigned gen = old / nloc;
        if (old + 1u == (gen + 1u) * nloc) {
            __builtin_amdgcn_fence(__ATOMIC_RELEASE, "agent");
            asm volatile("s_waitcnt vmcnt(0)" ::: "memory");
            const unsigned og = xb_add(&bar[XB_TOP], 1u);
            const unsigned tg = og / nx;
            if (og + 1u == (tg + 1u) * nx) xb_add(&bar[XB_TOPGEN], 1u);
            else XB_SPIN(xb_ld(&bar[XB_TOPGEN]) == tg, bar);
            __builtin_amdgcn_fence(__ATOMIC_ACQUIRE, "agent");
            xb_add(&bar[XB_XGEN(b.x)], 1u);
            asm volatile("s_waitcnt vmcnt(0)" ::: "memory");
        } else {
            XB_SPIN(xb_ld(&bar[XB_XGEN(b.x)]) == gen, bar);
            __builtin_amdgcn_fence(__ATOMIC_ACQUIRE, "agent");
            asm volatile("s_waitcnt vmcnt(0)" ::: "memory");
        }
    }
    __syncthreads();
}

struct Args { const float* in[15]; float* out; unsigned char* ws; };
struct Frame { LAS unsigned char* lds; int tid, lane, wave, G, bid; };
__device__ __forceinline__ Frame relaunder(const Frame& F0) { Frame F = F0; int t = F0.tid; asm volatile("" : "+v"(t)); F.tid = t; F.lane = t & 63; F.wave = __builtin_amdgcn_readfirstlane(t >> 6); return F; }

__device__ __forceinline__ void p0_item(const float* W, int K, int N, bf16_t* WT, int row_off, bool permff, LAS float* scr, int item, int lane) {
    const int nblk = N >> 6, kb = item / nblk, nb = item - kb * nblk, k0 = kb << 6, n0 = nb << 6;
    const float* src = W + (size_t)k0 * N + n0 + lane;
#pragma unroll 16
    for (int kk = 0; kk < 64; ++kk) scr[kk * 65 + lane] = src[(size_t)kk * N];
    asm volatile("s_waitcnt lgkmcnt(0)" ::: "memory");
    int orow0 = row_off + n0;
    if (permff) { orow0 = (n0 < FF) ? ((n0 >> 7) * 256 + (n0 & 127)) : (((n0 - FF) >> 7) * 256 + 128 + ((n0 - FF) & 127)); }
#pragma unroll
    for (int j = 0; j < 8; ++j) { const int id = lane + 64 * j, n = id >> 3, c = id & 7; const LAS float* s = scr + (8 * c) * 65 + n;
        u32x4 o; o.x = pk2(s[0 * 65], s[1 * 65]); o.y = pk2(s[2 * 65], s[3 * 65]); o.z = pk2(s[4 * 65], s[5 * 65]); o.w = pk2(s[6 * 65], s[7 * 65]);
        *(u32x4*)(WT + (size_t)(orow0 + n) * K + k0 + 8 * c) = o; }
    asm volatile("s_waitcnt lgkmcnt(0)" ::: "memory");
}
__device__ __forceinline__ void p0_prologue(const Frame& F0, const Args& a) {
    const Frame F = relaunder(F0);
    LAS float* scr = (LAS float*)(F.lds + F.wave * 16640);
    const int gw = F.bid * 8 + F.wave, NGW = F.G * 8;
    unsigned char* ws = a.ws;
    constexpr int I_EIN = (D / 64) * (EIN / 64), I_SQ = (D / 64) * (D / 64), I_PW = 16, I_QKV = (D / 64) * (OIN / 64), I_F1 = (D / 64) * (FF2 / 64), I_F2 = (FF / 64) * (D / 64);
    constexpr int T0 = 2 * I_EIN, T1 = T0 + 2 * I_SQ, T2 = T1 + 8 * I_PW, T3 = T2 + 2 * I_QKV, T4 = T3 + 2 * I_SQ, T5 = T4 + 4 * I_F1, T6 = T5 + 4 * I_F2;
    for (int it = gw; it < T6; it += NGW) {
        if (it < T0) { const int li = it / I_EIN, r = it - li * I_EIN; p0_item(a.in[3] + (size_t)li * D * EIN, D, EIN, (bf16_t*)(ws + WS_EIN) + (size_t)li * EIN * D, 0, false, scr, r, F.lane); }
        else if (it < T1) { const int x = it - T0, li = x / I_SQ, r = x - li * I_SQ; p0_item(a.in[6] + (size_t)li * D * D, D, D, (bf16_t*)(ws + WS_EOUT) + (size_t)li * D * D, 0, false, scr, r, F.lane); }
        else if (it < T2) { const int x = it - T1, lg = x / I_PW, r = x - lg * I_PW, li = lg >> 2, g = lg & 3; p0_item(a.in[4] + (size_t)lg * 65536, 256, 256, (bf16_t*)(ws + WS_POOLW) + (size_t)li * 1024 * 256, g * 256, false, scr, r, F.lane); }
        else if (it < T3) { const int x = it - T2, li = x / I_QKV, r = x - li * I_QKV; p0_item(a.in[7] + (size_t)li * D * OIN, D, OIN, (bf16_t*)(ws + WS_QKVW) + (size_t)li * OIN * D, 0, false, scr, r, F.lane); }
        else if (it < T4) { const int x = it - T3, li = x / I_SQ, r = x - li * I_SQ; p0_item(a.in[10] + (size_t)li * D * D, D, D, (bf16_t*)(ws + WS_AOUT) + (size_t)li * D * D, 0, false, scr, r, F.lane); }
        else if (it < T5) { const int x = it - T4, l = x / I_F1, r = x - l * I_F1; p0_item(a.in[11] + (size_t)l * D * FF2, D, FF2, (bf16_t*)(ws + WS_F1) + (size_t)l * FF2 * D, 0, true, scr, r, F.lane); }
        else { const int x = it - T5, l = x / I_F2, r = x - l * I_F2; p0_item(a.in[14] + (size_t)l * FF * D, FF, D, (bf16_t*)(ws + WS_F2) + (size_t)l * D * FF, 0, false, scr, r, F.lane); }
    }
    const f32x4* x4 = (const f32x4*)a.in[0]; u32x2* xb = (u32x2*)(ws + WS_XB);
    for (size_t i = (size_t)F.bid * 512 + F.tid; i < (size_t)M * D / 4; i += (size_t)F.G * 512) { const f32x4 v = x4[i]; u32x2 o; o.x = pk2(v[0], v[1]); o.y = pk2(v[2], v[3]); xb[i] = o; }
}

__device__ __forceinline__ void ln_phase(const Frame& F0, const float* Y, const float* g, const float* b, float* XF, bf16_t* XB) {
    const Frame F = relaunder(F0);
    const int gw = F.bid * 8 + F.wave, NGW = F.G * 8;
    for (int row = gw; row < M; row += NGW) {
        const f32x4* yr = (const f32x4*)(Y + (size_t)row * D) + F.lane;
        f32x4 v[8]; float s = 0.f;
#pragma unroll
        for (int j = 0; j < 8; ++j) { v[j] = yr[64 * j]; s += (v[j][0] + v[j][1]) + (v[j][2] + v[j][3]); }
        const float mean = wave_sum(s) * (1.f / D); float s2 = 0.f;
#pragma unroll
        for (int j = 0; j < 8; ++j) { v[j] = v[j] - mean; s2 += (v[j][0] * v[j][0] + v[j][1] * v[j][1]) + (v[j][2] * v[j][2] + v[j][3] * v[j][3]); }
        const float rstd = 1.0f / sqrtf(wave_sum(s2) * (1.f / D) + LN_EPS);
        f32x4* xo = (f32x4*)(XF + (size_t)row * D) + F.lane; u32x2* bo = (u32x2*)(XB + (size_t)row * D) + F.lane;
#pragma unroll
        for (int j = 0; j < 8; ++j) { const f32x4 gg = ((const f32x4*)g)[F.lane + 64 * j], bb = ((const f32x4*)b)[F.lane + 64 * j];
            const f32x4 o = v[j] * rstd * gg + bb; xo[64 * j] = o; u32x2 w; w.x = pk2(o[0], o[1]); w.y = pk2(o[2], o[3]); bo[64 * j] = w; }
    }
}

__device__ __forceinline__ void conv_fixup_item(int pm, int cq, const float* HALO, const float* cw, const float* cb, bf16_t* ACT) {
    const int c = cq * 4, col = (c >> 7) * 256 + (c & 127);
    f32x4 cv[2][2];
#pragma unroll
    for (int bj = 0; bj < 2; ++bj) {
        const float* hp = HALO + (size_t)(pm * 4) * FF2 + col + bj * 128;
        const f32x4 hm2 = *(const f32x4*)(hp - 2 * FF2), hm1 = *(const f32x4*)(hp - FF2), h0 = *(const f32x4*)hp, h1 = *(const f32x4*)(hp + FF2);
        const f32x4 w0 = *(const f32x4*)(cw + bj * FF + c), w1 = *(const f32x4*)(cw + (size_t)FF2 + bj * FF + c), w2 = *(const f32x4*)(cw + (size_t)2 * FF2 + bj * FF + c), b = *(const f32x4*)(cb + bj * FF + c);
        cv[bj][0] = b + w0 * hm2 + w1 * hm1 + w2 * h0; cv[bj][1] = b + w0 * hm1 + w1 * h0 + w2 * h1;
    }
#pragma unroll
    for (int rr = 0; rr < 2; ++rr) { const f32x2 g0 = gelu_pk((f32x2){cv[0][rr][0], cv[0][rr][1]}), g1 = gelu_pk((f32x2){cv[0][rr][2], cv[0][rr][3]});
        u32x2 o; o.x = pk2(g0.x * cv[1][rr][0], g0.y * cv[1][rr][1]); o.y = pk2(g1.x * cv[1][rr][2], g1.y * cv[1][rr][3]);
        *(u32x2*)(ACT + (size_t)(pm * 256 + rr) * FF + c) = o; }
}
__device__ __forceinline__ void conv_fixup_phase(const Frame& F0, const float* HALO, const float* cw, const float* cb, bf16_t* ACT) {
    const Frame F = relaunder(F0);
    constexpr int NCQ = FF / 4;
    for (int it = F.bid * 512 + F.tid; it < 64 * NCQ; it += F.G * 512) { const int pm = it / NCQ, cq = it - pm * NCQ; if ((pm & 15) == 0) continue; conv_fixup_item(pm, cq, HALO, cw, cb, ACT); }
}
__device__ __forceinline__ void conv_fixup_own(const Frame& F0, const float* HALO, const float* cw, const float* cb, bf16_t* ACT) {
    const Frame F = relaunder(F0);
    constexpr int NCQ = FF / 4;
    const int x = F.bid & 7, j = F.bid >> 3;
#pragma unroll 1
    for (int i = 0; i < 2; ++i) { const int pm = 32 * i + 4 * x + (j & 3); if ((pm & 15) == 0) continue;
        for (int cq = F.tid; cq < NCQ; cq += 512) conv_fixup_item(pm, cq, HALO, cw, cb, ACT); }
    asm volatile("s_waitcnt vmcnt(0)" ::: "memory"); __syncthreads();
}

__device__ __forceinline__ void attn_phase(const Frame& F0, const bf16_t* QKV, const float* sinks, bf16_t* MIX) {
    const Frame F = relaunder(F0);
    constexpr int RS = 144;
    LAS unsigned char* Kt = F.lds; LAS unsigned char* Vt = F.lds + 256 * RS;
    const int lane = F.lane, r = lane & 15, g4 = lane >> 4, qq = r >> 2, pp = r & 3;
    for (int u = F.bid; u < 512; u += F.G) {
        const int kvh = u & 3, n = (u >> 2) & 31, b = u >> 7, tok0 = b * SEQ + n * 128;
        for (int c = F.tid; c < 256 * 8; c += 512) { const int row = c >> 3, ch = c & 7; const bool valid = (n > 0) || (row >= 128);
            u32x4 kv = (u32x4){0u, 0u, 0u, 0u}, vv = kv;
            if (valid) { const bf16_t* src = QKV + (size_t)(tok0 - 128 + row) * OIN + 2048 + kvh * 64 + ch * 8; kv = *(const u32x4*)src; vv = *(const u32x4*)(src + 256); }
            *(LAS u32x4*)(Kt + row * RS + ch * 16) = kv; *(LAS u32x4*)(Vt + row * RS + ch * 16) = vv; }
        __syncthreads();
        const int head = kvh * 8 + F.wave;
        const float slope2 = __builtin_amdgcn_exp2f(-0.25f * (float)(head + 1)) * LOG2E, sink2 = sinks[head] * LOG2E;
        for (int rb = 0; rb < 8; ++rb) {
            const bf16_t* qp = QKV + (size_t)(tok0 + 16 * rb + r) * OIN + head * 64 + 8 * g4;
            const bf16x8 q0 = *(const bf16x8*)qp, q1 = *(const bf16x8*)(qp + 32);
            f32x4 s[9];
#pragma unroll
            for (int tt = 0; tt < 9; ++tt) { const LAS unsigned char* kp = Kt + (16 * (rb + tt) + r) * RS + 16 * g4;
                f32x4 acc = (f32x4){0.f, 0.f, 0.f, 0.f};
                acc = mfma16(*(const LAS bf16x8*)kp, q0, acc); acc = mfma16(*(const LAS bf16x8*)(kp + 64), q1, acc); s[tt] = acc; }
            const int i = 16 * rb + r; float mx = -INFINITY;
#pragma unroll
            for (int tt = 0; tt < 9; ++tt)
#pragma unroll
                for (int jj = 0; jj < 4; ++jj) { const int j = 16 * (rb + tt) + 4 * g4 + jj, delta = 128 + i - j; const bool valid = (delta >= 0) && (delta < 128) && ((n > 0) || (j >= 128));
                    const float v = s[tt][jj] * (0.125f * LOG2E) - slope2 * (float)delta; s[tt][jj] = valid ? v : -INFINITY; mx = fmaxf(mx, s[tt][jj]); }
            mx = fmaxf(mx, __shfl_xor(mx, 16)); mx = fmaxf(mx, __shfl_xor(mx, 32)); mx = fmaxf(mx, sink2);
            float sum = 0.f;
#pragma unroll
            for (int tt = 0; tt < 9; ++tt)
#pragma unroll
                for (int jj = 0; jj < 4; ++jj) { const float p = __builtin_amdgcn_exp2f(s[tt][jj] - mx); s[tt][jj] = p; sum += p; }
            sum += __shfl_xor(sum, 16); sum += __shfl_xor(sum, 32);
            const float inv = 1.0f / (sum + __builtin_amdgcn_exp2f(sink2 - mx));
            u32x2 P[10];
#pragma unroll
            for (int tt = 0; tt < 9; ++tt) { P[tt].x = pk2(s[tt][0] * inv, s[tt][1] * inv); P[tt].y = pk2(s[tt][2] * inv, s[tt][3] * inv); }
            P[9] = (u32x2){0u, 0u};
            f32x4 o[4];
#pragma unroll
            for (int te = 0; te < 4; ++te) o[te] = (f32x4){0.f, 0.f, 0.f, 0.f};
#pragma unroll
            for (int pr = 0; pr < 5; ++pr) { const int t0 = 2 * pr, t1 = (pr < 4) ? 2 * pr + 1 : 2 * pr;
                const u32x4 bw = (u32x4){P[t0].x, P[t0].y, P[2 * pr + 1].x, P[2 * pr + 1].y}; const bf16x8 bfrag = __builtin_bit_cast(bf16x8, bw);
                const LAS unsigned char* v0 = Vt + (16 * (rb + t0) + 4 * g4 + qq) * RS + 8 * pp; const LAS unsigned char* v1 = Vt + (16 * (rb + t1) + 4 * g4 + qq) * RS + 8 * pp;
#pragma unroll
                for (int te = 0; te < 4; ++te) o[te] = mfma16(cat8(vtr(v0 + 32 * te), vtr(v1 + 32 * te)), bfrag, o[te]); }
            bf16_t* op = MIX + (size_t)(tok0 + i) * D + head * 64 + 4 * g4;
#pragma unroll
            for (int te = 0; te < 4; ++te) { u32x2 w; w.x = pk2(o[te][0], o[te][1]); w.y = pk2(o[te][2], o[te][3]); *(u32x2*)(op + 16 * te) = w; }
        }
        __syncthreads();
    }
}

__device__ __forceinline__ float ret_lg2(int h) { return __builtin_amdgcn_logf(1.0f - __builtin_amdgcn_exp2f(-5.0f - (float)h)); }
constexpr int RRS = 528;

__device__ __forceinline__ void ret_kv_phase(const Frame& F0, const bf16_t* H5, bf16_t* KVT) {
    const Frame F = relaunder(F0);
    LAS unsigned char* Kt = F.lds; LAS unsigned char* Vt = F.lds + 128 * RRS;
    const int lane = F.lane, r = lane & 15, g4 = lane >> 4, qq = r >> 2, pp = r & 3, w = F.wave;
    for (int u = F.bid; u < 512; u += F.G) {
        const int h = u & 3, n = (u >> 2) & 31, b = u >> 7, tok0 = b * SEQ + n * 128; const float lg2 = ret_lg2(h);
        for (int c = F.tid; c < 128 * 32; c += 512) { const int row = c >> 5, ch = c & 31; const bf16_t* src = H5 + (size_t)(tok0 + row) * EIN + 1024 + h * 256 + ch * 8;
            const u32x4 kv = *(const u32x4*)src, vv = *(const u32x4*)(src + 1024); const float z = __builtin_amdgcn_exp2f(lg2 * (float)(127 - row)) * 0.0625f;
            u32x4 ks;
#pragma unroll
            for (int e = 0; e < 4; ++e) ks[e] = pk2(bflo(kv[e]) * z, bfhi(kv[e]) * z);
            *(LAS u32x4*)(Kt + row * RRS + ch * 16) = ks; *(LAS u32x4*)(Vt + row * RRS + ch * 16) = vv; }
        __syncthreads();
        for (int dh = 0; dh < 2; ++dh) {
            f32x4 acc[2][8];
#pragma unroll
            for (int a = 0; a < 2; ++a)
#pragma unroll
                for (int d = 0; d < 8; ++d) acc[a][d] = (f32x4){0.f, 0.f, 0.f, 0.f};
#pragma unroll
            for (int ks = 0; ks < 4; ++ks) { const int R0 = 32 * ks + 8 * g4 + qq;
                const LAS unsigned char* vb = Vt + R0 * RRS + 8 * pp; const LAS unsigned char* kb = Kt + R0 * RRS + 8 * pp + 256 * dh;
                const bf16x8 vf0 = cat8(vtr(vb + 64 * w), vtr(vb + 4 * RRS + 64 * w)), vf1 = cat8(vtr(vb + 64 * w + 32), vtr(vb + 4 * RRS + 64 * w + 32));
#pragma unroll
                for (int dt = 0; dt < 8; ++dt) { const bf16x8 kf = cat8(vtr(kb + 32 * dt), vtr(kb + 4 * RRS + 32 * dt)); acc[0][dt] = mfma16(kf, vf0, acc[0][dt]); acc[1][dt] = mfma16(kf, vf1, acc[1][dt]); } }
            bf16_t* op = KVT + (size_t)u * 65536 + (size_t)(32 * w + r) * 256 + 128 * dh + 4 * g4;
#pragma unroll
            for (int a = 0; a < 2; ++a)
#pragma unroll
                for (int dt = 0; dt < 8; ++dt) { u32x2 o; o.x = pk2(acc[a][dt][0], acc[a][dt][1]); o.y = pk2(acc[a][dt][2], acc[a][dt][3]); *(u32x2*)(op + a * 16 * 256 + 16 * dt) = o; }
        }
        __syncthreads();
    }
}
__device__ __forceinline__ void pooled_phase(const Frame& F0, const bf16_t* H5, bf16_t* PO) {
    const Frame F = relaunder(F0);
    for (int it = F.bid * 512 + F.tid; it < 1024 * 128; it += F.G * 512) {
        const int cgp = it & 127, run = it >> 7, c = cgp * 8, w = 2 << (c >> 8), t0 = run * 16, p0 = t0 & (SEQ - 1);
        const bf16_t* U = H5 + 4096 + c;
        float S[8];
#pragma unroll
        for (int e = 0; e < 8; ++e) S[e] = 0.f;
        for (int s = 1; s < w; ++s) if (p0 - s >= 0) { const u32x4 x = *(const u32x4*)(U + (size_t)(t0 - s) * EIN);
#pragma unroll
            for (int e = 0; e < 4; ++e) { S[2 * e] += bflo(x[e]); S[2 * e + 1] += bfhi(x[e]); } }
        for (int k = 0; k < 16; ++k) { const int t = t0 + k, p = p0 + k; const u32x4 x = *(const u32x4*)(U + (size_t)t * EIN);
            const float rc = 1.0f / (float)((p + 1 < w) ? p + 1 : w); u32x4 o;
#pragma unroll
            for (int e = 0; e < 4; ++e) { const float a0 = bflo(x[e]), a1 = bfhi(x[e]); S[2 * e] += a0; S[2 * e + 1] += a1; o[e] = pk2(S[2 * e] * rc - a0, S[2 * e + 1] * rc - a1); }
            *(u32x4*)(PO + (size_t)t * 1024 + c) = o;
            if (p - (w - 1) >= 0) { const u32x4 y = *(const u32x4*)(U + (size_t)(t - (w - 1)) * EIN);
#pragma unroll
                for (int e = 0; e < 4; ++e) { S[2 * e] -= bflo(y[e]); S[2 * e + 1] -= bfhi(y[e]); } }
        }
    }
}
__device__ __forceinline__ void ret_scan_phase(const Frame& F0, const bf16_t* KVT, bf16_t* PREVT) {
    const Frame F = relaunder(F0);
    for (int it = F.bid * 512 + F.tid; it < 16 * 16384; it += F.G * 512) {
        const int bh = it >> 14, e4 = it & 16383, b = bh >> 2, h = bh & 3; const float cd = __builtin_amdgcn_exp2f(ret_lg2(h) * 128.0f);
        f32x4 st = (f32x4){0.f, 0.f, 0.f, 0.f};
#pragma unroll 8
        for (int n = 0; n < 31; ++n) { const size_t u = (size_t)((b * 32 + n) * 4 + h);
            { const u32x2 kw = *(const u32x2*)(KVT + u * 65536 + (size_t)e4 * 4); st = st * cd + (f32x4){bflo(kw.x), bfhi(kw.x), bflo(kw.y), bfhi(kw.y)}; }
            u32x2 o; o.x = pk2(st[0], st[1]); o.y = pk2(st[2], st[3]); *(u32x2*)(PREVT + (u + 4) * 65536 + (size_t)e4 * 4) = o; }
    }
}
__device__ __forceinline__ void ret_out_phase(const Frame& F0, const bf16_t* H5, const bf16_t* PREVT, bf16_t* MIX) {
    const Frame F = relaunder(F0);
    LAS unsigned char* Kt = F.lds; LAS unsigned char* Vt = F.lds + 128 * RRS;
    const int lane = F.lane, r = lane & 15, g4 = lane >> 4, qq = r >> 2, pp = r & 3, w = F.wave;
    for (int u = F.bid; u < 512; u += F.G) {
        const int h = u & 3, n = (u >> 2) & 31, b = u >> 7, tok0 = b * SEQ + n * 128; const float lg2 = ret_lg2(h);
        for (int c = F.tid; c < 128 * 32; c += 512) { const int row = c >> 5, ch = c & 31; const bf16_t* src = H5 + (size_t)(tok0 + row) * EIN + 1024 + h * 256 + ch * 8;
            *(LAS u32x4*)(Kt + row * RRS + ch * 16) = *(const u32x4*)src; *(LAS u32x4*)(Vt + row * RRS + ch * 16) = *(const u32x4*)(src + 1024); }
        const int i = 16 * w + r;
        bf16x8 Qf[8];
        { const bf16_t* qp = H5 + (size_t)(tok0 + i) * EIN + h * 256 + 8 * g4;
#pragma unroll
          for (int kk = 0; kk < 8; ++kk) Qf[kk] = *(const bf16x8*)(qp + 32 * kk); }
        __syncthreads();
        u32x2 P[8];
#pragma unroll
        for (int tj = 0; tj < 8; ++tj) {
            P[tj] = (u32x2){0u, 0u};
            if (tj <= w) { f32x4 acc = (f32x4){0.f, 0.f, 0.f, 0.f}; const LAS unsigned char* kp = Kt + (16 * tj + r) * RRS + 16 * g4;
#pragma unroll
                for (int kk = 0; kk < 8; ++kk) acc = mfma16(*(const LAS bf16x8*)(kp + 64 * kk), Qf[kk], acc);
                float pv[4];
#pragma unroll
                for (int jj = 0; jj < 4; ++jj) { const int j = 16 * tj + 4 * g4 + jj; pv[jj] = (i >= j) ? acc[jj] * 0.0625f * __builtin_amdgcn_exp2f(lg2 * (float)(i - j)) : 0.f; }
                P[tj].x = pk2(pv[0], pv[1]); P[tj].y = pk2(pv[2], pv[3]); }
        }
        __syncthreads();
        f32x4 acc[16];
#pragma unroll
        for (int te = 0; te < 16; ++te) acc[te] = (f32x4){0.f, 0.f, 0.f, 0.f};
        if (n > 0) {
#pragma unroll
            for (int half = 0; half < 2; ++half) {
                for (int c = F.tid; c < 128 * 32; c += 512) { const int row = c >> 5, ch = c & 31;
                    *(LAS u32x4*)(Kt + row * RRS + ch * 16) = *(const u32x4*)(PREVT + (size_t)u * 65536 + (size_t)(128 * half + row) * 256 + ch * 8); }
                __syncthreads();
#pragma unroll
                for (int te = 0; te < 8; ++te) { const LAS unsigned char* pq = Kt + (16 * te + r) * RRS + 16 * g4;
#pragma unroll
                    for (int kk = 0; kk < 8; ++kk) acc[8 * half + te] = mfma16(*(const LAS bf16x8*)(pq + 64 * kk), Qf[kk], acc[8 * half + te]);
                    asm volatile("" : "+v"(acc[8 * half + te])); }
                __syncthreads();
            }
            const float xi = __builtin_amdgcn_exp2f(lg2 * (float)(i + 1));
#pragma unroll
            for (int te = 0; te < 16; ++te) acc[te] = acc[te] * xi;
        }
#pragma unroll
        for (int pr = 0; pr < 4; ++pr) {
            if (2 * pr <= w) { const u32x4 bw = (u32x4){P[2 * pr].x, P[2 * pr].y, P[2 * pr + 1].x, P[2 * pr + 1].y}; const bf16x8 bfrag = __builtin_bit_cast(bf16x8, bw);
                const LAS unsigned char* v0 = Vt + (32 * pr + 4 * g4 + qq) * RRS + 8 * pp;
#pragma unroll
                for (int te = 0; te < 16; ++te) { acc[te] = mfma16(cat8(vtr(v0 + 32 * te), vtr(v0 + 16 * RRS + 32 * te)), bfrag, acc[te]); if ((te & 3) == 3) asm volatile("" : "+v"(acc[te])); } }
        }
        float s = 0.f;
#pragma unroll
        for (int te = 0; te < 16; ++te) s += (acc[te][0] + acc[te][1]) + (acc[te][2] + acc[te][3]);
        s += __shfl_xor(s, 16); s += __shfl_xor(s, 32);
        const float mean = s * (1.f / 256.f); float s2 = 0.f;
#pragma unroll
        for (int te = 0; te < 16; ++te) { acc[te] = acc[te] - mean; s2 += (acc[te][0] * acc[te][0] + acc[te][1] * acc[te][1]) + (acc[te][2] * acc[te][2] + acc[te][3] * acc[te][3]); }
        s2 += __shfl_xor(s2, 16); s2 += __shfl_xor(s2, 32);
        const float rstd = 1.0f / sqrtf(s2 * (1.f / 256.f) + LN_EPS);
        const bf16_t* gp = H5 + (size_t)(tok0 + i) * EIN + 3072 + h * 256 + 4 * g4; bf16_t* op = MIX + (size_t)(tok0 + i) * D + h * 256 + 4 * g4;
#pragma unroll
        for (int te = 0; te < 16; ++te) { const u32x2 gw = *(const u32x2*)(gp + 16 * te); float gv[4] = {bflo(gw.x), bfhi(gw.x), bflo(gw.y), bfhi(gw.y)}; float ov[4];
#pragma unroll
            for (int jj = 0; jj < 4; ++jj) { const float sg = gv[jj] / (1.0f + __builtin_amdgcn_exp2f(-gv[jj] * LOG2E)); ov[jj] = sg * acc[te][jj] * rstd; }
            u32x2 o; o.x = pk2(ov[0], ov[1]); o.y = pk2(ov[2], ov[3]); *(u32x2*)(op + 16 * te) = o; }
        __syncthreads();
    }
}

__device__ __forceinline__ void gemm_res_ln(const Frame& F, const XcdBarrier& bar, const bf16_t* A, const bf16_t* Bt, int K, const float* xres, float* Y, float* XF, bf16_t* XB,
                                            const float* g, const float* b, unsigned char* ws, int inst, bool last) {
    pg8::Gemm gm{A, Bt, K, K, K, 0};
    if (F.G == 256) {
        pg8::PanelOrder S{F.bid};
        pg8::EpiResLn E{xres, last ? XF : nullptr, XB, g, b, (unsigned long long*)(ws + WS_XCH) + (size_t)inst * 131072, (unsigned*)(ws + WS_CTL) + CW_LN + inst * 4096, F.lds + 131072};
        pg8::gemm_phase<pg8::EpiResLn, pg8::PanelOrder, true>(F.lds, gm, S, E);
        xcd_barrier(bar);
    } else {
        pg8::StaticOrder S; S.init(M, D, F.G, F.bid);
        pg8::EpiRes E{xres ? xres : XF, Y};
        pg8::gemm_phase<pg8::EpiRes, pg8::StaticOrder, true>(F.lds, gm, S, E);
        xcd_barrier(bar);
        ln_phase(F, Y, g, b, XF, XB);
        xcd_barrier(bar);
    }
}

__global__ void __launch_bounds__(512, 2) fwd_megakernel(Args args) {
    extern __shared__ __attribute__((aligned(16))) unsigned char lds_raw[];
    cg::grid_group grid = cg::this_grid();
    Frame F; F.lds = (LAS unsigned char*)lds_raw; F.tid = threadIdx.x; F.lane = F.tid & 63; F.wave = __builtin_amdgcn_readfirstlane(F.tid >> 6); F.G = gridDim.x; F.bid = blockIdx.x;
    unsigned char* ws = args.ws;
    bf16_t* XB = (bf16_t*)(ws + WS_XB); float* Y = (float*)(ws + WS_Y); bf16_t* MIX = (bf16_t*)(ws + WS_MIX);
    float* HALO = (float*)(ws + WS_HF); bf16_t* ACT = (bf16_t*)(ws + WS_ACT); bf16_t* H5 = (bf16_t*)(ws + WS_H5); bf16_t* QKV = (bf16_t*)(ws + WS_QKV);
    bf16_t* KVT = (bf16_t*)(ws + WS_KVT); bf16_t* PREVT = (bf16_t*)(ws + WS_PREVT); bf16_t* POOLED = (bf16_t*)(ws + WS_POOLED);
    float* XF = args.out;

    for (int u = F.tid; u < (LDS_BYTES - MISC_OFF) / 4; u += 512) ((LAS unsigned*)(F.lds + MISC_OFF))[u] = 0u;
    __syncthreads();
    const XcdBarrier bar = xcd_barrier_post((unsigned*)(ws + WS_CTL), (volatile LAS unsigned*)(F.lds + MISC_OFF));
#define GRID_BAR() xcd_barrier(bar)

    for (int rep = 0; rep < EXP_REP_P0; ++rep) p0_prologue(F, args);
    grid.sync();

    for (int layer = 0; layer < 4; ++layer) {
        const int li = layer >> 1;
        const float* xres = (layer == 0) ? args.in[0] : nullptr;
        if ((layer & 1) == 0) {
            for (int rep = 0; rep < EXP_REP_INP; ++rep)
            {
                pg8::Gemm g{XB, (const bf16_t*)(ws + WS_EIN) + (size_t)li * EIN * D, D, D, D, 0}; pg8::StaticOrder S; S.init(M, EIN, F.G, F.bid);
                pg8::EpiBf16 E{H5, EIN, nullptr, nullptr, 0};
                pg8::gemm_phase<pg8::EpiBf16, pg8::StaticOrder, true>(F.lds, g, S, E);
            }
            GRID_BAR();
            for (int rep = 0; rep < EXP_REP_RET; ++rep) {
            ret_kv_phase(F, H5, KVT);
            pooled_phase(F, H5, POOLED);
            GRID_BAR();
            ret_scan_phase(F, KVT, PREVT);
            {
                pg8::Gemm g{POOLED, (const bf16_t*)(ws + WS_POOLW) + (size_t)li * 1024 * 256, 1024, 256, 256, 256}; pg8::StaticOrder S; S.init(M, 1024, F.G, F.bid);
                pg8::EpiBf16 E{MIX, D, nullptr, args.in[5] + (size_t)li * 1024, 1024};
                pg8::gemm_phase<pg8::EpiBf16, pg8::StaticOrder, true>(F.lds, g, S, E);
            }
            GRID_BAR();
            ret_out_phase(F, H5, PREVT, MIX);
            GRID_BAR();
            }
        } else {
            {
                pg8::Gemm g{XB, (const bf16_t*)(ws + WS_QKVW) + (size_t)li * OIN * D, D, D, D, 0}; pg8::StaticOrder S; S.init(M, OIN, F.G, F.bid);
                pg8::EpiBf16 E{QKV, OIN, args.in[8] + (size_t)li * OIN, nullptr, 0};
                pg8::gemm_phase<pg8::EpiBf16, pg8::StaticOrder, true>(F.lds, g, S, E);
            }
            GRID_BAR();
            for (int rep = 0; rep < EXP_REP_ATT; ++rep) {
            attn_phase(F, QKV, args.in[9] + li * 32, MIX);
            GRID_BAR();
            }
        }
        gemm_res_ln(F, bar, MIX, ((layer & 1) == 0) ? (const bf16_t*)(ws + WS_EOUT) + (size_t)li * D * D : (const bf16_t*)(ws + WS_AOUT) + (size_t)li * D * D, D, xres, Y, XF, XB,
                    args.in[1] + (size_t)(layer * 2 + 0) * D, args.in[2] + (size_t)(layer * 2 + 0) * D, ws, layer * 2 + 0, false);
        for (int rep = 0; rep < EXP_REP_F1; ++rep)
        {
            pg8::Gemm g{XB, (const bf16_t*)(ws + WS_F1) + (size_t)layer * FF2 * D, D, D, D, 0}; pg8::StaticOrder S; S.init(M, FF2, F.G, F.bid);
            pg8::EpiConvGlu E{ACT, HALO, args.in[12] + (size_t)layer * 3 * FF2, args.in[13] + (size_t)layer * FF2, (LAS float*)(F.lds + 131072)};
            pg8::gemm_phase<pg8::EpiConvGlu, pg8::StaticOrder, true>(F.lds, g, S, E);
        }
        GRID_BAR();
        if (F.G == 256) conv_fixup_own(F, HALO, args.in[12] + (size_t)layer * 3 * FF2, args.in[13] + (size_t)layer * FF2, ACT);
        else { conv_fixup_phase(F, HALO, args.in[12] + (size_t)layer * 3 * FF2, args.in[13] + (size_t)layer * FF2, ACT); GRID_BAR(); }
        gemm_res_ln(F, bar, ACT, (const bf16_t*)(ws + WS_F2) + (size_t)layer * D * FF, FF, nullptr, Y, XF, XB,
                    args.in[1] + (size_t)(layer * 2 + 1) * D, args.in[2] + (size_t)(layer * 2 + 1) * D, ws, layer * 2 + 1, layer == 3);
    }
}

extern "C" void kernel_launch(void* const* d_in, const int* in_sizes, int n_in, void* d_out, int out_size, void* d_ws, size_t ws_size, hipStream_t stream) {
    static int grid = 0;
    if (grid == 0) {
        if (n_in != 15 || out_size != M * D || ws_size < WS_END) { fprintf(stderr, "kernel_launch: unexpected problem: n_in %d out %d ws %zu (need %zu)\n", n_in, out_size, ws_size, (size_t)WS_END); grid = -1; return; }
        int dev = 0, cus = 0, per_cu = 0;
        hipGetDevice(&dev); hipDeviceGetAttribute(&cus, hipDeviceAttributeMultiprocessorCount, dev);
        if (hipFuncSetAttribute((const void*)fwd_megakernel, hipFuncAttributeMaxDynamicSharedMemorySize, LDS_BYTES) != hipSuccess) { fprintf(stderr, "kernel_launch: hipFuncSetAttribute failed\n"); grid = -1; return; }
        if (hipOccupancyMaxActiveBlocksPerMultiprocessor(&per_cu, (const void*)fwd_megakernel, 512, LDS_BYTES) != hipSuccess || per_cu < 1) { fprintf(stderr, "kernel_launch: occupancy query says %d\n", per_cu); per_cu = 1; }
        (void)hipGetLastError();
        grid = cus;
    }
    if (grid < 0) return;
    Args a{};
    for (int i = 0; i < 15; ++i) a.in[i] = (const float*)d_in[i];
    a.out = (float*)d_out; a.ws = (unsigned char*)d_ws;
    if (hipMemsetAsync((char*)d_ws + WS_CTL, 0, CTL_BYTES, stream) != hipSuccess) { fprintf(stderr, "kernel_launch: memset failed\n"); return; }
    void* kargs[] = {&a};
    hipError_t e = hipLaunchCooperativeKernel((const void*)fwd_megakernel, dim3(grid), dim3(512), kargs, LDS_BYTES, stream);
    if (e != hipSuccess) fprintf(stderr, "kernel_launch: cooperative launch failed: %s (grid %d)\n", hipGetErrorString(e), grid);
}
```

```cpp
#include <hip/hip_runtime.h>
#include <hip/hip_cooperative_groups.h>
#include <cstdio>
#include <cstdint>
namespace cg = cooperative_groups;
#ifndef EXP_REP_P0
#define EXP_REP_P0 1
#endif
#ifndef EXP_REP_RET
#define EXP_REP_RET 1
#endif
#ifndef EXP_REP_F1
#define EXP_REP_F1 1
#endif
#ifndef EXP_REP_INP
#define EXP_REP_INP 1
#endif
#ifndef EXP_REP_ATT
#define EXP_REP_ATT 1
#endif

#define LAS __attribute__((address_space(3)))
typedef unsigned short bf16_t;
typedef short bf16x8 __attribute__((ext_vector_type(8)));
typedef short s16x4 __attribute__((ext_vector_type(4)));
typedef float f32x4 __attribute__((ext_vector_type(4)));
typedef float f32x2 __attribute__((ext_vector_type(2)));
typedef unsigned u32x4 __attribute__((ext_vector_type(4)));
typedef unsigned u32x2 __attribute__((ext_vector_type(2)));
typedef __bf16 bf16x2_t __attribute__((ext_vector_type(2)));

constexpr int NBATCH = 4, SEQ = 4096, M = NBATCH * SEQ, D = 2048;
constexpr int EIN = 5120, OIN = 2560, FF = 5632, FF2 = 11264;
constexpr float ALPHA = 1.6817928305074290f;
constexpr float LN_EPS = 1e-5f;
constexpr float LOG2E = 1.4426950408889634f;

constexpr size_t MiB = 1u << 20;
constexpr size_t WS_EIN = 0 * MiB;
constexpr size_t WS_EOUT = 40 * MiB;
constexpr size_t WS_POOLW = 56 * MiB;
constexpr size_t WS_QKVW = 57 * MiB;
constexpr size_t WS_AOUT = 77 * MiB;
constexpr size_t WS_F1 = 93 * MiB;
constexpr size_t WS_F2 = 269 * MiB;
constexpr size_t WS_XB = 357 * MiB;
constexpr size_t WS_Y = 421 * MiB;
constexpr size_t WS_MIX = 549 * MiB;
constexpr size_t WS_BIG = 613 * MiB;
constexpr size_t WS_HF = WS_BIG;
constexpr size_t WS_ACT = WS_BIG + 352 * MiB;
constexpr size_t WS_H5 = WS_BIG;
constexpr size_t WS_QKV = WS_BIG;
constexpr size_t WS_KVT = WS_BIG + 160 * MiB;
constexpr size_t WS_PREVT = WS_BIG + 288 * MiB;
constexpr size_t WS_POOLED = WS_BIG + 352 * MiB;
constexpr size_t WS_CTL = 1141 * MiB;
constexpr size_t CTL_BYTES = 256 * 1024;
constexpr int CW_LN = 4096;
constexpr size_t WS_XCH = 1142 * MiB;
constexpr size_t WS_END = 1150 * MiB;
constexpr int MISC_OFF = 143360;

constexpr int LDS_BYTES = 147456;

__device__ __forceinline__ unsigned pk2(float lo, float hi) { f32x2 v = {lo, hi}; bf16x2_t b = __builtin_convertvector(v, bf16x2_t); return __builtin_bit_cast(unsigned, b); }
__device__ __forceinline__ float bflo(unsigned w) { return __uint_as_float(w << 16); }
__device__ __forceinline__ float bfhi(unsigned w) { return __uint_as_float(w & 0xffff0000u); }
__device__ __forceinline__ float wave_sum(float v) {
#pragma unroll
    for (int o = 1; o < 64; o <<= 1) v += __shfl_xor(v, o);
    return v;
}
typedef short v4i16_t __attribute__((ext_vector_type(4)));
__device__ __forceinline__ s16x4 vtr(const LAS unsigned char* p) { return __builtin_bit_cast(s16x4, __builtin_amdgcn_ds_read_tr16_b64_v4i16((LAS v4i16_t*)p)); }
__device__ __forceinline__ bf16x8 cat8(s16x4 lo, s16x4 hi) { return (bf16x8){lo[0], lo[1], lo[2], lo[3], hi[0], hi[1], hi[2], hi[3]}; }
__device__ __forceinline__ f32x4 mfma16(bf16x8 a, bf16x8 b, f32x4 c) { return __builtin_amdgcn_mfma_f32_16x16x32_bf16(a, b, c, 0, 0, 0); }
__device__ __forceinline__ f32x2 gelu_pk(f32x2 v) {
    const f32x2 av = __builtin_elementwise_abs(v), d = av * 0.2316418882f + 1.0f;
    f32x2 t; t.x = __builtin_amdgcn_rcpf(d.x); t.y = __builtin_amdgcn_rcpf(d.y);
    f32x2 q = t * 0.5307027145f + (-0.7265760135f); q = q * t + 0.7107068705f; q = q * t + (-0.142248368f); q = q * t + 0.127414796f; q = q * t;
    const f32x2 s = (v * v) * (-0.72134752044f);
    f32x2 e; e.x = __builtin_amdgcn_exp2f(s.x); e.y = __builtin_amdgcn_exp2f(s.y);
    const f32x2 m = v * (q * e), r = v - m;
    f32x2 o; o.x = v.x < 0.f ? m.x : r.x; o.y = v.y < 0.f ? m.y : r.y; return o;
}

namespace pg8 {
constexpr int BM = 256, BK = 64, HALF = 128, HTB = HALF * BK * 2, STAGE_BYTES = 8 * HTB, NXCD = 8, WGM = 8;
__host__ __device__ __forceinline__ int lds_byte(int r, int c) { const int st = (r >> 4) * 2 + (c >> 5), rr = r & 15, cc = c & 31, ob = rr * 64 + cc * 2; return st * 1024 + (ob ^ (((ob >> 9) & 1) << 5)); }
__host__ __device__ __forceinline__ void stage_rc(int b, int& R, int& C) { const int st = b / 1024, sb = b % 1024, swz = sb ^ (((sb >> 9) & 1) << 5); R = (st >> 1) * 16 + swz / 64; C = (st & 1) * 32 + (swz % 64) / 2; }
__host__ __device__ __forceinline__ int perm32(int rho) { const int n = rho >> 4, i = rho & 15; return 8 * (i >> 2) + 4 * n + (i & 3); }

struct Unit { int pm, pn; };
struct Gemm { const bf16_t* A; const bf16_t* Bt; int lda, ldb, K, a_pn_off; };

struct StaticOrder {
    int nM, nN, nwg, G, c;
    __device__ void init(int M_, int N_, int G_, int c_) { nM = M_ / BM; nN = N_ / BM; nwg = nM * nN; G = G_; c = c_; }
    __device__ bool next(int i, Unit& u) const {
        const long L = (long)i * G + c; if (L >= nwg) return false;
        int wgid = (int)L; { const int q = nwg / NXCD, r = nwg % NXCD, xcd = wgid % NXCD, off = wgid / NXCD; wgid = (xcd < r ? xcd * (q + 1) : r * (q + 1) + (xcd - r) * q) + off; }
        const int nig = WGM * nN, gid = wgid / nig, fm = gid * WGM, gsz = (nM - fm) < WGM ? (nM - fm) : WGM;
        u.pm = fm + ((wgid % nig) % gsz); u.pn = (wgid % nig) / gsz; return true;
    }
};

struct EpiBf16 {
    static constexpr bool PERM = true;
    bf16_t* O; int ldc; const float* bias; const float* scale; int ocol_off;
    __device__ __forceinline__ void operator()(f32x4 (&acc)[2][2][4][2], const Unit& u, int wr, int wc, int fr, int fq, int wid, int lane) const {
        const int row0 = u.pm * BM + wr * 64 + fr; const int bcol0 = u.pn * BM + wc * 32 + 8 * fq; const int col0 = ocol_off + bcol0;
        f32x4 bv[2][2], sv[2][2];
#pragma unroll
        for (int bj = 0; bj < 2; ++bj)
#pragma unroll
            for (int n = 0; n < 2; ++n) { bv[bj][n] = bias ? *(const f32x4*)(bias + bcol0 + bj * HALF + 4 * n) : (f32x4){0.f, 0.f, 0.f, 0.f};
                                          sv[bj][n] = scale ? *(const f32x4*)(scale + bcol0 + bj * HALF + 4 * n) : (f32x4){1.f, 1.f, 1.f, 1.f}; }
#pragma unroll
        for (int ai = 0; ai < 2; ++ai)
#pragma unroll
            for (int m = 0; m < 4; ++m) { bf16_t* rowp = O + (size_t)(row0 + ai * HALF + m * 16) * ldc + col0;
#pragma unroll
                for (int bj = 0; bj < 2; ++bj) { f32x4 v0 = (acc[ai][bj][m][0] + bv[bj][0]) * sv[bj][0], v1 = (acc[ai][bj][m][1] + bv[bj][1]) * sv[bj][1];
                    u32x4 w; w.x = pk2(v0[0], v0[1]); w.y = pk2(v0[2], v0[3]); w.z = pk2(v1[0], v1[1]); w.w = pk2(v1[2], v1[3]);
                    *(u32x4*)(rowp + bj * HALF) = w; } }
    }
};
struct EpiRes {
    static constexpr bool PERM = false;
    const float* X; float* Y;
    __device__ __forceinline__ void operator()(f32x4 (&acc)[2][2][4][2], const Unit& u, int wr, int wc, int fr, int fq, int wid, int lane) const {
        const int row0 = u.pm * BM + wr * 64 + fr, col0 = u.pn * BM + wc * 32 + 4 * fq;
#pragma unroll
        for (int ai = 0; ai < 2; ++ai)
#pragma unroll
            for (int m = 0; m < 4; ++m) { const size_t off = (size_t)(row0 + ai * HALF + m * 16) * D + col0;
#pragma unroll
                for (int bj = 0; bj < 2; ++bj)
#pragma unroll
                    for (int n = 0; n < 2; ++n) { const f32x4 xv = *(const f32x4*)(X + off + bj * HALF + n * 16); *(f32x4*)(Y + off + bj * HALF + n * 16) = xv * ALPHA + acc[ai][bj][m][n]; }
                asm volatile("" ::: "memory"); }
    }
};

__device__ __forceinline__ float dpp_ror1(float v) { return __int_as_float(__builtin_amdgcn_update_dpp(0, __float_as_int(v), 0x121, 0xf, 0xf, true)); }
__device__ __forceinline__ float dpp_ror2(float v) { return __int_as_float(__builtin_amdgcn_update_dpp(0, __float_as_int(v), 0x122, 0xf, 0xf, true)); }
struct EpiConvGlu {
    static constexpr bool PERM = true;
    bf16_t* ACT; float* HALO; const float* cw; const float* cb; LAS float* xbuf;
    __device__ __forceinline__ void operator()(f32x4 (&acc)[2][2][4][2], const Unit& u, int wr, int wc, int fr_, int fq_, int wid, int lane_) const {
        int lane = lane_; asm volatile("" : "+v"(lane));
        const int fr = lane & 15, fq = lane >> 4;
        const int cl = 32 * wc + 8 * fq;
        LAS float* wl = xbuf + 2048;
        {
            const int t = wid * 64 + lane, kind = t >> 6, pr = t & 63, bj = kind >> 2, tap = kind & 3;
            const float* src = (tap < 3) ? (cw + (size_t)tap * FF2 + bj * FF + u.pn * 128 + 2 * pr) : (cb + bj * FF + u.pn * 128 + 2 * pr);
            const f32x2 wv = *(const f32x2*)src;
            if (fr >= 14) {
                unsigned xo = (unsigned)(wr * 512 + (fr - 14) * 128 + cl) * 4u; asm volatile("" : "+v"(xo));
                LAS unsigned char* xb = (LAS unsigned char*)xbuf + xo;
#pragma unroll
                for (int ai = 0; ai < 2; ++ai)
#pragma unroll
                    for (int bj2 = 0; bj2 < 2; ++bj2)
#pragma unroll
                        for (int n = 0; n < 2; ++n) *(LAS f32x4*)(xb + (ai * 1024 + bj2 * 256 + 4 * n) * 4) = acc[ai][bj2][3][n];
            }
            if (wr == 0 && fr < 2) {
#pragma unroll
                for (int bj2 = 0; bj2 < 2; ++bj2)
#pragma unroll
                    for (int n = 0; n < 2; ++n) *(f32x4*)(HALO + (size_t)(u.pm * 4 + fr) * FF2 + u.pn * 256 + bj2 * 128 + cl + 4 * n) = acc[0][bj2][0][n];
            }
            if (wr == 1 && fr >= 14) {
#pragma unroll
                for (int bj2 = 0; bj2 < 2; ++bj2)
#pragma unroll
                    for (int n = 0; n < 2; ++n) *(f32x4*)(HALO + (size_t)(u.pm * 4 + fr - 12) * FF2 + u.pn * 256 + bj2 * 128 + cl + 4 * n) = acc[1][bj2][3][n];
            }
            *(LAS f32x2*)(wl + kind * 128 + 2 * pr) = wv;
        }
        asm volatile("s_waitcnt lgkmcnt(0)" ::: "memory"); __builtin_amdgcn_s_barrier(); asm volatile("" ::: "memory");
        const int row0 = u.pm * BM + wr * 64 + fr;
        const float k1a = fr >= 1 ? 1.f : 0.f, k1b = 1.f - k1a, k0a = fr >= 2 ? 1.f : 0.f, k0b = 1.f - k0a;
#pragma unroll
        for (int n = 0; n < 2; ++n)
#pragma unroll
            for (int bj = 0; bj < 2; ++bj) {
                const LAS float* wp = wl + bj * 512 + cl + 4 * n;
                const f32x4 t0 = *(const LAS f32x4*)wp, t1 = *(const LAS f32x4*)(wp + 128), w2 = *(const LAS f32x4*)(wp + 256), bb = *(const LAS f32x4*)(wp + 384);
                const f32x4 w1a = t1 * k1a, w1b = t1 * k1b, w0a = t0 * k0a, w0b = t0 * k0b;
#pragma unroll
                for (int ai = 0; ai < 2; ++ai) {
                    f32x4 r1p = (f32x4){0.f, 0.f, 0.f, 0.f}, r2p = r1p;
                    if (wr == 1 || ai == 1) { const int sai = (wr == 1) ? ai : 0, swr = (wr == 1) ? 0 : 1; const LAS float* xp = xbuf + (((sai * 2 + swr) * 2 + bj) * 2) * 128 + cl + 4 * n;
                        r1p = *(const LAS f32x4*)(xp + 128); r2p = *(const LAS f32x4*)(xp + (fr & 1) * 128); }
#pragma unroll
                    for (int m = 0; m < 4; ++m) {
                        const f32x4 cur = acc[ai][bj][m][n]; f32x4 r1, r2;
#pragma unroll
                        for (int j = 0; j < 4; ++j) { r1[j] = dpp_ror1(cur[j]); r2[j] = dpp_ror2(cur[j]); }
                        acc[ai][bj][m][n] = bb + w2 * cur + w1a * r1 + w0a * r2 + w1b * r1p + w0b * r2p;
                        r1p = r1; r2p = r2;
                        asm volatile("" : "+v"(acc[ai][bj][m][n]));
                    }
                }
            }
        const int ch = u.pn * 128 + cl;
#pragma unroll
        for (int ai = 0; ai < 2; ++ai)
#pragma unroll
            for (int m = 0; m < 4; ++m) {
                u32x4 o;
#pragma unroll
                for (int n = 0; n < 2; ++n) { const f32x4 gv = acc[ai][0][m][n], vv = acc[ai][1][m][n];
                    const f32x2 g0 = gelu_pk((f32x2){gv[0], gv[1]}), g1 = gelu_pk((f32x2){gv[2], gv[3]});
                    o[2 * n] = pk2(g0.x * vv[0], g0.y * vv[1]); o[2 * n + 1] = pk2(g1.x * vv[2], g1.y * vv[3]); }
                *(u32x4*)(ACT + (size_t)(row0 + ai * HALF + m * 16) * FF + ch) = o;
            }
    }
};

struct PanelOrder {
    int c;
    __device__ bool next(int i, Unit& u) const { if (i >= 2) return false; const int x = c & 7, j = c >> 3; u.pm = 32 * i + 4 * x + (j & 3); u.pn = j >> 2; return true; }
};
struct EpiResLn {
    static constexpr bool PERM = true;
    const float* X; float* XF; bf16_t* XB; const float* g; const float* b; unsigned long long* slots; unsigned* cnt; LAS unsigned char* tl;
    __device__ __forceinline__ void operator()(f32x4 (&acc)[2][2][4][2], const Unit& u, int wr, int wc, int fr, int fq, int wid, int lane) const {
        LAS f32x2* P = (LAS f32x2*)tl; LAS f32x2* S = (LAS f32x2*)(tl + 8192);
        const int row0 = u.pm * BM + wr * 64 + fr, col0 = u.pn * BM + wc * 32 + 8 * fq;
#pragma unroll
        for (int ai = 0; ai < 2; ++ai)
#pragma unroll
            for (int m = 0; m < 4; ++m) { const size_t off = (size_t)(row0 + ai * HALF + m * 16) * D + col0;
#pragma unroll
                for (int bj = 0; bj < 2; ++bj) { f32x4 x0, x1;
                    if (X) { x0 = *(const f32x4*)(X + off + bj * HALF); x1 = *(const f32x4*)(X + off + bj * HALF + 4); }
                    else { const u32x4 xw = *(const u32x4*)(XB + off + bj * HALF); x0 = (f32x4){bflo(xw.x), bfhi(xw.x), bflo(xw.y), bfhi(xw.y)}; x1 = (f32x4){bflo(xw.z), bfhi(xw.z), bflo(xw.w), bfhi(xw.w)}; }
                    acc[ai][bj][m][0] = x0 * ALPHA + acc[ai][bj][m][0]; acc[ai][bj][m][1] = x1 * ALPHA + acc[ai][bj][m][1]; }
                asm volatile("" : "+v"(acc[ai][0][m][0]), "+v"(acc[ai][0][m][1]), "+v"(acc[ai][1][m][0]), "+v"(acc[ai][1][m][1]));
                float s = 0.f;
#pragma unroll
                for (int bj = 0; bj < 2; ++bj)
#pragma unroll
                    for (int n = 0; n < 2; ++n) { const f32x4 x = acc[ai][bj][m][n]; s += (x[0] + x[1]) + (x[2] + x[3]); }
                s += __shfl_xor(s, 16); s += __shfl_xor(s, 32);
                const float mw = s * (1.0f / 64.0f); float q = 0.f;
#pragma unroll
                for (int bj = 0; bj < 2; ++bj)
#pragma unroll
                    for (int n = 0; n < 2; ++n) { const f32x4 d = acc[ai][bj][m][n] - mw; q += (d[0] * d[0] + d[1] * d[1]) + (d[2] * d[2] + d[3] * d[3]); }
                q += __shfl_xor(q, 16); q += __shfl_xor(q, 32);
                if (fq == 0) P[(ai * HALF + wr * 64 + m * 16 + fr) * 4 + wc] = (f32x2){mw, q};
            }
        asm volatile("s_waitcnt lgkmcnt(0)" ::: "memory"); __builtin_amdgcn_s_barrier(); asm volatile("" ::: "memory");
        const int row = wid * 32 + (lane & 31);
        unsigned long long* slot = slots + ((size_t)(u.pm * BM + row) * 8);
        if (lane < 32) {
            const f32x2 a = P[row * 4 + 0], b4 = P[row * 4 + 1], c = P[row * 4 + 2], d = P[row * 4 + 3];
            const float mt = (a.x + b4.x + c.x + d.x) * 0.25f;
            const float da = a.x - mt, db = b4.x - mt, dc = c.x - mt, dd = d.x - mt;
            const float m2 = (a.y + b4.y) + (c.y + d.y) + 64.0f * ((da * da + db * db) + (dc * dc + dd * dd));
            __hip_atomic_store(slot + u.pn, ((unsigned long long)__float_as_uint(m2) << 32) | __float_as_uint(mt), __ATOMIC_RELAXED, __HIP_MEMORY_SCOPE_AGENT);
        }
        asm volatile("s_waitcnt vmcnt(0)" ::: "memory");
        unsigned* cw = cnt + 64 * u.pm;
        if (lane == 0) __hip_atomic_fetch_add(cw, 1u, __ATOMIC_RELAXED, __HIP_MEMORY_SCOPE_AGENT);
        if (wid == 0) {
            unsigned sp = 0;
            while ((unsigned)__builtin_amdgcn_readfirstlane(__hip_atomic_load(cw, __ATOMIC_RELAXED, __HIP_MEMORY_SCOPE_AGENT)) < 64u) { __builtin_amdgcn_s_sleep(1); if (++sp > (1u << 24)) break; }
            __builtin_amdgcn_fence(__ATOMIC_ACQUIRE, "agent");
        }
        asm volatile("s_waitcnt vmcnt(0) lgkmcnt(0)" ::: "memory"); __builtin_amdgcn_s_barrier(); asm volatile("" ::: "memory");
        if (lane < 32) {
            float mt[8], m2[8]; float ms = 0.f;
#pragma unroll
            for (int t = 0; t < 8; ++t) { const unsigned long long w = __hip_atomic_load(slot + t, __ATOMIC_RELAXED, __HIP_MEMORY_SCOPE_AGENT); mt[t] = __uint_as_float((unsigned)w); m2[t] = __uint_as_float((unsigned)(w >> 32)); ms += mt[t]; }
            const float mean = ms * 0.125f; float q = 0.f;
#pragma unroll
            for (int t = 0; t < 8; ++t) { const float dm = mt[t] - mean; q += m2[t] + 256.0f * dm * dm; }
            S[row] = (f32x2){mean, 1.0f / sqrtf(q * (1.0f / 2048.0f) + LN_EPS)};
        }
        asm volatile("s_waitcnt lgkmcnt(0)" ::: "memory"); __builtin_amdgcn_s_barrier(); asm volatile("" ::: "memory");
#pragma unroll
        for (int bj = 0; bj < 2; ++bj) {
            const f32x4 g0 = *(const f32x4*)(g + col0 + bj * HALF), g1 = *(const f32x4*)(g + col0 + bj * HALF + 4), b0 = *(const f32x4*)(b + col0 + bj * HALF), b1 = *(const f32x4*)(b + col0 + bj * HALF + 4);
#pragma unroll
            for (int ai = 0; ai < 2; ++ai)
#pragma unroll
                for (int m = 0; m < 4; ++m) { const int r = ai * HALF + wr * 64 + m * 16 + fr; const f32x2 sr = S[r]; const size_t off = (size_t)(u.pm * BM + r) * D + col0 + bj * HALF;
                    const f32x4 o0 = (acc[ai][bj][m][0] - sr.x) * sr.y * g0 + b0, o1 = (acc[ai][bj][m][1] - sr.x) * sr.y * g1 + b1;
                    if (XF) { *(f32x4*)(XF + off) = o0; *(f32x4*)(XF + off + 4) = o1; }
                    u32x4 w; w.x = pk2(o0[0], o0[1]); w.y = pk2(o0[2], o0[3]); w.z = pk2(o1[0], o1[1]); w.w = pk2(o1[2], o1[3]); *(u32x4*)(XB + off) = w; } }
    }
};

template <class Epi, class Sched, bool ALIGN_EPI = true>
__device__ __forceinline__ void gemm_phase(LAS unsigned char* lds, const Gemm g, const Sched& S, const Epi& E) {
    int tid = threadIdx.x; asm volatile("" : "+v"(tid));
    const int wid = __builtin_amdgcn_readfirstlane(tid >> 6), lane = tid & 63, wr = wid >> 2, wc = wid & 3, fr = lane & 15, fq = lane >> 4;
    const int K = g.K, nt = K / BK;
    unsigned voffA[2], voffB[2];
#pragma unroll
    for (int i = 0; i < 2; ++i) { int R, C; stage_rc(tid * 16 + i * 8192, R, C); const int Rb = Epi::PERM ? ((R & ~31) + perm32(R & 31)) : R;
        voffA[i] = (unsigned)(R * g.lda + C) * 2u; voffB[i] = (unsigned)(Rb * g.ldb + C) * 2u; }
    const size_t kstep = (size_t)(BK * 2);
    const size_t hA = (size_t)HALF * g.lda * 2, hB = (size_t)HALF * g.ldb * 2;
    const unsigned ldsw = (unsigned)wid * 1024u;
    const int aoff = lds_byte(wr * 64 + fr, fq * 8), boff = lds_byte(wc * 32 + fr, fq * 8);
#define PG8_SA(b, h) (((b) * 2 + (h)) * HTB)
#define PG8_SB(b, h) ((4 + (b) * 2 + (h)) * HTB)
#define PG8_STAGE(bufoff, gbase, voff) do { _Pragma("unroll") for (int _i = 0; _i < 2; ++_i) \
        __builtin_amdgcn_global_load_lds((const unsigned*)((const char*)(gbase) + (voff)[_i]), (LAS unsigned*)(lds + (bufoff) + ldsw + _i * 8192), 16, 0, 0); } while (0)
#define PG8_LDA(dst, b, h) do { _Pragma("unroll") for (int m = 0; m < 4; ++m) _Pragma("unroll") for (int k = 0; k < 2; ++k) dst[m][k] = *(const LAS bf16x8*)(lds + PG8_SA(b, h) + aoff + m * 2048 + k * 1024); } while (0)
#define PG8_LDB(dst, b, h) do { _Pragma("unroll") for (int n = 0; n < 2; ++n) _Pragma("unroll") for (int k = 0; k < 2; ++k) dst[n][k] = *(const LAS bf16x8*)(lds + PG8_SB(b, h) + boff + n * 2048 + k * 1024); } while (0)
#define PG8_MMA(ai, bj, At, Bt) do { __builtin_amdgcn_s_setprio(1); _Pragma("unroll") for (int m = 0; m < 4; ++m) _Pragma("unroll") for (int n = 0; n < 2; ++n) _Pragma("unroll") for (int k = 0; k < 2; ++k) \
        acc[ai][bj][m][n] = __builtin_amdgcn_mfma_f32_16x16x32_bf16(Bt[n][k], At[m][k], acc[ai][bj][m][n], 0, 0, 0); __builtin_amdgcn_s_setprio(0); } while (0)
#define PG8_WAIT_V(n) asm volatile("s_waitcnt vmcnt(" #n ")" ::: "memory")
#define PG8_WAIT_L(n) asm volatile("s_waitcnt lgkmcnt(" #n ")" ::: "memory")
#define PG8_BAR __builtin_amdgcn_s_barrier()
#define PG8_SCHED __builtin_amdgcn_sched_barrier(0)
    Unit cur, nxt; int ui = 0;
    if (!S.next(0, cur)) return;
    f32x4 acc[2][2][4][2];
#pragma unroll
    for (int a = 0; a < 2; ++a)
#pragma unroll
        for (int b = 0; b < 2; ++b)
#pragma unroll
            for (int m = 0; m < 4; ++m)
#pragma unroll
                for (int n = 0; n < 2; ++n) acc[a][b][m][n] = (f32x4){0.f, 0.f, 0.f, 0.f};
    bf16x8 At[4][2], B0[2][2], B1[2][2];
    const char* cA = (const char*)g.A + ((size_t)cur.pm * BM * g.lda + (size_t)cur.pn * g.a_pn_off) * 2; const char* cB = (const char*)g.Bt + (size_t)cur.pn * BM * g.ldb * 2;
    PG8_STAGE(PG8_SB(0, 0), cB, voffB); PG8_STAGE(PG8_SB(0, 1), cB + hB, voffB); PG8_STAGE(PG8_SA(0, 0), cA, voffA); PG8_STAGE(PG8_SA(0, 1), cA + hA, voffA);
    if (wr == 1) PG8_BAR;
    PG8_WAIT_V(2); PG8_BAR;
    PG8_STAGE(PG8_SB(1, 0), cB + kstep, voffB); PG8_STAGE(PG8_SA(1, 0), cA + kstep, voffA); PG8_STAGE(PG8_SB(1, 1), cB + hB + kstep, voffB);
    PG8_WAIT_V(6); PG8_BAR;
    for (;;) {
        const bool has_next = S.next(ui + 1, nxt);
        const char* nA = has_next ? (const char*)g.A + ((size_t)nxt.pm * BM * g.lda + (size_t)nxt.pn * g.a_pn_off) * 2 : cA; const char* nB = has_next ? (const char*)g.Bt + (size_t)nxt.pn * BM * g.ldb * 2 : cB;
        for (int t = 0; t < nt; t += 2) {
            const bool last = (t == nt - 2);
            const char* a1 = cA + (size_t)(t + 1) * kstep;
            const char* a2 = last ? nA : cA + (size_t)(t + 2) * kstep; const char* b2 = last ? nB : cB + (size_t)(t + 2) * kstep;
            const char* a3 = a2 + kstep; const char* b3 = b2 + kstep;
            PG8_LDB(B0, 0, 0); PG8_LDB(B1, 0, 1); PG8_SCHED; PG8_LDA(At, 0, 0); PG8_STAGE(PG8_SA(1, 1), a1 + hA, voffA);
            PG8_WAIT_V(8); PG8_WAIT_L(0); PG8_BAR; PG8_MMA(0, 0, At, B0); PG8_MMA(0, 1, At, B1); PG8_BAR; PG8_SCHED;
            PG8_LDA(At, 0, 1); PG8_STAGE(PG8_SB(0, 0), b2, voffB); PG8_STAGE(PG8_SB(0, 1), b2 + hB, voffB); PG8_STAGE(PG8_SA(0, 0), a2, voffA);
            PG8_WAIT_V(8); PG8_WAIT_L(0); PG8_BAR; PG8_MMA(1, 0, At, B0); PG8_MMA(1, 1, At, B1); PG8_BAR; PG8_SCHED;
            PG8_LDB(B0, 1, 0); PG8_LDB(B1, 1, 1); PG8_SCHED; PG8_LDA(At, 1, 0); PG8_STAGE(PG8_SA(0, 1), a2 + hA, voffA);
            PG8_WAIT_V(8); PG8_WAIT_L(0); PG8_BAR; PG8_MMA(0, 0, At, B0); PG8_MMA(0, 1, At, B1); PG8_BAR; PG8_SCHED;
            PG8_LDA(At, 1, 1); PG8_STAGE(PG8_SB(1, 0), b3, voffB); PG8_STAGE(PG8_SB(1, 1), b3 + hB, voffB); PG8_STAGE(PG8_SA(1, 0), a3, voffA);
            PG8_WAIT_V(8); PG8_WAIT_L(0); PG8_BAR; PG8_MMA(1, 0, At, B0); PG8_MMA(1, 1, At, B1); PG8_BAR; PG8_SCHED;
        }
        if constexpr (ALIGN_EPI) { if (wr == 0) PG8_BAR; }
        E(acc, cur, wr, wc, fr, fq, wid, lane);
        if (!has_next) break;
#pragma unroll
        for (int a = 0; a < 2; ++a)
#pragma unroll
            for (int b = 0; b < 2; ++b)
#pragma unroll
                for (int m = 0; m < 4; ++m)
#pragma unroll
                    for (int n = 0; n < 2; ++n) acc[a][b][m][n] = (f32x4){0.f, 0.f, 0.f, 0.f};
        cur = nxt; cA = nA; cB = nB; ++ui;
        if constexpr (ALIGN_EPI) { if (wr == 1) PG8_BAR; }
    }
    PG8_WAIT_V(0);
    if constexpr (!ALIGN_EPI) { if (wr == 0) PG8_BAR; }
    PG8_BAR;
#undef PG8_SA
#undef PG8_SB
#undef PG8_STAGE
#undef PG8_LDA
#undef PG8_LDB
#undef PG8_MMA
#undef PG8_WAIT_V
#undef PG8_WAIT_L
#undef PG8_BAR
#undef PG8_SCHED
}
}

#define XB_TMO      128
#define XB_XCNT(j)  (256  + 64 * (j))
#define XB_XSUB(j)  (1280 + 64 * (j))
#define XB_XGEN(j)  (2304 + 64 * (j))
#define XB_TOP      3328
#define XB_TOPGEN   3392
#define XCD_BAR_WORDS 3456
#define XB_SPIN_CAP (1u << 22)
__device__ __forceinline__ unsigned xb_ld(unsigned* p)              { return __hip_atomic_load(p, __ATOMIC_RELAXED, __HIP_MEMORY_SCOPE_AGENT); }
__device__ __forceinline__ unsigned xb_add(unsigned* p, unsigned v) { return __hip_atomic_fetch_add(p, v, __ATOMIC_RELAXED, __HIP_MEMORY_SCOPE_AGENT); }
__device__ __forceinline__ unsigned xb_xcc_id() { return (unsigned)__builtin_amdgcn_s_getreg((3 << 11) | 20) & 0xFu; }
#define XB_SPIN(cond, bar) do { unsigned _sp = 0; while (cond) { __builtin_amdgcn_s_sleep(1); \
    if ((++_sp & 255u) == 0u) { if (xb_ld(&(bar)[XB_TMO])) break; if (_sp > XB_SPIN_CAP) { atomicAdd(&(bar)[XB_TMO], 1u); break; } } } } while (0)
struct XcdBarrier { unsigned* bar; unsigned x; volatile LAS unsigned* st; };
__device__ __forceinline__ XcdBarrier xcd_barrier_post(unsigned* bar, volatile LAS unsigned* st) {
    XcdBarrier b; b.bar = bar; b.x = xb_xcc_id(); b.st = st;
    if (threadIdx.x == 0) (void)xb_add(&bar[XB_XCNT(b.x)], 1u);
    return b;
}
__device__ __forceinline__ void xcd_barrier_complete(unsigned* bar, unsigned x, unsigned& nloc, unsigned& nx) {
    const unsigned G = gridDim.x * gridDim.y * gridDim.z;
    unsigned sum, cnt, mine, sp = 0u;
    for (;;) {
        sum = 0u; cnt = 0u; mine = 0u;
#pragma unroll
        for (unsigned j = 0; j < 16; ++j) { const unsigned c = xb_ld(&bar[XB_XCNT(j)]); sum += c; cnt += (c > 0u) ? 1u : 0u; mine = (j == x) ? c : mine; }
        if (sum == G) break;
        __builtin_amdgcn_s_sleep(1);
        if ((++sp & 255u) == 0u) { if (xb_ld(&bar[XB_TMO])) break; if (sp > XB_SPIN_CAP) { atomicAdd(&bar[XB_TMO], 1u); break; } }
    }
    nloc = mine > 0u ? mine : 1u; nx = cnt > 0u ? cnt : 1u;
}
__device__ __forceinline__ void xcd_barrier(const XcdBarrier& b) {
    asm volatile("s_waitcnt vmcnt(0)" ::: "memory");
    __syncthreads();
    if (threadIdx.x == 0) {
        unsigned* bar = b.bar;
        __builtin_amdgcn_s_waitcnt(0);
        unsigned nloc = b.st[0], nx = b.st[1];
        if (nloc == 0u) { xcd_barrier_complete(bar, b.x, nloc, nx); b.st[0] = nloc; b.st[1] = nx; }
        const unsigned old = xb_add(&bar[XB_XSUB(b.x)], 1u);
        const unsigned gen = old / nloc;
        if (old + 1u == (gen + 1u) * nloc) {
            __builtin_amdgcn_fence(__ATOMIC_RELEASE, "agent");
            asm volatile("s_waitcnt vmcnt(0)" ::: "memory");
            const unsigned og = xb_add(&bar[XB_TOP], 1u);
            const unsigned tg = og / nx;
            if (og + 1u == (tg + 1u) * nx) xb_add(&bar[XB_TOPGEN], 1u);
            else XB_SPIN(xb_ld(&bar[XB_TOPGEN]) == tg, bar);
            __builtin_amdgcn_fence(__ATOMIC_ACQUIRE, "agent");
            xb_add(&bar[XB_XGEN(b.x)], 1u);
            asm volatile("s_waitcnt vmcnt(0)" ::: "memory");
        } else {
            XB_SPIN(xb_ld(&bar[XB_XGEN(b.x)]) == gen, bar);
            __builtin_amdgcn_fence(__ATOMIC_ACQUIRE, "agent");
            asm volatile("s_waitcnt vmcnt(0)" ::: "memory");
        }
    }
    __syncthreads();
}

struct Args { const float* in[15]; float* out; unsigned char* ws; };
struct Frame { LAS unsigned char* lds; int tid, lane, wave, G, bid; };
__device__ __forceinline__ Frame relaunder(const Frame& F0) { Frame F = F0; int t = F0.tid; asm volatile("" : "+v"(t)); F.tid = t; F.lane = t & 63; F.wave = __builtin_amdgcn_readfirstlane(t >> 6); return F; }

__device__ __forceinline__ void p0_item(const float* W, int K, int N, bf16_t* WT, int row_off, bool permff, LAS float* scr, int item, int lane) {
    const int nblk = N >> 6, kb = item / nblk, nb = item - kb * nblk, k0 = kb << 6, n0 = nb << 6;
    const float* src = W + (size_t)k0 * N + n0 + lane;
#pragma unroll 16
    for (int kk = 0; kk < 64; ++kk) scr[kk * 65 + lane] = src[(size_t)kk * N];
    asm volatile("s_waitcnt lgkmcnt(0)" ::: "memory");
    int orow0 = row_off + n0;
    if (permff) { orow0 = (n0 < FF) ? ((n0 >> 7) * 256 + (n0 & 127)) : (((n0 - FF) >> 7) * 256 + 128 + ((n0 - FF) & 127)); }
#pragma unroll
    for (int j = 0; j < 8; ++j) { const int id = lane + 64 * j, n = id >> 3, c = id & 7; const LAS float* s = scr + (8 * c) * 65 + n;
        u32x4 o; o.x = pk2(s[0 * 65], s[1 * 65]); o.y = pk2(s[2 * 65], s[3 * 65]); o.z = pk2(s[4 * 65], s[5 * 65]); o.w = pk2(s[6 * 65], s[7 * 65]);
        *(u32x4*)(WT + (size_t)(orow0 + n) * K + k0 + 8 * c) = o; }
    asm volatile("s_waitcnt lgkmcnt(0)" ::: "memory");
}
__device__ __forceinline__ void p0_prologue(const Frame& F0, const Args& a) {
    const Frame F = relaunder(F0);
    LAS float* scr = (LAS float*)(F.lds + F.wave * 16640);
    const int gw = F.bid * 8 + F.wave, NGW = F.G * 8;
    unsigned char* ws = a.ws;
    constexpr int I_EIN = (D / 64) * (EIN / 64), I_SQ = (D / 64) * (D / 64), I_PW = 16, I_QKV = (D / 64) * (OIN / 64), I_F1 = (D / 64) * (FF2 / 64), I_F2 = (FF / 64) * (D / 64);
    constexpr int T0 = 2 * I_EIN, T1 = T0 + 2 * I_SQ, T2 = T1 + 8 * I_PW, T3 = T2 + 2 * I_QKV, T4 = T3 + 2 * I_SQ, T5 = T4 + 4 * I_F1, T6 = T5 + 4 * I_F2;
    for (int it = gw; it < T6; it += NGW) {
        if (it < T0) { const int li = it / I_EIN, r = it - li * I_EIN; p0_item(a.in[3] + (size_t)li * D * EIN, D, EIN, (bf16_t*)(ws + WS_EIN) + (size_t)li * EIN * D, 0, false, scr, r, F.lane); }
        else if (it < T1) { const int x = it - T0, li = x / I_SQ, r = x - li * I_SQ; p0_item(a.in[6] + (size_t)li * D * D, D, D, (bf16_t*)(ws + WS_EOUT) + (size_t)li * D * D, 0, false, scr, r, F.lane); }
        else if (it < T2) { const int x = it - T1, lg = x / I_PW, r = x - lg * I_PW, li = lg >> 2, g = lg & 3; p0_item(a.in[4] + (size_t)lg * 65536, 256, 256, (bf16_t*)(ws + WS_POOLW) + (size_t)li * 1024 * 256, g * 256, false, scr, r, F.lane); }
        else if (it < T3) { const int x = it - T2, li = x / I_QKV, r = x - li * I_QKV; p0_item(a.in[7] + (size_t)li * D * OIN, D, OIN, (bf16_t*)(ws + WS_QKVW) + (size_t)li * OIN * D, 0, false, scr, r, F.lane); }
        else if (it < T4) { const int x = it - T3, li = x / I_SQ, r = x - li * I_SQ; p0_item(a.in[10] + (size_t)li * D * D, D, D, (bf16_t*)(ws + WS_AOUT) + (size_t)li * D * D, 0, false, scr, r, F.lane); }
        else if (it < T5) { const int x = it - T4, l = x / I_F1, r = x - l * I_F1; p0_item(a.in[11] + (size_t)l * D * FF2, D, FF2, (bf16_t*)(ws + WS_F1) + (size_t)l * FF2 * D, 0, true, scr, r, F.lane); }
        else { const int x = it - T5, l = x / I_F2, r = x - l * I_F2; p0_item(a.in[14] + (size_t)l * FF * D, FF, D, (bf16_t*)(ws + WS_F2) + (size_t)l * D * FF, 0, false, scr, r, F.lane); }
    }
    const f32x4* x4 = (const f32x4*)a.in[0]; u32x2* xb = (u32x2*)(ws + WS_XB);
    for (size_t i = (size_t)F.bid * 512 + F.tid; i < (size_t)M * D / 4; i += (size_t)F.G * 512) { const f32x4 v = x4[i]; u32x2 o; o.x = pk2(v[0], v[1]); o.y = pk2(v[2], v[3]); xb[i] = o; }
}

__device__ __forceinline__ void ln_phase(const Frame& F0, const float* Y, const float* g, const float* b, float* XF, bf16_t* XB) {
    const Frame F = relaunder(F0);
    const int gw = F.bid * 8 + F.wave, NGW = F.G * 8;
    for (int row = gw; row < M; row += NGW) {
        const f32x4* yr = (const f32x4*)(Y + (size_t)row * D) + F.lane;
        f32x4 v[8]; float s = 0.f;
#pragma unroll
        for (int j = 0; j < 8; ++j) { v[j] = yr[64 * j]; s += (v[j][0] + v[j][1]) + (v[j][2] + v[j][3]); }
        const float mean = wave_sum(s) * (1.f / D); float s2 = 0.f;
#pragma unroll
        for (int j = 0; j < 8; ++j) { v[j] = v[j] - mean; s2 += (v[j][0] * v[j][0] + v[j][1] * v[j][1]) + (v[j][2] * v[j][2] + v[j][3] * v[j][3]); }
        const float rstd = 1.0f / sqrtf(wave_sum(s2) * (1.f / D) + LN_EPS);
        f32x4* xo = (f32x4*)(XF + (size_t)row * D) + F.lane; u32x2* bo = (u32x2*)(XB + (size_t)row * D) + F.lane;
#pragma unroll
        for (int j = 0; j < 8; ++j) { const f32x4 gg = ((const f32x4*)g)[F.lane + 64 * j], bb = ((const f32x4*)b)[F.lane + 64 * j];
            const f32x4 o = v[j] * rstd * gg + bb; xo[64 * j] = o; u32x2 w; w.x = pk2(o[0], o[1]); w.y = pk2(o[2], o[3]); bo[64 * j] = w; }
    }
}

__device__ __forceinline__ void conv_fixup_item(int pm, int cq, const float* HALO, const float* cw, const float* cb, bf16_t* ACT) {
    const int c = cq * 4, col = (c >> 7) * 256 + (c & 127);
    f32x4 cv[2][2];
#pragma unroll
    for (int bj = 0; bj < 2; ++bj) {
        const float* hp = HALO + (size_t)(pm * 4) * FF2 + col + bj * 128;
        const f32x4 hm2 = *(const f32x4*)(hp - 2 * FF2), hm1 = *(const f32x4*)(hp - FF2), h0 = *(const f32x4*)hp, h1 = *(const f32x4*)(hp + FF2);
        const f32x4 w0 = *(const f32x4*)(cw + bj * FF + c), w1 = *(const f32x4*)(cw + (size_t)FF2 + bj * FF + c), w2 = *(const f32x4*)(cw + (size_t)2 * FF2 + bj * FF + c), b = *(const f32x4*)(cb + bj * FF + c);
        cv[bj][0] = b + w0 * hm2 + w1 * hm1 + w2 * h0; cv[bj][1] = b + w0 * hm1 + w1 * h0 + w2 * h1;
    }
#pragma unroll
    for (int rr = 0; rr < 2; ++rr) { const f32x2 g0 = gelu_pk((f32x2){cv[0][rr][0], cv[0][rr][1]}), g1 = gelu_pk((f32x2){cv[0][rr][2], cv[0][rr][3]});
        u32x2 o; o.x = pk2(g0.x * cv[1][rr][0], g0.y * cv[1][rr][1]); o.y = pk2(g1.x * cv[1][rr][2], g1.y * cv[1][rr][3]);
        *(u32x2*)(ACT + (size_t)(pm * 256 + rr) * FF + c) = o; }
}
__device__ __forceinline__ void conv_fixup_phase(const Frame& F0, const float* HALO, const float* cw, const float* cb, bf16_t* ACT) {
    const Frame F = relaunder(F0);
    constexpr int NCQ = FF / 4;
    for (int it = F.bid * 512 + F.tid; it < 64 * NCQ; it += F.G * 512) { const int pm = it / NCQ, cq = it - pm * NCQ; if ((pm & 15) == 0) continue; conv_fixup_item(pm, cq, HALO, cw, cb, ACT); }
}
__device__ __forceinline__ void conv_fixup_own(const Frame& F0, const float* HALO, const float* cw, const float* cb, bf16_t* ACT) {
    const Frame F = relaunder(F0);
    constexpr int NCQ = FF / 4;
    const int x = F.bid & 7, j = F.bid >> 3;
#pragma unroll 1
    for (int i = 0; i < 2; ++i) { const int pm = 32 * i + 4 * x + (j & 3); if ((pm & 15) == 0) continue;
        for (int cq = F.tid; cq < NCQ; cq += 512) conv_fixup_item(pm, cq, HALO, cw, cb, ACT); }
    asm volatile("s_waitcnt vmcnt(0)" ::: "memory"); __syncthreads();
}

__device__ __forceinline__ void attn_phase(const Frame& F0, const bf16_t* QKV, const float* sinks, bf16_t* MIX) {
    const Frame F = relaunder(F0);
    constexpr int RS = 144;
    LAS unsigned char* Kt = F.lds; LAS unsigned char* Vt = F.lds + 256 * RS;
    const int lane = F.lane, r = lane & 15, g4 = lane >> 4, qq = r >> 2, pp = r & 3;
    for (int u = F.bid; u < 512; u += F.G) {
        const int kvh = u & 3, n = (u >> 2) & 31, b = u >> 7, tok0 = b * SEQ + n * 128;
        for (int c = F.tid; c < 256 * 8; c += 512) { const int row = c >> 3, ch = c & 7; const bool valid = (n > 0) || (row >= 128);
            u32x4 kv = (u32x4){0u, 0u, 0u, 0u}, vv = kv;
            if (valid) { const bf16_t* src = QKV + (size_t)(tok0 - 128 + row) * OIN + 2048 + kvh * 64 + ch * 8; kv = *(const u32x4*)src; vv = *(const u32x4*)(src + 256); }
            *(LAS u32x4*)(Kt + row * RS + ch * 16) = kv; *(LAS u32x4*)(Vt + row * RS + ch * 16) = vv; }
        __syncthreads();
        const int head = kvh * 8 + F.wave;
        const float slope2 = __builtin_amdgcn_exp2f(-0.25f * (float)(head + 1)) * LOG2E, sink2 = sinks[head] * LOG2E;
        for (int rb = 0; rb < 8; ++rb) {
            const bf16_t* qp = QKV + (size_t)(tok0 + 16 * rb + r) * OIN + head * 64 + 8 * g4;
            const bf16x8 q0 = *(const bf16x8*)qp, q1 = *(const bf16x8*)(qp + 32);
            f32x4 s[9];
#pragma unroll
            for (int tt = 0; tt < 9; ++tt) { const LAS unsigned char* kp = Kt + (16 * (rb + tt) + r) * RS + 16 * g4;
                f32x4 acc = (f32x4){0.f, 0.f, 0.f, 0.f};
                acc = mfma16(*(const LAS bf16x8*)kp, q0, acc); acc = mfma16(*(const LAS bf16x8*)(kp + 64), q1, acc); s[tt] = acc; }
            const int i = 16 * rb + r; float mx = -INFINITY;
#pragma unroll
            for (int tt = 0; tt < 9; ++tt)
#pragma unroll
                for (int jj = 0; jj < 4; ++jj) { const int j = 16 * (rb + tt) + 4 * g4 + jj, delta = 128 + i - j; const bool valid = (delta >= 0) && (delta < 128) && ((n > 0) || (j >= 128));
                    const float v = s[tt][jj] * (0.125f * LOG2E) - slope2 * (float)delta; s[tt][jj] = valid ? v : -INFINITY; mx = fmaxf(mx, s[tt][jj]); }
            mx = fmaxf(mx, __shfl_xor(mx, 16)); mx = fmaxf(mx, __shfl_xor(mx, 32)); mx = fmaxf(mx, sink2);
            float sum = 0.f;
#pragma unroll
            for (int tt = 0; tt < 9; ++tt)
#pragma unroll
                for (int jj = 0; jj < 4; ++jj) { const float p = __builtin_amdgcn_exp2f(s[tt][jj] - mx); s[tt][jj] = p; sum += p; }
            sum += __shfl_xor(sum, 16); sum += __shfl_xor(sum, 32);
            const float inv = 1.0f / (sum + __builtin_amdgcn_exp2f(sink2 - mx));
            u32x2 P[10];
#pragma unroll
            for (int tt = 0; tt < 9; ++tt) { P[tt].x = pk2(s[tt][0] * inv, s[tt][1] * inv); P[tt].y = pk2(s[tt][2] * inv, s[tt][3] * inv); }
            P[9] = (u32x2){0u, 0u};
            f32x4 o[4];
#pragma unroll
            for (int te = 0; te < 4; ++te) o[te] = (f32x4){0.f, 0.f, 0.f, 0.f};
#pragma unroll
            for (int pr = 0; pr < 5; ++pr) { const int t0 = 2 * pr, t1 = (pr < 4) ? 2 * pr + 1 : 2 * pr;
                const u32x4 bw = (u32x4){P[t0].x, P[t0].y, P[2 * pr + 1].x, P[2 * pr + 1].y}; const bf16x8 bfrag = __builtin_bit_cast(bf16x8, bw);
                const LAS unsigned char* v0 = Vt + (16 * (rb + t0) + 4 * g4 + qq) * RS + 8 * pp; const LAS unsigned char* v1 = Vt + (16 * (rb + t1) + 4 * g4 + qq) * RS + 8 * pp;
#pragma unroll
                for (int te = 0; te < 4; ++te) o[te] = mfma16(cat8(vtr(v0 + 32 * te), vtr(v1 + 32 * te)), bfrag, o[te]); }
            bf16_t* op = MIX + (size_t)(tok0 + i) * D + head * 64 + 4 * g4;
#pragma unroll
            for (int te = 0; te < 4; ++te) { u32x2 w; w.x = pk2(o[te][0], o[te][1]); w.y = pk2(o[te][2], o[te][3]); *(u32x2*)(op + 16 * te) = w; }
        }
        __syncthreads();
    }
}

__device__ __forceinline__ float ret_lg2(int h) { return __builtin_amdgcn_logf(1.0f - __builtin_amdgcn_exp2f(-5.0f - (float)h)); }
constexpr int RRS = 528;

__device__ __forceinline__ void ret_kv_phase(const Frame& F0, const bf16_t* H5, bf16_t* KVT) {
    const Frame F = relaunder(F0);
    LAS unsigned char* Kt = F.lds; LAS unsigned char* Vt = F.lds + 128 * RRS;
    const int lane = F.lane, r = lane & 15, g4 = lane >> 4, qq = r >> 2, pp = r & 3, w = F.wave;
    for (int u = F.bid; u < 512; u += F.G) {
        const int h = u & 3, n = (u >> 2) & 31, b = u >> 7, tok0 = b * SEQ + n * 128; const float lg2 = ret_lg2(h);
        for (int c = F.tid; c < 128 * 32; c += 512) { const int row = c >> 5, ch = c & 31; const bf16_t* src = H5 + (size_t)(tok0 + row) * EIN + 1024 + h * 256 + ch * 8;
            const u32x4 kv = *(const u32x4*)src, vv = *(const u32x4*)(src + 1024); const float z = __builtin_amdgcn_exp2f(lg2 * (float)(127 - row)) * 0.0625f;
            u32x4 ks;
#pragma unroll
            for (int e = 0; e < 4; ++e) ks[e] = pk2(bflo(kv[e]) * z, bfhi(kv[e]) * z);
            *(LAS u32x4*)(Kt + row * RRS + ch * 16) = ks; *(LAS u32x4*)(Vt + row * RRS + ch * 16) = vv; }
        __syncthreads();
        for (int dh = 0; dh < 2; ++dh) {
            f32x4 acc[2][8];
#pragma unroll
            for (int a = 0; a < 2; ++a)
#pragma unroll
                for (int d = 0; d < 8; ++d) acc[a][d] = (f32x4){0.f, 0.f, 0.f, 0.f};
#pragma unroll
            for (int ks = 0; ks < 4; ++ks) { const int R0 = 32 * ks + 8 * g4 + qq;
                const LAS unsigned char* vb = Vt + R0 * RRS + 8 * pp; const LAS unsigned char* kb = Kt + R0 * RRS + 8 * pp + 256 * dh;
                const bf16x8 vf0 = cat8(vtr(vb + 64 * w), vtr(vb + 4 * RRS + 64 * w)), vf1 = cat8(vtr(vb + 64 * w + 32), vtr(vb + 4 * RRS + 64 * w + 32));
#pragma unroll
                for (int dt = 0; dt < 8; ++dt) { const bf16x8 kf = cat8(vtr(kb + 32 * dt), vtr(kb + 4 * RRS + 32 * dt)); acc[0][dt] = mfma16(kf, vf0, acc[0][dt]); acc[1][dt] = mfma16(kf, vf1, acc[1][dt]); } }
            bf16_t* op = KVT + (size_t)u * 65536 + (size_t)(32 * w + r) * 256 + 128 * dh + 4 * g4;
#pragma unroll
            for (int a = 0; a < 2; ++a)
#pragma unroll
                for (int dt = 0; dt < 8; ++dt) { u32x2 o; o.x = pk2(acc[a][dt][0], acc[a][dt][1]); o.y = pk2(acc[a][dt][2], acc[a][dt][3]); *(u32x2*)(op + a * 16 * 256 + 16 * dt) = o; }
        }
        __syncthreads();
    }
}
__device__ __forceinline__ void pooled_phase(const Frame& F0, const bf16_t* H5, bf16_t* PO) {
    const Frame F = relaunder(F0);
    for (int it = F.bid * 512 + F.tid; it < 1024 * 128; it += F.G * 512) {
        const int cgp = it & 127, run = it >> 7, c = cgp * 8, w = 2 << (c >> 8), t0 = run * 16, p0 = t0 & (SEQ - 1);
        const bf16_t* U = H5 + 4096 + c;
        float S[8];
#pragma unroll
        for (int e = 0; e < 8; ++e) S[e] = 0.f;
        for (int s = 1; s < w; ++s) if (p0 - s >= 0) { const u32x4 x = *(const u32x4*)(U + (size_t)(t0 - s) * EIN);
#pragma unroll
            for (int e = 0; e < 4; ++e) { S[2 * e] += bflo(x[e]); S[2 * e + 1] += bfhi(x[e]); } }
        for (int k = 0; k < 16; ++k) { const int t = t0 + k, p = p0 + k; const u32x4 x = *(const u32x4*)(U + (size_t)t * EIN);
            const float rc = 1.0f / (float)((p + 1 < w) ? p + 1 : w); u32x4 o;
#pragma unroll
            for (int e = 0; e < 4; ++e) { const float a0 = bflo(x[e]), a1 = bfhi(x[e]); S[2 * e] += a0; S[2 * e + 1] += a1; o[e] = pk2(S[2 * e] * rc - a0, S[2 * e + 1] * rc - a1); }
            *(u32x4*)(PO + (size_t)t * 1024 + c) = o;
            if (p - (w - 1) >= 0) { const u32x4 y = *(const u32x4*)(U + (size_t)(t - (w - 1)) * EIN);
#pragma unroll
                for (int e = 0; e < 4; ++e) { S[2 * e] -= bflo(y[e]); S[2 * e + 1] -= bfhi(y[e]); } }
        }
    }
}
__device__ __forceinline__ void ret_scan_phase(const Frame& F0, const bf16_t* KVT, bf16_t* PREVT) {
    const Frame F = relaunder(F0);
    for (int it = F.bid * 512 + F.tid; it < 16 * 16384; it += F.G * 512) {
        const int bh = it >> 14, e4 = it & 16383, b = bh >> 2, h = bh & 3; const float cd = __builtin_amdgcn_exp2f(ret_lg2(h) * 128.0f);
        f32x4 st = (f32x4){0.f, 0.f, 0.f, 0.f};
#pragma unroll 8
        for (int n = 0; n < 31; ++n) { const size_t u = (size_t)((b * 32 + n) * 4 + h);
            { const u32x2 kw = *(const u32x2*)(KVT + u * 65536 + (size_t)e4 * 4); st = st * cd + (f32x4){bflo(kw.x), bfhi(kw.x), bflo(kw.y), bfhi(kw.y)}; }
            u32x2 o; o.x = pk2(st[0], st[1]); o.y = pk2(st[2], st[3]); *(u32x2*)(PREVT + (u + 4) * 65536 + (size_t)e4 * 4) = o; }
    }
}
__device__ __forceinline__ void ret_out_phase(const Frame& F0, const bf16_t* H5, const bf16_t* PREVT, bf16_t* MIX) {
    const Frame F = relaunder(F0);
    LAS unsigned char* Kt = F.lds; LAS unsigned char* Vt = F.lds + 128 * RRS;
    const int lane = F.lane, r = lane & 15, g4 = lane >> 4, qq = r >> 2, pp = r & 3, w = F.wave;
    for (int u = F.bid; u < 512; u += F.G) {
        const int h = u & 3, n = (u >> 2) & 31, b = u >> 7, tok0 = b * SEQ + n * 128; const float lg2 = ret_lg2(h);
        for (int c = F.tid; c < 128 * 32; c += 512) { const int row = c >> 5, ch = c & 31; const bf16_t* src = H5 + (size_t)(tok0 + row) * EIN + 1024 + h * 256 + ch * 8;
            *(LAS u32x4*)(Kt + row * RRS + ch * 16) = *(const u32x4*)src; *(LAS u32x4*)(Vt + row * RRS + ch * 16) = *(const u32x4*)(src + 1024); }
        const int i = 16 * w + r;
        bf16x8 Qf[8];
        { const bf16_t* qp = H5 + (size_t)(tok0 + i) * EIN + h * 256 + 8 * g4;
#pragma unroll
          for (int kk = 0; kk < 8; ++kk) Qf[kk] = *(const bf16x8*)(qp + 32 * kk); }
        __syncthreads();
        u32x2 P[8];
#pragma unroll
        for (int tj = 0; tj < 8; ++tj) {
            P[tj] = (u32x2){0u, 0u};
            if (tj <= w) { f32x4 acc = (f32x4){0.f, 0.f, 0.f, 0.f}; const LAS unsigned char* kp = Kt + (16 * tj + r) * RRS + 16 * g4;
#pragma unroll
                for (int kk = 0; kk < 8; ++kk) acc = mfma16(*(const LAS bf16x8*)(kp + 64 * kk), Qf[kk], acc);
                float pv[4];
#pragma unroll
                for (int jj = 0; jj < 4; ++jj) { const int j = 16 * tj + 4 * g4 + jj; pv[jj] = (i >= j) ? acc[jj] * 0.0625f * __builtin_amdgcn_exp2f(lg2 * (float)(i - j)) : 0.f; }
                P[tj].x = pk2(pv[0], pv[1]); P[tj].y = pk2(pv[2], pv[3]); }
        }
        __syncthreads();
        f32x4 acc[16];
#pragma unroll
        for (int te = 0; te < 16; ++te) acc[te] = (f32x4){0.f, 0.f, 0.f, 0.f};
        if (n > 0) {
#pragma unroll
            for (int half = 0; half < 2; ++half) {
                for (int c = F.tid; c < 128 * 32; c += 512) { const int row = c >> 5, ch = c & 31;
                    *(LAS u32x4*)(Kt + row * RRS + ch * 16) = *(const u32x4*)(PREVT + (size_t)u * 65536 + (size_t)(128 * half + row) * 256 + ch * 8); }
                __syncthreads();
#pragma unroll
                for (int te = 0; te < 8; ++te) { const LAS unsigned char* pq = Kt + (16 * te + r) * RRS + 16 * g4;
#pragma unroll
                    for (int kk = 0; kk < 8; ++kk) acc[8 * half + te] = mfma16(*(const LAS bf16x8*)(pq + 64 * kk), Qf[kk], acc[8 * half + te]);
                    asm volatile("" : "+v"(acc[8 * half + te])); }
                __syncthreads();
            }
            const float xi = __builtin_amdgcn_exp2f(lg2 * (float)(i + 1));
#pragma unroll
            for (int te = 0; te < 16; ++te) acc[te] = acc[te] * xi;
        }
#pragma unroll
        for (int pr = 0; pr < 4; ++pr) {
            if (2 * pr <= w) { const u32x4 bw = (u32x4){P[2 * pr].x, P[2 * pr].y, P[2 * pr + 1].x, P[2 * pr + 1].y}; const bf16x8 bfrag = __builtin_bit_cast(bf16x8, bw);
                const LAS unsigned char* v0 = Vt + (32 * pr + 4 * g4 + qq) * RRS + 8 * pp;
#pragma unroll
                for (int te = 0; te < 16; ++te) { acc[te] = mfma16(cat8(vtr(v0 + 32 * te), vtr(v0 + 16 * RRS + 32 * te)), bfrag, acc[te]); if ((te & 3) == 3) asm volatile("" : "+v"(acc[te])); } }
        }
        float s = 0.f;
#pragma unroll
        for (int te = 0; te < 16; ++te) s += (acc[te][0] + acc[te][1]) + (acc[te][2] + acc[te][3]);
        s += __shfl_xor(s, 16); s += __shfl_xor(s, 32);
        const float mean = s * (1.f / 256.f); float s2 = 0.f;
#pragma unroll
        for (int te = 0; te < 16; ++te) { acc[te] = acc[te] - mean; s2 += (acc[te][0] * acc[te][0] + acc[te][1] * acc[te][1]) + (acc[te][2] * acc[te][2] + acc[te][3] * acc[te][3]); }
        s2 += __shfl_xor(s2, 16); s2 += __shfl_xor(s2, 32);
        const float rstd = 1.0f / sqrtf(s2 * (1.f / 256.f) + LN_EPS);
        const bf16_t* gp = H5 + (size_t)(tok0 + i) * EIN + 3072 + h * 256 + 4 * g4; bf16_t* op = MIX + (size_t)(tok0 + i) * D + h * 256 + 4 * g4;
#pragma unroll
        for (int te = 0; te < 16; ++te) { const u32x2 gw = *(const u32x2*)(gp + 16 * te); float gv[4] = {bflo(gw.x), bfhi(gw.x), bflo(gw.y), bfhi(gw.y)}; float ov[4];
#pragma unroll
            for (int jj = 0; jj < 4; ++jj) { const float sg = gv[jj] / (1.0f + __builtin_amdgcn_exp2f(-gv[jj] * LOG2E)); ov[jj] = sg * acc[te][jj] * rstd; }
            u32x2 o; o.x = pk2(ov[0], ov[1]); o.y = pk2(ov[2], ov[3]); *(u32x2*)(op + 16 * te) = o; }
        __syncthreads();
    }
}

__device__ __forceinline__ void gemm_res_ln(const Frame& F, const XcdBarrier& bar, const bf16_t* A, const bf16_t* Bt, int K, const float* xres, float* Y, float* XF, bf16_t* XB,
                                            const float* g, const float* b, unsigned char* ws, int inst, bool last) {
    pg8::Gemm gm{A, Bt, K, K, K, 0};
    if (F.G == 256) {
        pg8::PanelOrder S{F.bid};
        pg8::EpiResLn E{xres, last ? XF : nullptr, XB, g, b, (unsigned long long*)(ws + WS_XCH) + (size_t)inst * 131072, (unsigned*)(ws + WS_CTL) + CW_LN + inst * 4096, F.lds + 131072};
        pg8::gemm_phase<pg8::EpiResLn, pg8::PanelOrder, true>(F.lds, gm, S, E);
        xcd_barrier(bar);
    } else {
        pg8::StaticOrder S; S.init(M, D, F.G, F.bid);
        pg8::EpiRes E{xres ? xres : XF, Y};
        pg8::gemm_phase<pg8::EpiRes, pg8::StaticOrder, true>(F.lds, gm, S, E);
        xcd_barrier(bar);
        ln_phase(F, Y, g, b, XF, XB);
        xcd_barrier(bar);
    }
}

__global__ void __launch_bounds__(512, 2) fwd_megakernel(Args args) {
    extern __shared__ __attribute__((aligned(16))) unsigned char lds_raw[];
    cg::grid_group grid = cg::this_grid();
    Frame F; F.lds = (LAS unsigned char*)lds_raw; F.tid = threadIdx.x; F.lane = F.tid & 63; F.wave = __builtin_amdgcn_readfirstlane(F.tid >> 6); F.G = gridDim.x; F.bid = blockIdx.x;
    unsigned char* ws = args.ws;
    bf16_t* XB = (bf16_t*)(ws + WS_XB); float* Y = (float*)(ws + WS_Y); bf16_t* MIX = (bf16_t*)(ws + WS_MIX);
    float* HALO = (float*)(ws + WS_HF); bf16_t* ACT = (bf16_t*)(ws + WS_ACT); bf16_t* H5 = (bf16_t*)(ws + WS_H5); bf16_t* QKV = (bf16_t*)(ws + WS_QKV);
    bf16_t* KVT = (bf16_t*)(ws + WS_KVT); bf16_t* PREVT = (bf16_t*)(ws + WS_PREVT); bf16_t* POOLED = (bf16_t*)(ws + WS_POOLED);
    float* XF = args.out;

    for (int u = F.tid; u < (LDS_BYTES - MISC_OFF) / 4; u += 512) ((LAS unsigned*)(F.lds + MISC_OFF))[u] = 0u;
    __syncthreads();
    const XcdBarrier bar = xcd_barrier_post((unsigned*)(ws + WS_CTL), (volatile LAS unsigned*)(F.lds + MISC_OFF));
#define GRID_BAR() xcd_barrier(bar)

    for (int rep = 0; rep < EXP_REP_P0; ++rep) p0_prologue(F, args);
    grid.sync();

    for (int layer = 0; layer < 4; ++layer) {
        const int li = layer >> 1;
        const float* xres = (layer == 0) ? args.in[0] : nullptr;
        if ((layer & 1) == 0) {
            for (int rep = 0; rep < EXP_REP_INP; ++rep)
            {
                pg8::Gemm g{XB, (const bf16_t*)(ws + WS_EIN) + (size_t)li * EIN * D, D, D, D, 0}; pg8::StaticOrder S; S.init(M, EIN, F.G, F.bid);
                pg8::EpiBf16 E{H5, EIN, nullptr, nullptr, 0};
                pg8::gemm_phase<pg8::EpiBf16, pg8::StaticOrder, true>(F.lds, g, S, E);
            }
            GRID_BAR();
            for (int rep = 0; rep < EXP_REP_RET; ++rep) {
            ret_kv_phase(F, H5, KVT);
            pooled_phase(F, H5, POOLED);
            GRID_BAR();
            ret_scan_phase(F, KVT, PREVT);
            {
                pg8::Gemm g{POOLED, (const bf16_t*)(ws + WS_POOLW) + (size_t)li * 1024 * 256, 1024, 256, 256, 256}; pg8::StaticOrder S; S.init(M, 1024, F.G, F.bid);
                pg8::EpiBf16 E{MIX, D, nullptr, args.in[5] + (size_t)li * 1024, 1024};
                pg8::gemm_phase<pg8::EpiBf16, pg8::StaticOrder, true>(F.lds, g, S, E);
            }
            GRID_BAR();
            ret_out_phase(F, H5, PREVT, MIX);
            GRID_BAR();
            }
        } else {
            {
                pg8::Gemm g{XB, (const bf16_t*)(ws + WS_QKVW) + (size_t)li * OIN * D, D, D, D, 0}; pg8::StaticOrder S; S.init(M, OIN, F.G, F.bid);
                pg8::EpiBf16 E{QKV, OIN, args.in[8] + (size_t)li * OIN, nullptr, 0};
                pg8::gemm_phase<pg8::EpiBf16, pg8::StaticOrder, true>(F.lds, g, S, E);
            }
            GRID_BAR();
            for (int rep = 0; rep < EXP_REP_ATT; ++rep) {
            attn_phase(F, QKV, args.in[9] + li * 32, MIX);
            GRID_BAR();
            }
        }
        gemm_res_ln(F, bar, MIX, ((layer & 1) == 0) ? (const bf16_t*)(ws + WS_EOUT) + (size_t)li * D * D : (const bf16_t*)(ws + WS_AOUT) + (size_t)li * D * D, D, xres, Y, XF, XB,
                    args.in[1] + (size_t)(layer * 2 + 0) * D, args.in[2] + (size_t)(layer * 2 + 0) * D, ws, layer * 2 + 0, false);
        for (int rep = 0; rep < EXP_REP_F1; ++rep)
        {
            pg8::Gemm g{XB, (const bf16_t*)(ws + WS_F1) + (size_t)layer * FF2 * D, D, D, D, 0}; pg8::StaticOrder S; S.init(M, FF2, F.G, F.bid);
            pg8::EpiConvGlu E{ACT, HALO, args.in[12] + (size_t)layer * 3 * FF2, args.in[13] + (size_t)layer * FF2, (LAS float*)(F.lds + 131072)};
            pg8::gemm_phase<pg8::EpiConvGlu, pg8::StaticOrder, true>(F.lds, g, S, E);
        }
        GRID_BAR();
        if (F.G == 256) conv_fixup_own(F, HALO, args.in[12] + (size_t)layer * 3 * FF2, args.in[13] + (size_t)layer * FF2, ACT);
        else { conv_fixup_phase(F, HALO, args.in[12] + (size_t)layer * 3 * FF2, args.in[13] + (size_t)layer * FF2, ACT); GRID_BAR(); }
        gemm_res_ln(F, bar, ACT, (const bf16_t*)(ws + WS_F2) + (size_t)layer * D * FF, FF, nullptr, Y, XF, XB,
                    args.in[1] + (size_t)(layer * 2 + 1) * D, args.in[2] + (size_t)(layer * 2 + 1) * D, ws, layer * 2 + 1, layer == 3);
    }
}

extern "C" void kernel_launch(void* const* d_in, const int* in_sizes, int n_in, void* d_out, int out_size, void* d_ws, size_t ws_size, hipStream_t stream) {
    static int grid = 0;
    if (grid == 0) {
        if (n_in != 15 || out_size != M * D || ws_size < WS_END) { fprintf(stderr, "kernel_launch: unexpected problem: n_in %d out %d ws %zu (need %zu)\n", n_in, out_size, ws_size, (size_t)WS_END); grid = -1; return; }
        int dev = 0, cus = 0, per_cu = 0;
        hipGetDevice(&dev); hipDeviceGetAttribute(&cus, hipDeviceAttributeMultiprocessorCount, dev);
        if (hipFuncSetAttribute((const void*)fwd_megakernel, hipFuncAttributeMaxDynamicSharedMemorySize, LDS_BYTES) != hipSuccess) { fprintf(stderr, "kernel_launch: hipFuncSetAttribute failed\n"); grid = -1; return; }
        if (hipOccupancyMaxActiveBlocksPerMultiprocessor(&per_cu, (const void*)fwd_megakernel, 512, LDS_BYTES) != hipSuccess || per_cu < 1) { fprintf(stderr, "kernel_launch: occupancy query says %d\n", per_cu); per_cu = 1; }
        (void)hipGetLastError();
        grid = cus;
    }
    if (grid < 0) return;
    Args a{};
    for (int i = 0; i < 15; ++i) a.in[i] = (const float*)d_in[i];
    a.out = (float*)d_out; a.ws = (unsigned char*)d_ws;
    if (hipMemsetAsync((char*)d_ws + WS_CTL, 0, CTL_BYTES, stream) != hipSuccess) { fprintf(stderr, "kernel_launch: memset failed\n"); return; }
    void* kargs[] = {&a};
    hipError_t e = hipLaunchCooperativeKernel((const void*)fwd_megakernel, dim3(grid), dim3(512), kargs, LDS_BYTES, stream);
    if (e != hipSuccess) fprintf(stderr, "kernel_launch: cooperative launch failed: %s (grid %d)\n", hipGetErrorString(e), grid);
}
```

```cpp
#include <hip/hip_runtime.h>
#include <hip/hip_cooperative_groups.h>
#include <cstdio>
#include <cstdint>
namespace cg = cooperative_groups;
#ifndef EXP_REP_P0
#define EXP_REP_P0 1
#endif
#ifndef EXP_REP_RET
#define EXP_REP_RET 1
#endif
#ifndef EXP_REP_F1
#define EXP_REP_F1 1
#endif
#ifndef EXP_REP_INP
#define EXP_REP_INP 1
#endif
#ifndef EXP_REP_ATT
#define EXP_REP_ATT 1
#endif

#define LAS __attribute__((address_space(3)))
typedef unsigned short bf16_t;
typedef short bf16x8 __attribute__((ext_vector_type(8)));
typedef short s16x4 __attribute__((ext_vector_type(4)));
typedef float f32x4 __attribute__((ext_vector_type(4)));
typedef float f32x2 __attribute__((ext_vector_type(2)));
typedef unsigned u32x4 __attribute__((ext_vector_type(4)));
typedef unsigned u32x2 __attribute__((ext_vector_type(2)));
typedef __bf16 bf16x2_t __attribute__((ext_vector_type(2)));

constexpr int NBATCH = 4, SEQ = 4096, M = NBATCH * SEQ, D = 2048;
constexpr int EIN = 5120, OIN = 2560, FF = 5632, FF2 = 11264;
constexpr float ALPHA = 1.6817928305074290f;
constexpr float LN_EPS = 1e-5f;
constexpr float LOG2E = 1.4426950408889634f;

constexpr size_t MiB = 1u << 20;
constexpr size_t WS_EIN = 0 * MiB;
constexpr size_t WS_EOUT = 40 * MiB;
constexpr size_t WS_POOLW = 56 * MiB;
constexpr size_t WS_QKVW = 57 * MiB;
constexpr size_t WS_AOUT = 77 * MiB;
constexpr size_t WS_F1 = 93 * MiB;
constexpr size_t WS_F2 = 269 * MiB;
constexpr size_t WS_XB = 357 * MiB;
constexpr size_t WS_Y = 421 * MiB;
constexpr size_t WS_MIX = 549 * MiB;
constexpr size_t WS_BIG = 613 * MiB;
constexpr size_t WS_HF = WS_BIG;
constexpr size_t WS_ACT = WS_BIG + 352 * MiB;
constexpr size_t WS_H5 = WS_BIG;
constexpr size_t WS_QKV = WS_BIG;
constexpr size_t WS_KVT = WS_BIG + 160 * MiB;
constexpr size_t WS_PREVT = WS_BIG + 288 * MiB;
constexpr size_t WS_POOLED = WS_BIG + 352 * MiB;
constexpr size_t WS_CTL = 1141 * MiB;
constexpr size_t CTL_BYTES = 256 * 1024;
constexpr int CW_LN = 4096;
constexpr size_t WS_XCH = 1142 * MiB;
constexpr size_t WS_END = 1150 * MiB;
constexpr int MISC_OFF = 143360;

constexpr int LDS_BYTES = 147456;

__device__ __forceinline__ unsigned pk2(float lo, float hi) { f32x2 v = {lo, hi}; bf16x2_t b = __builtin_convertvector(v, bf16x2_t); return __builtin_bit_cast(unsigned, b); }
__device__ __forceinline__ float bflo(unsigned w) { return __uint_as_float(w << 16); }
__device__ __forceinline__ float bfhi(unsigned w) { return __uint_as_float(w & 0xffff0000u); }
__device__ __forceinline__ float wave_sum(float v) {
#pragma unroll
    for (int o = 1; o < 64; o <<= 1) v += __shfl_xor(v, o);
    return v;
}
typedef short v4i16_t __attribute__((ext_vector_type(4)));
__device__ __forceinline__ s16x4 vtr(const LAS unsigned char* p) { return __builtin_bit_cast(s16x4, __builtin_amdgcn_ds_read_tr16_b64_v4i16((LAS v4i16_t*)p)); }
__device__ __forceinline__ bf16x8 cat8(s16x4 lo, s16x4 hi) { return (bf16x8){lo[0], lo[1], lo[2], lo[3], hi[0], hi[1], hi[2], hi[3]}; }
__device__ __forceinline__ f32x4 mfma16(bf16x8 a, bf16x8 b, f32x4 c) { return __builtin_amdgcn_mfma_f32_16x16x32_bf16(a, b, c, 0, 0, 0); }
__device__ __forceinline__ f32x2 gelu_pk(f32x2 v) {
    const f32x2 av = __builtin_elementwise_abs(v), d = av * 0.2316418882f + 1.0f;
    f32x2 t; t.x = __builtin_amdgcn_rcpf(d.x); t.y = __builtin_amdgcn_rcpf(d.y);
    f32x2 q = t * 0.5307027145f + (-0.7265760135f); q = q * t + 0.7107068705f; q = q * t + (-0.142248368f); q = q * t + 0.127414796f; q = q * t;
    const f32x2 s = (v * v) * (-0.72134752044f);
    f32x2 e; e.x = __builtin_amdgcn_exp2f(s.x); e.y = __builtin_amdgcn_exp2f(s.y);
    const f32x2 m = v * (q * e), r = v - m;
    f32x2 o; o.x = v.x < 0.f ? m.x : r.x; o.y = v.y < 0.f ? m.y : r.y; return o;
}

namespace pg8 {
constexpr int BM = 256, BK = 64, HALF = 128, HTB = HALF * BK * 2, STAGE_BYTES = 8 * HTB, NXCD = 8, WGM = 8;
__host__ __device__ __forceinline__ int lds_byte(int r, int c) { const int st = (r >> 4) * 2 + (c >> 5), rr = r & 15, cc = c & 31, ob = rr * 64 + cc * 2; return st * 1024 + (ob ^ (((ob >> 9) & 1) << 5)); }
__host__ __device__ __forceinline__ void stage_rc(int b, int& R, int& C) { const int st = b / 1024, sb = b % 1024, swz = sb ^ (((sb >> 9) & 1) << 5); R = (st >> 1) * 16 + swz / 64; C = (st & 1) * 32 + (swz % 64) / 2; }
__host__ __device__ __forceinline__ int perm32(int rho) { const int n = rho >> 4, i = rho & 15; return 8 * (i >> 2) + 4 * n + (i & 3); }

struct Unit { int pm, pn; };
struct Gemm { const bf16_t* A; const bf16_t* Bt; int lda, ldb, K, a_pn_off; };

struct StaticOrder {
    int nM, nN, nwg, G, c;
    __device__ void init(int M_, int N_, int G_, int c_) { nM = M_ / BM; nN = N_ / BM; nwg = nM * nN; G = G_; c = c_; }
    __device__ bool next(int i, Unit& u) const {
        const long L = (long)i * G + c; if (L >= nwg) return false;
        int wgid = (int)L; { const int q = nwg / NXCD, r = nwg % NXCD, xcd = wgid % NXCD, off = wgid / NXCD; wgid = (xcd < r ? xcd * (q + 1) : r * (q + 1) + (xcd - r) * q) + off; }
        const int nig = WGM * nN, gid = wgid / nig, fm = gid * WGM, gsz = (nM - fm) < WGM ? (nM - fm) : WGM;
        u.pm = fm + ((wgid % nig) % gsz); u.pn = (wgid % nig) / gsz; return true;
    }
};

struct EpiBf16 {
    static constexpr bool PERM = true;
    bf16_t* O; int ldc; const float* bias; const float* scale; int ocol_off;
    __device__ __forceinline__ void operator()(f32x4 (&acc)[2][2][4][2], const Unit& u, int wr, int wc, int fr, int fq, int wid, int lane) const {
        const int row0 = u.pm * BM + wr * 64 + fr; const int bcol0 = u.pn * BM + wc * 32 + 8 * fq; const int col0 = ocol_off + bcol0;
        f32x4 bv[2][2], sv[2][2];
#pragma unroll
        for (int bj = 0; bj < 2; ++bj)
#pragma unroll
            for (int n = 0; n < 2; ++n) { bv[bj][n] = bias ? *(const f32x4*)(bias + bcol0 + bj * HALF + 4 * n) : (f32x4){0.f, 0.f, 0.f, 0.f};
                                          sv[bj][n] = scale ? *(const f32x4*)(scale + bcol0 + bj * HALF + 4 * n) : (f32x4){1.f, 1.f, 1.f, 1.f}; }
#pragma unroll
        for (int ai = 0; ai < 2; ++ai)
#pragma unroll
            for (int m = 0; m < 4; ++m) { bf16_t* rowp = O + (size_t)(row0 + ai * HALF + m * 16) * ldc + col0;
#pragma unroll
                for (int bj = 0; bj < 2; ++bj) { f32x4 v0 = (acc[ai][bj][m][0] + bv[bj][0]) * sv[bj][0], v1 = (acc[ai][bj][m][1] + bv[bj][1]) * sv[bj][1];
                    u32x4 w; w.x = pk2(v0[0], v0[1]); w.y = pk2(v0[2], v0[3]); w.z = pk2(v1[0], v1[1]); w.w = pk2(v1[2], v1[3]);
                    *(u32x4*)(rowp + bj * HALF) = w; } }
    }
};
struct EpiRes {
    static constexpr bool PERM = false;
    const float* X; float* Y;
    __device__ __forceinline__ void operator()(f32x4 (&acc)[2][2][4][2], const Unit& u, int wr, int wc, int fr, int fq, int wid, int lane) const {
        const int row0 = u.pm * BM + wr * 64 + fr, col0 = u.pn * BM + wc * 32 + 4 * fq;
#pragma unroll
        for (int ai = 0; ai < 2; ++ai)
#pragma unroll
            for (int m = 0; m < 4; ++m) { const size_t off = (size_t)(row0 + ai * HALF + m * 16) * D + col0;
#pragma unroll
                for (int bj = 0; bj < 2; ++bj)
#pragma unroll
                    for (int n = 0; n < 2; ++n) { const f32x4 xv = *(const f32x4*)(X + off + bj * HALF + n * 16); *(f32x4*)(Y + off + bj * HALF + n * 16) = xv * ALPHA + acc[ai][bj][m][n]; }
                asm volatile("" ::: "memory"); }
    }
};

__device__ __forceinline__ float dpp_ror1(float v) { return __int_as_float(__builtin_amdgcn_update_dpp(0, __float_as_int(v), 0x121, 0xf, 0xf, true)); }
__device__ __forceinline__ float dpp_ror2(float v) { return __int_as_float(__builtin_amdgcn_update_dpp(0, __float_as_int(v), 0x122, 0xf, 0xf, true)); }
struct EpiConvGlu {
    static constexpr bool PERM = true;
    bf16_t* ACT; float* HALO; const float* cw; const float* cb; LAS float* xbuf;
    __device__ __forceinline__ void operator()(f32x4 (&acc)[2][2][4][2], const Unit& u, int wr, int wc, int fr_, int fq_, int wid, int lane_) const {
        int lane = lane_; asm volatile("" : "+v"(lane));
        const int fr = lane & 15, fq = lane >> 4;
        const int cl = 32 * wc + 8 * fq;
        LAS float* wl = xbuf + 2048;
        {
            const int t = wid * 64 + lane, kind = t >> 6, pr = t & 63, bj = kind >> 2, tap = kind & 3;
            const float* src = (tap < 3) ? (cw + (size_t)tap * FF2 + bj * FF + u.pn * 128 + 2 * pr) : (cb + bj * FF + u.pn * 128 + 2 * pr);
            const f32x2 wv = *(const f32x2*)src;
            if (fr >= 14) {
                unsigned xo = (unsigned)(wr * 512 + (fr - 14) * 128 + cl) * 4u; asm volatile("" : "+v"(xo));
                LAS unsigned char* xb = (LAS unsigned char*)xbuf + xo;
#pragma unroll
                for (int ai = 0; ai < 2; ++ai)
#pragma unroll
                    for (int bj2 = 0; bj2 < 2; ++bj2)
#pragma unroll
                        for (int n = 0; n < 2; ++n) *(LAS f32x4*)(xb + (ai * 1024 + bj2 * 256 + 4 * n) * 4) = acc[ai][bj2][3][n];
            }
            if (wr == 0 && fr < 2) {
#pragma unroll
                for (int bj2 = 0; bj2 < 2; ++bj2)
#pragma unroll
                    for (int n = 0; n < 2; ++n) *(f32x4*)(HALO + (size_t)(u.pm * 4 + fr) * FF2 + u.pn * 256 + bj2 * 128 + cl + 4 * n) = acc[0][bj2][0][n];
            }
            if (wr == 1 && fr >= 14) {
#pragma unroll
                for (int bj2 = 0; bj2 < 2; ++bj2)
#pragma unroll
                    for (int n = 0; n < 2; ++n) *(f32x4*)(HALO + (size_t)(u.pm * 4 + fr - 12) * FF2 + u.pn * 256 + bj2 * 128 + cl + 4 * n) = acc[1][bj2][3][n];
            }
            *(LAS f32x2*)(wl + kind * 128 + 2 * pr) = wv;
        }
        asm volatile("s_waitcnt lgkmcnt(0)" ::: "memory"); __builtin_amdgcn_s_barrier(); asm volatile("" ::: "memory");
        const int row0 = u.pm * BM + wr * 64 + fr;
        const float k1a = fr >= 1 ? 1.f : 0.f, k1b = 1.f - k1a, k0a = fr >= 2 ? 1.f : 0.f, k0b = 1.f - k0a;
#pragma unroll
        for (int n = 0; n < 2; ++n)
#pragma unroll
            for (int bj = 0; bj < 2; ++bj) {
                const LAS float* wp = wl + bj * 512 + cl + 4 * n;
                const f32x4 t0 = *(const LAS f32x4*)wp, t1 = *(const LAS f32x4*)(wp + 128), w2 = *(const LAS f32x4*)(wp + 256), bb = *(const LAS f32x4*)(wp + 384);
                const f32x4 w1a = t1 * k1a, w1b = t1 * k1b, w0a = t0 * k0a, w0b = t0 * k0b;
#pragma unroll
                for (int ai = 0; ai < 2; ++ai) {
                    f32x4 r1p = (f32x4){0.f, 0.f, 0.f, 0.f}, r2p = r1p;
                    if (wr == 1 || ai == 1) { const int sai = (wr == 1) ? ai : 0, swr = (wr == 1) ? 0 : 1; const LAS float* xp = xbuf + (((sai * 2 + swr) * 2 + bj) * 2) * 128 + cl + 4 * n;
                        r1p = *(const LAS f32x4*)(xp + 128); r2p = *(const LAS f32x4*)(xp + (fr & 1) * 128); }
#pragma unroll
                    for (int m = 0; m < 4; ++m) {
                        const f32x4 cur = acc[ai][bj][m][n]; f32x4 r1, r2;
#pragma unroll
                        for (int j = 0; j < 4; ++j) { r1[j] = dpp_ror1(cur[j]); r2[j] = dpp_ror2(cur[j]); }
                        acc[ai][bj][m][n] = bb + w2 * cur + w1a * r1 + w0a * r2 + w1b * r1p + w0b * r2p;
                        r1p = r1; r2p = r2;
                        asm volatile("" : "+v"(acc[ai][bj][m][n]));
                    }
                }
            }
        const int ch = u.pn * 128 + cl;
#pragma unroll
        for (int ai = 0; ai < 2; ++ai)
#pragma unroll
            for (int m = 0; m < 4; ++m) {
                u32x4 o;
#pragma unroll
                for (int n = 0; n < 2; ++n) { const f32x4 gv = acc[ai][0][m][n], vv = acc[ai][1][m][n];
                    const f32x2 g0 = gelu_pk((f32x2){gv[0], gv[1]}), g1 = gelu_pk((f32x2){gv[2], gv[3]});
                    o[2 * n] = pk2(g0.x * vv[0], g0.y * vv[1]); o[2 * n + 1] = pk2(g1.x * vv[2], g1.y * vv[3]); }
                *(u32x4*)(ACT + (size_t)(row0 + ai * HALF + m * 16) * FF + ch) = o;
            }
    }
};

struct PanelOrder {
    int c;
    __device__ bool next(int i, Unit& u) const { if (i >= 2) return false; const int x = c & 7, j = c >> 3; u.pm = 32 * i + 4 * x + (j & 3); u.pn = j >> 2; return true; }
};
struct EpiResLn {
    static constexpr bool PERM = true;
    const float* X; float* XF; bf16_t* XB; const float* g; const float* b; unsigned long long* slots; unsigned* cnt; LAS unsigned char* tl;
    __device__ __forceinline__ void operator()(f32x4 (&acc)[2][2][4][2], const Unit& u, int wr, int wc, int fr, int fq, int wid, int lane) const {
        LAS f32x2* P = (LAS f32x2*)tl; LAS f32x2* S = (LAS f32x2*)(tl + 8192);
        const int row0 = u.pm * BM + wr * 64 + fr, col0 = u.pn * BM + wc * 32 + 8 * fq;
#pragma unroll
        for (int ai = 0; ai < 2; ++ai)
#pragma unroll
            for (int m = 0; m < 4; ++m) { const size_t off = (size_t)(row0 + ai * HALF + m * 16) * D + col0;
#pragma unroll
                for (int bj = 0; bj < 2; ++bj) { f32x4 x0, x1;
                    if (X) { x0 = *(const f32x4*)(X + off + bj * HALF); x1 = *(const f32x4*)(X + off + bj * HALF + 4); }
                    else { const u32x4 xw = *(const u32x4*)(XB + off + bj * HALF); x0 = (f32x4){bflo(xw.x), bfhi(xw.x), bflo(xw.y), bfhi(xw.y)}; x1 = (f32x4){bflo(xw.z), bfhi(xw.z), bflo(xw.w), bfhi(xw.w)}; }
                    acc[ai][bj][m][0] = x0 * ALPHA + acc[ai][bj][m][0]; acc[ai][bj][m][1] = x1 * ALPHA + acc[ai][bj][m][1]; }
                asm volatile("" : "+v"(acc[ai][0][m][0]), "+v"(acc[ai][0][m][1]), "+v"(acc[ai][1][m][0]), "+v"(acc[ai][1][m][1]));
                float s = 0.f;
#pragma unroll
                for (int bj = 0; bj < 2; ++bj)
#pragma unroll
                    for (int n = 0; n < 2; ++n) { const f32x4 x = acc[ai][bj][m][n]; s += (x[0] + x[1]) + (x[2] + x[3]); }
                s += __shfl_xor(s, 16); s += __shfl_xor(s, 32);
                const float mw = s * (1.0f / 64.0f); float q = 0.f;
#pragma unroll
                for (int bj = 0; bj < 2; ++bj)
#pragma unroll
                    for (int n = 0; n < 2; ++n) { const f32x4 d = acc[ai][bj][m][n] - mw; q += (d[0] * d[0] + d[1] * d[1]) + (d[2] * d[2] + d[3] * d[3]); }
                q += __shfl_xor(q, 16); q += __shfl_xor(q, 32);
                if (fq == 0) P[(ai * HALF + wr * 64 + m * 16 + fr) * 4 + wc] = (f32x2){mw, q};
            }
        asm volatile("s_waitcnt lgkmcnt(0)" ::: "memory"); __builtin_amdgcn_s_barrier(); asm volatile("" ::: "memory");
        const int row = wid * 32 + (lane & 31);
        unsigned long long* slot = slots + ((size_t)(u.pm * BM + row) * 8);
        if (lane < 32) {
            const f32x2 a = P[row * 4 + 0], b4 = P[row * 4 + 1], c = P[row * 4 + 2], d = P[row * 4 + 3];
            const float mt = (a.x + b4.x + c.x + d.x) * 0.25f;
            const float da = a.x - mt, db = b4.x - mt, dc = c.x - mt, dd = d.x - mt;
            const float m2 = (a.y + b4.y) + (c.y + d.y) + 64.0f * ((da * da + db * db) + (dc * dc + dd * dd));
            __hip_atomic_store(slot + u.pn, ((unsigned long long)__float_as_uint(m2) << 32) | __float_as_uint(mt), __ATOMIC_RELAXED, __HIP_MEMORY_SCOPE_AGENT);
        }
        asm volatile("s_waitcnt vmcnt(0)" ::: "memory");
        unsigned* cw = cnt + 64 * u.pm;
        if (lane == 0) __hip_atomic_fetch_add(cw, 1u, __ATOMIC_RELAXED, __HIP_MEMORY_SCOPE_AGENT);
        if (wid == 0) {
            unsigned sp = 0;
            while ((unsigned)__builtin_amdgcn_readfirstlane(__hip_atomic_load(cw, __ATOMIC_RELAXED, __HIP_MEMORY_SCOPE_AGENT)) < 64u) { __builtin_amdgcn_s_sleep(1); if (++sp > (1u << 24)) break; }
            __builtin_amdgcn_fence(__ATOMIC_ACQUIRE, "agent");
        }
        asm volatile("s_waitcnt vmcnt(0) lgkmcnt(0)" ::: "memory"); __builtin_amdgcn_s_barrier(); asm volatile("" ::: "memory");
        if (lane < 32) {
            float mt[8], m2[8]; float ms = 0.f;
#pragma unroll
            for (int t = 0; t < 8; ++t) { const unsigned long long w = __hip_atomic_load(slot + t, __ATOMIC_RELAXED, __HIP_MEMORY_SCOPE_AGENT); mt[t] = __uint_as_float((unsigned)w); m2[t] = __uint_as_float((unsigned)(w >> 32)); ms += mt[t]; }
            const float mean = ms * 0.125f; float q = 0.f;
#pragma unroll
            for (int t = 0; t < 8; ++t) { const float dm = mt[t] - mean; q += m2[t] + 256.0f * dm * dm; }
            S[row] = (f32x2){mean, 1.0f / sqrtf(q * (1.0f / 2048.0f) + LN_EPS)};
        }
        asm volatile("s_waitcnt lgkmcnt(0)" ::: "memory"); __builtin_amdgcn_s_barrier(); asm volatile("" ::: "memory");
#pragma unroll
        for (int bj = 0; bj < 2; ++bj) {
            const f32x4 g0 = *(const f32x4*)(g + col0 + bj * HALF), g1 = *(const f32x4*)(g + col0 + bj * HALF + 4), b0 = *(const f32x4*)(b + col0 + bj * HALF), b1 = *(const f32x4*)(b + col0 + bj * HALF + 4);
#pragma unroll
            for (int ai = 0; ai < 2; ++ai)
#pragma unroll
                for (int m = 0; m < 4; ++m) { const int r = ai * HALF + wr * 64 + m * 16 + fr; const f32x2 sr = S[r]; const size_t off = (size_t)(u.pm * BM + r) * D + col0 + bj * HALF;
                    const f32x4 o0 = (acc[ai][bj][m][0] - sr.x) * sr.y * g0 + b0, o1 = (acc[ai][bj][m][1] - sr.x) * sr.y * g1 + b1;
                    if (XF) { *(f32x4*)(XF + off) = o0; *(f32x4*)(XF + off + 4) = o1; }
                    u32x4 w; w.x = pk2(o0[0], o0[1]); w.y = pk2(o0[2], o0[3]); w.z = pk2(o1[0], o1[1]); w.w = pk2(o1[2], o1[3]); *(u32x4*)(XB + off) = w; } }
    }
};

template <class Epi, class Sched, bool ALIGN_EPI = true>
__device__ __forceinline__ void gemm_phase(LAS unsigned char* lds, const Gemm g, const Sched& S, const Epi& E) {
    int tid = threadIdx.x; asm volatile("" : "+v"(tid));
    const int wid = __builtin_amdgcn_readfirstlane(tid >> 6), lane = tid & 63, wr = wid >> 2, wc = wid & 3, fr = lane & 15, fq = lane >> 4;
    const int K = g.K, nt = K / BK;
    unsigned voffA[2], voffB[2];
#pragma unroll
    for (int i = 0; i < 2; ++i) { int R, C; stage_rc(tid * 16 + i * 8192, R, C); const int Rb = Epi::PERM ? ((R & ~31) + perm32(R & 31)) : R;
        voffA[i] = (unsigned)(R * g.lda + C) * 2u; voffB[i] = (unsigned)(Rb * g.ldb + C) * 2u; }
    const size_t kstep = (size_t)(BK * 2);
    const size_t hA = (size_t)HALF * g.lda * 2, hB = (size_t)HALF * g.ldb * 2;
    const unsigned ldsw = (unsigned)wid * 1024u;
    const int aoff = lds_byte(wr * 64 + fr, fq * 8), boff = lds_byte(wc * 32 + fr, fq * 8);
#define PG8_SA(b, h) (((b) * 2 + (h)) * HTB)
#define PG8_SB(b, h) ((4 + (b) * 2 + (h)) * HTB)
#define PG8_STAGE(bufoff, gbase, voff) do { _Pragma("unroll") for (int _i = 0; _i < 2; ++_i) \
        __builtin_amdgcn_global_load_lds((const unsigned*)((const char*)(gbase) + (voff)[_i]), (LAS unsigned*)(lds + (bufoff) + ldsw + _i * 8192), 16, 0, 0); } while (0)
#define PG8_LDA(dst, b, h) do { _Pragma("unroll") for (int m = 0; m < 4; ++m) _Pragma("unroll") for (int k = 0; k < 2; ++k) dst[m][k] = *(const LAS bf16x8*)(lds + PG8_SA(b, h) + aoff + m * 2048 + k * 1024); } while (0)
#define PG8_LDB(dst, b, h) do { _Pragma("unroll") for (int n = 0; n < 2; ++n) _Pragma("unroll") for (int k = 0; k < 2; ++k) dst[n][k] = *(const LAS bf16x8*)(lds + PG8_SB(b, h) + boff + n * 2048 + k * 1024); } while (0)
#define PG8_MMA(ai, bj, At, Bt) do { __builtin_amdgcn_s_setprio(1); _Pragma("unroll") for (int m = 0; m < 4; ++m) _Pragma("unroll") for (int n = 0; n < 2; ++n) _Pragma("unroll") for (int k = 0; k < 2; ++k) \
        acc[ai][bj][m][n] = __builtin_amdgcn_mfma_f32_16x16x32_bf16(Bt[n][k], At[m][k], acc[ai][bj][m][n], 0, 0, 0); __builtin_amdgcn_s_setprio(0); } while (0)
#define PG8_WAIT_V(n) asm volatile("s_waitcnt vmcnt(" #n ")" ::: "memory")
#define PG8_WAIT_L(n) asm volatile("s_waitcnt lgkmcnt(" #n ")" ::: "memory")
#define PG8_BAR __builtin_amdgcn_s_barrier()
#define PG8_SCHED __builtin_amdgcn_sched_barrier(0)
    Unit cur, nxt; int ui = 0;
    if (!S.next(0, cur)) return;
    f32x4 acc[2][2][4][2];
#pragma unroll
    for (int a = 0; a < 2; ++a)
#pragma unroll
        for (int b = 0; b < 2; ++b)
#pragma unroll
            for (int m = 0; m < 4; ++m)
#pragma unroll
                for (int n = 0; n < 2; ++n) acc[a][b][m][n] = (f32x4){0.f, 0.f, 0.f, 0.f};
    bf16x8 At[4][2], B0[2][2], B1[2][2];
    const char* cA = (const char*)g.A + ((size_t)cur.pm * BM * g.lda + (size_t)cur.pn * g.a_pn_off) * 2; const char* cB = (const char*)g.Bt + (size_t)cur.pn * BM * g.ldb * 2;
    PG8_STAGE(PG8_SB(0, 0), cB, voffB); PG8_STAGE(PG8_SB(0, 1), cB + hB, voffB); PG8_STAGE(PG8_SA(0, 0), cA, voffA); PG8_STAGE(PG8_SA(0, 1), cA + hA, voffA);
    if (wr == 1) PG8_BAR;
    PG8_WAIT_V(2); PG8_BAR;
    PG8_STAGE(PG8_SB(1, 0), cB + kstep, voffB); PG8_STAGE(PG8_SA(1, 0), cA + kstep, voffA); PG8_STAGE(PG8_SB(1, 1), cB + hB + kstep, voffB);
    PG8_WAIT_V(6); PG8_BAR;
    for (;;) {
        const bool has_next = S.next(ui + 1, nxt);
        const char* nA = has_next ? (const char*)g.A + ((size_t)nxt.pm * BM * g.lda + (size_t)nxt.pn * g.a_pn_off) * 2 : cA; const char* nB = has_next ? (const char*)g.Bt + (size_t)nxt.pn * BM * g.ldb * 2 : cB;
        for (int t = 0; t < nt; t += 2) {
            const bool last = (t == nt - 2);
            const char* a1 = cA + (size_t)(t + 1) * kstep;
            const char* a2 = last ? nA : cA + (size_t)(t + 2) * kstep; const char* b2 = last ? nB : cB + (size_t)(t + 2) * kstep;
            const char* a3 = a2 + kstep; const char* b3 = b2 + kstep;
            PG8_LDB(B0, 0, 0); PG8_LDB(B1, 0, 1); PG8_SCHED; PG8_LDA(At, 0, 0); PG8_STAGE(PG8_SA(1, 1), a1 + hA, voffA);
            PG8_WAIT_V(8); PG8_WAIT_L(0); PG8_BAR; PG8_MMA(0, 0, At, B0); PG8_MMA(0, 1, At, B1); PG8_BAR; PG8_SCHED;
            PG8_LDA(At, 0, 1); PG8_STAGE(PG8_SB(0, 0), b2, voffB); PG8_STAGE(PG8_SB(0, 1), b2 + hB, voffB); PG8_STAGE(PG8_SA(0, 0), a2, voffA);
            PG8_WAIT_V(8); PG8_WAIT_L(0); PG8_BAR; PG8_MMA(1, 0, At, B0); PG8_MMA(1, 1, At, B1); PG8_BAR; PG8_SCHED;
            PG8_LDB(B0, 1, 0); PG8_LDB(B1, 1, 1); PG8_SCHED; PG8_LDA(At, 1, 0); PG8_STAGE(PG8_SA(0, 1), a2 + hA, voffA);
            PG8_WAIT_V(8); PG8_WAIT_L(0); PG8_BAR; PG8_MMA(0, 0, At, B0); PG8_MMA(0, 1, At, B1); PG8_BAR; PG8_SCHED;
            PG8_LDA(At, 1, 1); PG8_STAGE(PG8_SB(1, 0), b3, voffB); PG8_STAGE(PG8_SB(1, 1), b3 + hB, voffB); PG8_STAGE(PG8_SA(1, 0), a3, voffA);
            PG8_WAIT_V(8); PG8_WAIT_L(0); PG8_BAR; PG8_MMA(1, 0, At, B0); PG8_MMA(1, 1, At, B1); PG8_BAR; PG8_SCHED;
        }
        if constexpr (ALIGN_EPI) { if (wr == 0) PG8_BAR; }
        E(acc, cur, wr, wc, fr, fq, wid, lane);
        if (!has_next) break;
#pragma unroll
        for (int a = 0; a < 2; ++a)
#pragma unroll
            for (int b = 0; b < 2; ++b)
#pragma unroll
                for (int m = 0; m < 4; ++m)
#pragma unroll
                    for (int n = 0; n < 2; ++n) acc[a][b][m][n] = (f32x4){0.f, 0.f, 0.f, 0.f};
        cur = nxt; cA = nA; cB = nB; ++ui;
        if constexpr (ALIGN_EPI) { if (wr == 1) PG8_BAR; }
    }
    PG8_WAIT_V(0);
    if constexpr (!ALIGN_EPI) { if (wr == 0) PG8_BAR; }
    PG8_BAR;
#undef PG8_SA
#undef PG8_SB
#undef PG8_STAGE
#undef PG8_LDA
#undef PG8_LDB
#undef PG8_MMA
#undef PG8_WAIT_V
#undef PG8_WAIT_L
#undef PG8_BAR
#undef PG8_SCHED
}
}

#define XB_TMO      128
#define XB_XCNT(j)  (256  + 64 * (j))
#define XB_XSUB(j)  (1280 + 64 * (j))
#define XB_XGEN(j)  (2304 + 64 * (j))
#define XB_TOP      3328
#define XB_TOPGEN   3392
#define XCD_BAR_WORDS 3456
#define XB_SPIN_CAP (1u << 22)
__device__ __forceinline__ unsigned xb_ld(unsigned* p)              { return __hip_atomic_load(p, __ATOMIC_RELAXED, __HIP_MEMORY_SCOPE_AGENT); }
__device__ __forceinline__ unsigned xb_add(unsigned* p, unsigned v) { return __hip_atomic_fetch_add(p, v, __ATOMIC_RELAXED, __HIP_MEMORY_SCOPE_AGENT); }
__device__ __forceinline__ unsigned xb_xcc_id() { return (unsigned)__builtin_amdgcn_s_getreg((3 << 11) | 20) & 0xFu; }
#define XB_SPIN(cond, bar) do { unsigned _sp = 0; while (cond) { __builtin_amdgcn_s_sleep(1); \
    if ((++_sp & 255u) == 0u) { if (xb_ld(&(bar)[XB_TMO])) break; if (_sp > XB_SPIN_CAP) { atomicAdd(&(bar)[XB_TMO], 1u); break; } } } } while (0)
struct XcdBarrier { unsigned* bar; unsigned x; volatile LAS unsigned* st; };
__device__ __forceinline__ XcdBarrier xcd_barrier_post(unsigned* bar, volatile LAS unsigned* st) {
    XcdBarrier b; b.bar = bar; b.x = xb_xcc_id(); b.st = st;
    if (threadIdx.x == 0) (void)xb_add(&bar[XB_XCNT(b.x)], 1u);
    return b;
}
__device__ __forceinline__ void xcd_barrier_complete(unsigned* bar, unsigned x, unsigned& nloc, unsigned& nx) {
    const unsigned G = gridDim.x * gridDim.y * gridDim.z;
    unsigned sum, cnt, mine, sp = 0u;
    for (;;) {
        sum = 0u; cnt = 0u; mine = 0u;
#pragma unroll
        for (unsigned j = 0; j < 16; ++j) { const unsigned c = xb_ld(&bar[XB_XCNT(j)]); sum += c; cnt += (c > 0u) ? 1u : 0u; mine = (j == x) ? c : mine; }
        if (sum == G) break;
        __builtin_amdgcn_s_sleep(1);
        if ((++sp & 255u) == 0u) { if (xb_ld(&bar[XB_TMO])) break; if (sp > XB_SPIN_CAP) { atomicAdd(&bar[XB_TMO], 1u); break; } }
    }
    nloc = mine > 0u ? mine : 1u; nx = cnt > 0u ? cnt : 1u;
}
__device__ __forceinline__ void xcd_barrier(const XcdBarrier& b) {
    asm volatile("s_waitcnt vmcnt(0)" ::: "memory");
    __syncthreads();
    if (threadIdx.x == 0) {
        unsigned* bar = b.bar;
        __builtin_amdgcn_s_waitcnt(0);
        unsigned nloc = b.st[0], nx = b.st[1];
        if (nloc == 0u) { xcd_barrier_complete(bar, b.x, nloc, nx); b.st[0] = nloc; b.st[1] = nx; }
        const unsigned old = xb_add(&bar[XB_XSUB(b.x)], 1u);
        const unsigned gen = old / nloc;
        if (old + 1u == (gen + 1u) * nloc) {
            __builtin_amdgcn_fence(__ATOMIC_RELEASE, "agent");
            asm volatile("s_waitcnt vmcnt(0)" ::: "memory");
            const unsigned og = xb_add(&bar[XB_TOP], 1u);
            const unsigned tg = og / nx;
            if (og + 1u == (tg + 1u) * nx) xb_add(&bar[XB_TOPGEN], 1u);
            else XB_SPIN(xb_ld(&bar[XB_TOPGEN]) == tg, bar);
            __builtin_amdgcn_fence(__ATOMIC_ACQUIRE, "agent");
            xb_add(&bar[XB_XGEN(b.x)], 1u);
            asm volatile("s_waitcnt vmcnt(0)" ::: "memory");
        } else {
            XB_SPIN(xb_ld(&bar[XB_XGEN(b.x)]) == gen, bar);
            __builtin_amdgcn_fence(__ATOMIC_ACQUIRE, "agent");
            asm volatile("s_waitcnt vmcnt(0)" ::: "memory");
        }
    }
    __syncthreads();
}

struct Args { const float* in[15]; float* out; unsigned char* ws; };
struct Frame { LAS unsigned char* lds; int tid, lane, wave, G, bid; };
__device__ __forceinline__ Frame relaunder(const Frame& F0) { Frame F = F0; int t = F0.tid; asm volatile("" : "+v"(t)); F.tid = t; F.lane = t & 63; F.wave = __builtin_amdgcn_readfirstlane(t >> 6); return F; }

__device__ __forceinline__ void p0_item(const float* W, int K, int N, bf16_t* WT, int row_off, bool permff, LAS float* scr, int item, int lane) {
    const int nblk = N >> 6, kb = item / nblk, nb = item - kb * nblk, k0 = kb << 6, n0 = nb << 6;
    const float* src = W + (size_t)k0 * N + n0 + lane;
#pragma unroll 16
    for (int kk = 0; kk < 64; ++kk) scr[kk * 65 + lane] = src[(size_t)kk * N];
    asm volatile("s_waitcnt lgkmcnt(0)" ::: "memory");
    int orow0 = row_off + n0;
    if (permff) { orow0 = (n0 < FF) ? ((n0 >> 7) * 256 + (n0 & 127)) : (((n0 - FF) >> 7) * 256 + 128 + ((n0 - FF) & 127)); }
#pragma unroll
    for (int j = 0; j < 8; ++j) { const int id = lane + 64 * j, n = id >> 3, c = id & 7; const LAS float* s = scr + (8 * c) * 65 + n;
        u32x4 o; o.x = pk2(s[0 * 65], s[1 * 65]); o.y = pk2(s[2 * 65], s[3 * 65]); o.z = pk2(s[4 * 65], s[5 * 65]); o.w = pk2(s[6 * 65], s[7 * 65]);
        *(u32x4*)(WT + (size_t)(orow0 + n) * K + k0 + 8 * c) = o; }
    asm volatile("s_waitcnt lgkmcnt(0)" ::: "memory");
}
__device__ __forceinline__ void p0_prologue(const Frame& F0, const Args& a) {
    const Frame F = relaunder(F0);
    LAS float* scr = (LAS float*)(F.lds + F.wave * 16640);
    const int gw = F.bid * 8 + F.wave, NGW = F.G * 8;
    unsigned char* ws = a.ws;
    constexpr int I_EIN = (D / 64) * (EIN / 64), I_SQ = (D / 64) * (D / 64), I_PW = 16, I_QKV = (D / 64) * (OIN / 64), I_F1 = (D / 64) * (FF2 / 64), I_F2 = (FF / 64) * (D / 64);
    constexpr int T0 = 2 * I_EIN, T1 = T0 + 2 * I_SQ, T2 = T1 + 8 * I_PW, T3 = T2 + 2 * I_QKV, T4 = T3 + 2 * I_SQ, T5 = T4 + 4 * I_F1, T6 = T5 + 4 * I_F2;
    for (int it = gw; it < T6; it += NGW) {
        if (it < T0) { const int li = it / I_EIN, r = it - li * I_EIN; p0_item(a.in[3] + (size_t)li * D * EIN, D, EIN, (bf16_t*)(ws + WS_EIN) + (size_t)li * EIN * D, 0, false, scr, r, F.lane); }
        else if (it < T1) { const int x = it - T0, li = x / I_SQ, r = x - li * I_SQ; p0_item(a.in[6] + (size_t)li * D * D, D, D, (bf16_t*)(ws + WS_EOUT) + (size_t)li * D * D, 0, false, scr, r, F.lane); }
        else if (it < T2) { const int x = it - T1, lg = x / I_PW, r = x - lg * I_PW, li = lg >> 2, g = lg & 3; p0_item(a.in[4] + (size_t)lg * 65536, 256, 256, (bf16_t*)(ws + WS_POOLW) + (size_t)li * 1024 * 256, g * 256, false, scr, r, F.lane); }
        else if (it < T3) { const int x = it - T2, li = x / I_QKV, r = x - li * I_QKV; p0_item(a.in[7] + (size_t)li * D * OIN, D, OIN, (bf16_t*)(ws + WS_QKVW) + (size_t)li * OIN * D, 0, false, scr, r, F.lane); }
        else if (it < T4) { const int x = it - T3, li = x / I_SQ, r = x - li * I_SQ; p0_item(a.in[10] + (size_t)li * D * D, D, D, (bf16_t*)(ws + WS_AOUT) + (size_t)li * D * D, 0, false, scr, r, F.lane); }
        else if (it < T5) { const int x = it - T4, l = x / I_F1, r = x - l * I_F1; p0_item(a.in[11] + (size_t)l * D * FF2, D, FF2, (bf16_t*)(ws + WS_F1) + (size_t)l * FF2 * D, 0, true, scr, r, F.lane); }
        else { const int x = it - T5, l = x / I_F2, r = x - l * I_F2; p0_item(a.in[14] + (size_t)l * FF * D, FF, D, (bf16_t*)(ws + WS_F2) + (size_t)l * D * FF, 0, false, scr, r, F.lane); }
    }
    const f32x4* x4 = (const f32x4*)a.in[0]; u32x2* xb = (u32x2*)(ws + WS_XB);
    for (size_t i = (size_t)F.bid * 512 + F.tid; i < (size_t)M * D / 4; i += (size_t)F.G * 512) { const f32x4 v = x4[i]; u32x2 o; o.x = pk2(v[0], v[1]); o.y = pk2(v[2], v[3]); xb[i] = o; }
}

__device__ __forceinline__ void ln_phase(const Frame& F0, const float* Y, const float* g, const float* b, float* XF, bf16_t* XB) {
    const Frame F = relaunder(F0);
    const int gw = F.bid * 8 + F.wave, NGW = F.G * 8;
    for (int row = gw; row < M; row += NGW) {
        const f32x4* yr = (const f32x4*)(Y + (size_t)row * D) + F.lane;
        f32x4 v[8]; float s = 0.f;
#pragma unroll
        for (int j = 0; j < 8; ++j) { v[j] = yr[64 * j]; s += (v[j][0] + v[j][1]) + (v[j][2] + v[j][3]); }
        const float mean = wave_sum(s) * (1.f / D); float s2 = 0.f;
#pragma unroll
        for (int j = 0; j < 8; ++j) { v[j] = v[j] - mean; s2 += (v[j][0] * v[j][0] + v[j][1] * v[j][1]) + (v[j][2] * v[j][2] + v[j][3] * v[j][3]); }
        const float rstd = 1.0f / sqrtf(wave_sum(s2) * (1.f / D) + LN_EPS);
        f32x4* xo = (f32x4*)(XF + (size_t)row * D) + F.lane; u32x2* bo = (u32x2*)(XB + (size_t)row * D) + F.lane;
#pragma unroll
        for (int j = 0; j < 8; ++j) { const f32x4 gg = ((const f32x4*)g)[F.lane + 64 * j], bb = ((const f32x4*)b)[F.lane + 64 * j];
            const f32x4 o = v[j] * rstd * gg + bb; xo[64 * j] = o; u32x2 w; w.x = pk2(o[0], o[1]); w.y = pk2(o[2], o[3]); bo[64 * j] = w; }
    }
}

__device__ __forceinline__ void conv_fixup_item(int pm, int cq, const float* HALO, const float* cw, const float* cb, bf16_t* ACT) {
    const int c = cq * 4, col = (c >> 7) * 256 + (c & 127);
    f32x4 cv[2][2];
#pragma unroll
    for (int bj = 0; bj < 2; ++bj) {
        const float* hp = HALO + (size_t)(pm * 4) * FF2 + col + bj * 128;
        const f32x4 hm2 = *(const f32x4*)(hp - 2 * FF2), hm1 = *(const f32x4*)(hp - FF2), h0 = *(const f32x4*)hp, h1 = *(const f32x4*)(hp + FF2);
        const f32x4 w0 = *(const f32x4*)(cw + bj * FF + c), w1 = *(const f32x4*)(cw + (size_t)FF2 + bj * FF + c), w2 = *(const f32x4*)(cw + (size_t)2 * FF2 + bj * FF + c), b = *(const f32x4*)(cb + bj * FF + c);
        cv[bj][0] = b + w0 * hm2 + w1 * hm1 + w2 * h0; cv[bj][1] = b + w0 * hm1 + w1 * h0 + w2 * h1;
    }
#pragma unroll
    for (int rr = 0; rr < 2; ++rr) { const f32x2 g0 = gelu_pk((f32x2){cv[0][rr][0], cv[0][rr][1]}), g1 = gelu_pk((f32x2){cv[0][rr][2], cv[0][rr][3]});
        u32x2 o; o.x = pk2(g0.x * cv[1][rr][0], g0.y * cv[1][rr][1]); o.y = pk2(g1.x * cv[1][rr][2], g1.y * cv[1][rr][3]);
        *(u32x2*)(ACT + (size_t)(pm * 256 + rr) * FF + c) = o; }
}
__device__ __forceinline__ void conv_fixup_phase(const Frame& F0, const float* HALO, const float* cw, const float* cb, bf16_t* ACT) {
    const Frame F = relaunder(F0);
    constexpr int NCQ = FF / 4;
    for (int it = F.bid * 512 + F.tid; it < 64 * NCQ; it += F.G * 512) { const int pm = it / NCQ, cq = it - pm * NCQ; if ((pm & 15) == 0) continue; conv_fixup_item(pm, cq, HALO, cw, cb, ACT); }
}
__device__ __forceinline__ void conv_fixup_own(const Frame& F0, const float* HALO, const float* cw, const float* cb, bf16_t* ACT) {
    const Frame F = relaunder(F0);
    constexpr int NCQ = FF / 4;
    const int x = F.bid & 7, j = F.bid >> 3;
#pragma unroll 1
    for (int i = 0; i < 2; ++i) { const int pm = 32 * i + 4 * x + (j & 3); if ((pm & 15) == 0) continue;
        for (int cq = F.tid; cq < NCQ; cq += 512) conv_fixup_item(pm, cq, HALO, cw, cb, ACT); }
    asm volatile("s_waitcnt vmcnt(0)" ::: "memory"); __syncthreads();
}

__device__ __forceinline__ void attn_phase(const Frame& F0, const bf16_t* QKV, const float* sinks, bf16_t* MIX) {
    const Frame F = relaunder(F0);
    constexpr int RS = 144;
    LAS unsigned char* Kt = F.lds; LAS unsigned char* Vt = F.lds + 256 * RS;
    const int lane = F.lane, r = lane & 15, g4 = lane >> 4, qq = r >> 2, pp = r & 3;
    for (int u = F.bid; u < 512; u += F.G) {
        const int kvh = u & 3, n = (u >> 2) & 31, b = u >> 7, tok0 = b * SEQ + n * 128;
        for (int c = F.tid; c < 256 * 8; c += 512) { const int row = c >> 3, ch = c & 7; const bool valid = (n > 0) || (row >= 128);
            u32x4 kv = (u32x4){0u, 0u, 0u, 0u}, vv = kv;
            if (valid) { const bf16_t* src = QKV + (size_t)(tok0 - 128 + row) * OIN + 2048 + kvh * 64 + ch * 8; kv = *(const u32x4*)src; vv = *(const u32x4*)(src + 256); }
            *(LAS u32x4*)(Kt + row * RS + ch * 16) = kv; *(LAS u32x4*)(Vt + row * RS + ch * 16) = vv; }
        __syncthreads();
        const int head = kvh * 8 + F.wave;
        const float slope2 = __builtin_amdgcn_exp2f(-0.25f * (float)(head + 1)) * LOG2E, sink2 = sinks[head] * LOG2E;
        for (int rb = 0; rb < 8; ++rb) {
            const bf16_t* qp = QKV + (size_t)(tok0 + 16 * rb + r) * OIN + head * 64 + 8 * g4;
            const bf16x8 q0 = *(const bf16x8*)qp, q1 = *(const bf16x8*)(qp + 32);
            f32x4 s[9];
            __builtin_amdgcn_s_setprio(1);
#pragma unroll
            for (int tt = 0; tt < 9; ++tt) { const LAS unsigned char* kp = Kt + (16 * (rb + tt) + r) * RS + 16 * g4;
                f32x4 acc = (f32x4){0.f, 0.f, 0.f, 0.f};
                acc = mfma16(*(const LAS bf16x8*)kp, q0, acc); acc = mfma16(*(const LAS bf16x8*)(kp + 64), q1, acc); s[tt] = acc; }
            __builtin_amdgcn_s_setprio(0);
            const int i = 16 * rb + r; float mx = -INFINITY;
#pragma unroll
            for (int tt = 0; tt < 9; ++tt)
#pragma unroll
                for (int jj = 0; jj < 4; ++jj) { const int j = 16 * (rb + tt) + 4 * g4 + jj, delta = 128 + i - j; const bool valid = (delta >= 0) && (delta < 128) && ((n > 0) || (j >= 128));
                    const float v = s[tt][jj] * (0.125f * LOG2E) - slope2 * (float)delta; s[tt][jj] = valid ? v : -INFINITY; mx = fmaxf(mx, s[tt][jj]); }
            mx = fmaxf(mx, __shfl_xor(mx, 16)); mx = fmaxf(mx, __shfl_xor(mx, 32)); mx = fmaxf(mx, sink2);
            float sum = 0.f;
#pragma unroll
            for (int tt = 0; tt < 9; ++tt)
#pragma unroll
                for (int jj = 0; jj < 4; ++jj) { const float p = __builtin_amdgcn_exp2f(s[tt][jj] - mx); s[tt][jj] = p; sum += p; }
            sum += __shfl_xor(sum, 16); sum += __shfl_xor(sum, 32);
            const float inv = 1.0f / (sum + __builtin_amdgcn_exp2f(sink2 - mx));
            u32x2 P[10];
#pragma unroll
            for (int tt = 0; tt < 9; ++tt) { P[tt].x = pk2(s[tt][0] * inv, s[tt][1] * inv); P[tt].y = pk2(s[tt][2] * inv, s[tt][3] * inv); }
            P[9] = (u32x2){0u, 0u};
            f32x4 o[4];
#pragma unroll
            for (int te = 0; te < 4; ++te) o[te] = (f32x4){0.f, 0.f, 0.f, 0.f};
            __builtin_amdgcn_s_setprio(1);
#pragma unroll
            for (int pr = 0; pr < 5; ++pr) { const int t0 = 2 * pr, t1 = (pr < 4) ? 2 * pr + 1 : 2 * pr;
                const u32x4 bw = (u32x4){P[t0].x, P[t0].y, P[2 * pr + 1].x, P[2 * pr + 1].y}; const bf16x8 bfrag = __builtin_bit_cast(bf16x8, bw);
                const LAS unsigned char* v0 = Vt + (16 * (rb + t0) + 4 * g4 + qq) * RS + 8 * pp; const LAS unsigned char* v1 = Vt + (16 * (rb + t1) + 4 * g4 + qq) * RS + 8 * pp;
#pragma unroll
                for (int te = 0; te < 4; ++te) o[te] = mfma16(cat8(vtr(v0 + 32 * te), vtr(v1 + 32 * te)), bfrag, o[te]); }
            __builtin_amdgcn_s_setprio(0);
            bf16_t* op = MIX + (size_t)(tok0 + i) * D + head * 64 + 4 * g4;
#pragma unroll
            for (int te = 0; te < 4; ++te) { u32x2 w; w.x = pk2(o[te][0], o[te][1]); w.y = pk2(o[te][2], o[te][3]); *(u32x2*)(op + 16 * te) = w; }
        }
        __syncthreads();
    }
}

__device__ __forceinline__ float ret_lg2(int h) { return __builtin_amdgcn_logf(1.0f - __builtin_amdgcn_exp2f(-5.0f - (float)h)); }
constexpr int RRS = 528;

__device__ __forceinline__ void ret_kv_phase(const Frame& F0, const bf16_t* H5, bf16_t* KVT) {
    const Frame F = relaunder(F0);
    LAS unsigned char* Kt = F.lds; LAS unsigned char* Vt = F.lds + 128 * RRS;
    const int lane = F.lane, r = lane & 15, g4 = lane >> 4, qq = r >> 2, pp = r & 3, w = F.wave;
    for (int u = F.bid; u < 512; u += F.G) {
        const int h = u & 3, n = (u >> 2) & 31, b = u >> 7, tok0 = b * SEQ + n * 128; const float lg2 = ret_lg2(h);
        for (int c = F.tid; c < 128 * 32; c += 512) { const int row = c >> 5, ch = c & 31; const bf16_t* src = H5 + (size_t)(tok0 + row) * EIN + 1024 + h * 256 + ch * 8;
            const u32x4 kv = *(const u32x4*)src, vv = *(const u32x4*)(src + 1024); const float z = __builtin_amdgcn_exp2f(lg2 * (float)(127 - row)) * 0.0625f;
            u32x4 ks;
#pragma unroll
            for (int e = 0; e < 4; ++e) ks[e] = pk2(bflo(kv[e]) * z, bfhi(kv[e]) * z);
            *(LAS u32x4*)(Kt + row * RRS + ch * 16) = ks; *(LAS u32x4*)(Vt + row * RRS + ch * 16) = vv; }
        __syncthreads();
        for (int dh = 0; dh < 2; ++dh) {
            f32x4 acc[2][8];
#pragma unroll
            for (int a = 0; a < 2; ++a)
#pragma unroll
                for (int d = 0; d < 8; ++d) acc[a][d] = (f32x4){0.f, 0.f, 0.f, 0.f};
            __builtin_amdgcn_s_setprio(1);
#pragma unroll
            for (int ks = 0; ks < 4; ++ks) { const int R0 = 32 * ks + 8 * g4 + qq;
                const LAS unsigned char* vb = Vt + R0 * RRS + 8 * pp; const LAS unsigned char* kb = Kt + R0 * RRS + 8 * pp + 256 * dh;
                const bf16x8 vf0 = cat8(vtr(vb + 64 * w), vtr(vb + 4 * RRS + 64 * w)), vf1 = cat8(vtr(vb + 64 * w + 32), vtr(vb + 4 * RRS + 64 * w + 32));
#pragma unroll
                for (int dt = 0; dt < 8; ++dt) { const bf16x8 kf = cat8(vtr(kb + 32 * dt), vtr(kb + 4 * RRS + 32 * dt)); acc[0][dt] = mfma16(kf, vf0, acc[0][dt]); acc[1][dt] = mfma16(kf, vf1, acc[1][dt]); } }
            __builtin_amdgcn_s_setprio(0);
            bf16_t* op = KVT + (size_t)u * 65536 + (size_t)(32 * w + r) * 256 + 128 * dh + 4 * g4;
#pragma unroll
            for (int a = 0; a < 2; ++a)
#pragma unroll
                for (int dt = 0; dt < 8; ++dt) { u32x2 o; o.x = pk2(acc[a][dt][0], acc[a][dt][1]); o.y = pk2(acc[a][dt][2], acc[a][dt][3]); *(u32x2*)(op + a * 16 * 256 + 16 * dt) = o; }
        }
        __syncthreads();
    }
}
__device__ __forceinline__ void pooled_phase(const Frame& F0, const bf16_t* H5, bf16_t* PO) {
    const Frame F = relaunder(F0);
    for (int it = F.bid * 512 + F.tid; it < 1024 * 128; it += F.G * 512) {
        const int cgp = it & 127, run = it >> 7, c = cgp * 8, w = 2 << (c >> 8), t0 = run * 16, p0 = t0 & (SEQ - 1);
        const bf16_t* U = H5 + 4096 + c;
        float S[8];
#pragma unroll
        for (int e = 0; e < 8; ++e) S[e] = 0.f;
        for (int s = 1; s < w; ++s) if (p0 - s >= 0) { const u32x4 x = *(const u32x4*)(U + (size_t)(t0 - s) * EIN);
#pragma unroll
            for (int e = 0; e < 4; ++e) { S[2 * e] += bflo(x[e]); S[2 * e + 1] += bfhi(x[e]); } }
        for (int k = 0; k < 16; ++k) { const int t = t0 + k, p = p0 + k; const u32x4 x = *(const u32x4*)(U + (size_t)t * EIN);
            const float rc = 1.0f / (float)((p + 1 < w) ? p + 1 : w); u32x4 o;
#pragma unroll
            for (int e = 0; e < 4; ++e) { const float a0 = bflo(x[e]), a1 = bfhi(x[e]); S[2 * e] += a0; S[2 * e + 1] += a1; o[e] = pk2(S[2 * e] * rc - a0, S[2 * e + 1] * rc - a1); }
            *(u32x4*)(PO + (size_t)t * 1024 + c) = o;
            if (p - (w - 1) >= 0) { const u32x4 y = *(const u32x4*)(U + (size_t)(t - (w - 1)) * EIN);
#pragma unroll
                for (int e = 0; e < 4; ++e) { S[2 * e] -= bflo(y[e]); S[2 * e + 1] -= bfhi(y[e]); } }
        }
    }
}
__device__ __forceinline__ void ret_scan_phase(const Frame& F0, const bf16_t* KVT, bf16_t* PREVT) {
    const Frame F = relaunder(F0);
    for (int it = F.bid * 512 + F.tid; it < 16 * 16384; it += F.G * 512) {
        const int bh = it >> 14, e4 = it & 16383, b = bh >> 2, h = bh & 3; const float cd = __builtin_amdgcn_exp2f(ret_lg2(h) * 128.0f);
        f32x4 st = (f32x4){0.f, 0.f, 0.f, 0.f};
#pragma unroll 8
        for (int n = 0; n < 31; ++n) { const size_t u = (size_t)((b * 32 + n) * 4 + h);
            { const u32x2 kw = *(const u32x2*)(KVT + u * 65536 + (size_t)e4 * 4); st = st * cd + (f32x4){bflo(kw.x), bfhi(kw.x), bflo(kw.y), bfhi(kw.y)}; }
            u32x2 o; o.x = pk2(st[0], st[1]); o.y = pk2(st[2], st[3]); *(u32x2*)(PREVT + (u + 4) * 65536 + (size_t)e4 * 4) = o; }
    }
}
__device__ __forceinline__ void ret_out_phase(const Frame& F0, const bf16_t* H5, const bf16_t* PREVT, bf16_t* MIX) {
    const Frame F = relaunder(F0);
    LAS unsigned char* Kt = F.lds; LAS unsigned char* Vt = F.lds + 128 * RRS;
    const int lane = F.lane, r = lane & 15, g4 = lane >> 4, qq = r >> 2, pp = r & 3, w = F.wave;
    for (int u = F.bid; u < 512; u += F.G) {
        const int h = u & 3, n = (u >> 2) & 31, b = u >> 7, tok0 = b * SEQ + n * 128; const float lg2 = ret_lg2(h);
        for (int c = F.tid; c < 128 * 32; c += 512) { const int row = c >> 5, ch = c & 31; const bf16_t* src = H5 + (size_t)(tok0 + row) * EIN + 1024 + h * 256 + ch * 8;
            *(LAS u32x4*)(Kt + row * RRS + ch * 16) = *(const u32x4*)src; *(LAS u32x4*)(Vt + row * RRS + ch * 16) = *(const u32x4*)(src + 1024); }
        const int i = 16 * w + r;
        bf16x8 Qf[8];
        { const bf16_t* qp = H5 + (size_t)(tok0 + i) * EIN + h * 256 + 8 * g4;
#pragma unroll
          for (int kk = 0; kk < 8; ++kk) Qf[kk] = *(const bf16x8*)(qp + 32 * kk); }
        __syncthreads();
        u32x2 P[8];
#pragma unroll
        for (int tj = 0; tj < 8; ++tj) {
            P[tj] = (u32x2){0u, 0u};
            if (tj <= w) { f32x4 acc = (f32x4){0.f, 0.f, 0.f, 0.f}; const LAS unsigned char* kp = Kt + (16 * tj + r) * RRS + 16 * g4;
#pragma unroll
                for (int kk = 0; kk < 8; ++kk) acc = mfma16(*(const LAS bf16x8*)(kp + 64 * kk), Qf[kk], acc);
                float pv[4];
#pragma unroll
                for (int jj = 0; jj < 4; ++jj) { const int j = 16 * tj + 4 * g4 + jj; pv[jj] = (i >= j) ? acc[jj] * 0.0625f * __builtin_amdgcn_exp2f(lg2 * (float)(i - j)) : 0.f; }
                P[tj].x = pk2(pv[0], pv[1]); P[tj].y = pk2(pv[2], pv[3]); }
        }
        __syncthreads();
        f32x4 acc[16];
#pragma unroll
        for (int te = 0; te < 16; ++te) acc[te] = (f32x4){0.f, 0.f, 0.f, 0.f};
        if (n > 0) {
#pragma unroll
            for (int half = 0; half < 2; ++half) {
                for (int c = F.tid; c < 128 * 32; c += 512) { const int row = c >> 5, ch = c & 31;
                    *(LAS u32x4*)(Kt + row * RRS + ch * 16) = *(const u32x4*)(PREVT + (size_t)u * 65536 + (size_t)(128 * half + row) * 256 + ch * 8); }
                __syncthreads();
                __builtin_amdgcn_s_setprio(1);
#pragma unroll
                for (int te = 0; te < 8; ++te) { const LAS unsigned char* pq = Kt + (16 * te + r) * RRS + 16 * g4;
#pragma unroll
                    for (int kk = 0; kk < 8; ++kk) acc[8 * half + te] = mfma16(*(const LAS bf16x8*)(pq + 64 * kk), Qf[kk], acc[8 * half + te]);
                    asm volatile("" : "+v"(acc[8 * half + te])); }
                __builtin_amdgcn_s_setprio(0);
                __syncthreads();
            }
            const float xi = __builtin_amdgcn_exp2f(lg2 * (float)(i + 1));
#pragma unroll
            for (int te = 0; te < 16; ++te) acc[te] = acc[te] * xi;
        }
        __builtin_amdgcn_s_setprio(1);
#pragma unroll
        for (int pr = 0; pr < 4; ++pr) {
            if (2 * pr <= w) { const u32x4 bw = (u32x4){P[2 * pr].x, P[2 * pr].y, P[2 * pr + 1].x, P[2 * pr + 1].y}; const bf16x8 bfrag = __builtin_bit_cast(bf16x8, bw);
                const LAS unsigned char* v0 = Vt + (32 * pr + 4 * g4 + qq) * RRS + 8 * pp;
#pragma unroll
                for (int te = 0; te < 16; ++te) { acc[te] = mfma16(cat8(vtr(v0 + 32 * te), vtr(v0 + 16 * RRS + 32 * te)), bfrag, acc[te]); if ((te & 3) == 3) asm volatile("" : "+v"(acc[te])); } }
        }
        __builtin_amdgcn_s_setprio(0);
        float s = 0.f;
#pragma unroll
        for (int te = 0; te < 16; ++te) s += (acc[te][0] + acc[te][1]) + (acc[te][2] + acc[te][3]);
        s += __shfl_xor(s, 16); s += __shfl_xor(s, 32);
        const float mean = s * (1.f / 256.f); float s2 = 0.f;
#pragma unroll
        for (int te = 0; te < 16; ++te) { acc[te] = acc[te] - mean; s2 += (acc[te][0] * acc[te][0] + acc[te][1] * acc[te][1]) + (acc[te][2] * acc[te][2] + acc[te][3] * acc[te][3]); }
        s2 += __shfl_xor(s2, 16); s2 += __shfl_xor(s2, 32);
        const float rstd = 1.0f / sqrtf(s2 * (1.f / 256.f) + LN_EPS);
        const bf16_t* gp = H5 + (size_t)(tok0 + i) * EIN + 3072 + h * 256 + 4 * g4; bf16_t* op = MIX + (size_t)(tok0 + i) * D + h * 256 + 4 * g4;
#pragma unroll
        for (int te = 0; te < 16; ++te) { const u32x2 gw = *(const u32x2*)(gp + 16 * te); float gv[4] = {bflo(gw.x), bfhi(gw.x), bflo(gw.y), bfhi(gw.y)}; float ov[4];
#pragma unroll
            for (int jj = 0; jj < 4; ++jj) { const float sg = gv[jj] / (1.0f + __builtin_amdgcn_exp2f(-gv[jj] * LOG2E)); ov[jj] = sg * acc[te][jj] * rstd; }
            u32x2 o; o.x = pk2(ov[0], ov[1]); o.y = pk2(ov[2], ov[3]); *(u32x2*)(op + 16 * te) = o; }
        __syncthreads();
    }
}

__device__ __forceinline__ void gemm_res_ln(const Frame& F, const XcdBarrier& bar, const bf16_t* A, const bf16_t* Bt, int K, const float* xres, float* Y, float* XF, bf16_t* XB,
                                            const float* g, const float* b, unsigned char* ws, int inst, bool last) {
    pg8::Gemm gm{A, Bt, K, K, K, 0};
    if (F.G == 256) {
        pg8::PanelOrder S{F.bid};
        pg8::EpiResLn E{xres, last ? XF : nullptr, XB, g, b, (unsigned long long*)(ws + WS_XCH) + (size_t)inst * 131072, (unsigned*)(ws + WS_CTL) + CW_LN + inst * 4096, F.lds + 131072};
        pg8::gemm_phase<pg8::EpiResLn, pg8::PanelOrder, true>(F.lds, gm, S, E);
        xcd_barrier(bar);
    } else {
        pg8::StaticOrder S; S.init(M, D, F.G, F.bid);
        pg8::EpiRes E{xres ? xres : XF, Y};
        pg8::gemm_phase<pg8::EpiRes, pg8::StaticOrder, true>(F.lds, gm, S, E);
        xcd_barrier(bar);
        ln_phase(F, Y, g, b, XF, XB);
        xcd_barrier(bar);
    }
}

__global__ void __launch_bounds__(512, 2) fwd_megakernel(Args args) {
    extern __shared__ __attribute__((aligned(16))) unsigned char lds_raw[];
    cg::grid_group grid = cg::this_grid();
    Frame F; F.lds = (LAS unsigned char*)lds_raw; F.tid = threadIdx.x; F.lane = F.tid & 63; F.wave = __builtin_amdgcn_readfirstlane(F.tid >> 6); F.G = gridDim.x; F.bid = blockIdx.x;
    unsigned char* ws = args.ws;
    bf16_t* XB = (bf16_t*)(ws + WS_XB); float* Y = (float*)(ws + WS_Y); bf16_t* MIX = (bf16_t*)(ws + WS_MIX);
    float* HALO = (float*)(ws + WS_HF); bf16_t* ACT = (bf16_t*)(ws + WS_ACT); bf16_t* H5 = (bf16_t*)(ws + WS_H5); bf16_t* QKV = (bf16_t*)(ws + WS_QKV);
    bf16_t* KVT = (bf16_t*)(ws + WS_KVT); bf16_t* PREVT = (bf16_t*)(ws + WS_PREVT); bf16_t* POOLED = (bf16_t*)(ws + WS_POOLED);
    float* XF = args.out;

    for (int u = F.tid; u < (LDS_BYTES - MISC_OFF) / 4; u += 512) ((LAS unsigned*)(F.lds + MISC_OFF))[u] = 0u;
    __syncthreads();
    const XcdBarrier bar = xcd_barrier_post((unsigned*)(ws + WS_CTL), (volatile LAS unsigned*)(F.lds + MISC_OFF));
#define GRID_BAR() xcd_barrier(bar)

    for (int rep = 0; rep < EXP_REP_P0; ++rep) p0_prologue(F, args);
    grid.sync();

    for (int layer = 0; layer < 4; ++layer) {
        const int li = layer >> 1;
        const float* xres = (layer == 0) ? args.in[0] : nullptr;
        if ((layer & 1) == 0) {
            for (int rep = 0; rep < EXP_REP_INP; ++rep)
            {
                pg8::Gemm g{XB, (const bf16_t*)(ws + WS_EIN) + (size_t)li * EIN * D, D, D, D, 0}; pg8::StaticOrder S; S.init(M, EIN, F.G, F.bid);
                pg8::EpiBf16 E{H5, EIN, nullptr, nullptr, 0};
                pg8::gemm_phase<pg8::EpiBf16, pg8::StaticOrder, true>(F.lds, g, S, E);
            }
            GRID_BAR();
            for (int rep = 0; rep < EXP_REP_RET; ++rep) {
            ret_kv_phase(F, H5, KVT);
            pooled_phase(F, H5, POOLED);
            GRID_BAR();
            ret_scan_phase(F, KVT, PREVT);
            {
                pg8::Gemm g{POOLED, (const bf16_t*)(ws + WS_POOLW) + (size_t)li * 1024 * 256, 1024, 256, 256, 256}; pg8::StaticOrder S; S.init(M, 1024, F.G, F.bid);
                pg8::EpiBf16 E{MIX, D, nullptr, args.in[5] + (size_t)li * 1024, 1024};
                pg8::gemm_phase<pg8::EpiBf16, pg8::StaticOrder, true>(F.lds, g, S, E);
            }
            GRID_BAR();
            ret_out_phase(F, H5, PREVT, MIX);
            GRID_BAR();
            }
        } else {
            {
                pg8::Gemm g{XB, (const bf16_t*)(ws + WS_QKVW) + (size_t)li * OIN * D, D, D, D, 0}; pg8::StaticOrder S; S.init(M, OIN, F.G, F.bid);
                pg8::EpiBf16 E{QKV, OIN, args.in[8] + (size_t)li * OIN, nullptr, 0};
                pg8::gemm_phase<pg8::EpiBf16, pg8::StaticOrder, true>(F.lds, g, S, E);
            }
            GRID_BAR();
            for (int rep = 0; rep < EXP_REP_ATT; ++rep) {
            attn_phase(F, QKV, args.in[9] + li * 32, MIX);
            GRID_BAR();
            }
        }
        gemm_res_ln(F, bar, MIX, ((layer & 1) == 0) ? (const bf16_t*)(ws + WS_EOUT) + (size_t)li * D * D : (const bf16_t*)(ws + WS_AOUT) + (size_t)li * D * D, D, xres, Y, XF, XB,
                    args.in[1] + (size_t)(layer * 2 + 0) * D, args.in[2] + (size_t)(layer * 2 + 0) * D, ws, layer * 2 + 0, false);
        for (int rep = 0; rep < EXP_REP_F1; ++rep)
        {
            pg8::Gemm g{XB, (const bf16_t*)(ws + WS_F1) + (size_t)layer * FF2 * D, D, D, D, 0}; pg8::StaticOrder S; S.init(M, FF2, F.G, F.bid);
            pg8::EpiConvGlu E{ACT, HALO, args.in[12] + (size_t)layer * 3 * FF2, args.in[13] + (size_t)layer * FF2, (LAS float*)(F.lds + 131072)};
            pg8::gemm_phase<pg8::EpiConvGlu, pg8::StaticOrder, true>(F.lds, g, S, E);
        }
        GRID_BAR();
        if (F.G == 256) conv_fixup_own(F, HALO, args.in[12] + (size_t)layer * 3 * FF2, args.in[13] + (size_t)layer * FF2, ACT);
        else { conv_fixup_phase(F, HALO, args.in[12] + (size_t)layer * 3 * FF2, args.in[13] + (size_t)layer * FF2, ACT); GRID_BAR(); }
        gemm_res_ln(F, bar, ACT, (const bf16_t*)(ws + WS_F2) + (size_t)layer * D * FF, FF, nullptr, Y, XF, XB,
                    args.in[1] + (size_t)(layer * 2 + 1) * D, args.in[2] + (size_t)(layer * 2 + 1) * D, ws, layer * 2 + 1, layer == 3);
    }
}

extern "C" void kernel_launch(void* const* d_in, const int* in_sizes, int n_in, void* d_out, int out_size, void* d_ws, size_t ws_size, hipStream_t stream) {
    static int grid = 0;
    if (grid == 0) {
        if (n_in != 15 || out_size != M * D || ws_size < WS_END) { fprintf(stderr, "kernel_launch: unexpected problem: n_in %d out %d ws %zu (need %zu)\n", n_in, out_size, ws_size, (size_t)WS_END); grid = -1; return; }
        int dev = 0, cus = 0, per_cu = 0;
        hipGetDevice(&dev); hipDeviceGetAttribute(&cus, hipDeviceAttributeMultiprocessorCount, dev);
        if (hipFuncSetAttribute((const void*)fwd_megakernel, hipFuncAttributeMaxDynamicSharedMemorySize, LDS_BYTES) != hipSuccess) { fprintf(stderr, "kernel_launch: hipFuncSetAttribute failed\n"); grid = -1; return; }
        if (hipOccupancyMaxActiveBlocksPerMultiprocessor(&per_cu, (const void*)fwd_megakernel, 512, LDS_BYTES) != hipSuccess || per_cu < 1) { fprintf(stderr, "kernel_launch: occupancy query says %d\n", per_cu); per_cu = 1; }
        (void)hipGetLastError();
        grid = cus;
    }
    if (grid < 0) return;
    Args a{};
    for (int i = 0; i < 15; ++i) a.in[i] = (const float*)d_in[i];
    a.out = (float*)d_out; a.ws = (unsigned char*)d_ws;
    if (hipMemsetAsync((char*)d_ws + WS_CTL, 0, CTL_BYTES, stream) != hipSuccess) { fprintf(stderr, "kernel_launch: memset failed\n"); return; }
    void* kargs[] = {&a};
    hipError_t e = hipLaunchCooperativeKernel((const void*)fwd_megakernel, dim3(grid), dim3(512), kargs, LDS_BYTES, stream);
    if (e != hipSuccess) fprintf(stderr, "kernel_launch: cooperative launch failed: %s (grid %d)\n", hipGetErrorString(e), grid);
}
```
